# Optimizing an MI355X kernel written in HIP

```python
import jax, jax.numpy as jnp
from jax import lax
import numpy as np

D_MODEL = 1024
BATCH = 8
SEQ = 4096
DEPTH = 2

MLA_HEADS = 8
MLA_NOPE = 64
MLA_ROPE = 32
MLA_V = 64
MLA_Q_RANK = 256
MLA_KV_RANK = 128
NSA_HEADS = 8
NSA_KV_HEADS = 2
NSA_HPG = NSA_HEADS // NSA_KV_HEADS
NSA_HD = 64
NSA_ROT = NSA_HD // 4
L_CMP = 32
S_CMP = 16
CMP_HIDDEN = 128
L_SLC = 64
N_SEL = 16
WINDOW = 512
ROPE_THETA = 500000.0
Q_BLOCK = 128
D_FF = 2816
ALPHA = (2 * DEPTH) ** 0.25
BETA = (8 * DEPTH) ** -0.25
LN_EPS = 1e-5
RMS_EPS = 1e-6
NEG = -1e30
BIG = 1e30
SPLITS = (MLA_Q_RANK, MLA_KV_RANK, MLA_ROPE, NSA_HEADS * NSA_HD, 6 * NSA_KV_HEADS * NSA_HD, 3 * NSA_HEADS, D_MODEL, D_MODEL)
D_IN = sum(SPLITS)

kernel_name = 'hybrid_mla_nsa_macaron_deepnorm'


def layer_norm(x, g, b):
    xf = x.astype(jnp.float32)
    mu = jnp.mean(xf, -1, keepdims=True)
    var = jnp.mean(jnp.square(xf - mu), -1, keepdims=True)
    return ((xf - mu) * lax.rsqrt(var + LN_EPS) * g + b).astype(x.dtype)


def rms_norm(x, g):
    xf = x.astype(jnp.float32)
    return (xf * lax.rsqrt(jnp.mean(xf * xf, -1, keepdims=True) + RMS_EPS) * g).astype(x.dtype)


def swiglu(x, wg, wu, wd):
    return (jax.nn.silu(x @ wg) * (x @ wu)) @ wd


def rope_tables(rot_dim, T):
    inv = 1.0 / (ROPE_THETA ** (jnp.arange(0, rot_dim, 2, dtype=jnp.float32) / rot_dim))
    ang = jnp.arange(T, dtype=jnp.float32)[:, None] * inv[None, :]
    return jnp.cos(ang), jnp.sin(ang)


def apply_rope(x, cos, sin):
    x1, x2 = jnp.split(x, 2, axis=-1)
    c, s = cos[:, None, :], sin[:, None, :]
    return jnp.concatenate([x1 * c - x2 * s, x2 * c + x1 * s], -1).astype(x.dtype)


def partial_rope(x, cos, sin):
    return jnp.concatenate([apply_rope(x[..., :NSA_ROT], cos, sin), x[..., NSA_ROT:]], -1)


def to_blocks(a):
    B, T = a.shape[:2]
    return a.reshape((B, T // Q_BLOCK, Q_BLOCK) + a.shape[2:]).swapaxes(0, 1)


def from_blocks(a):
    nblk, B, Q = a.shape[:3]
    return a.swapaxes(0, 1).reshape((B, nblk * Q) + a.shape[3:])


def mla_attention(q_nope, q_pe, k_nope, k_pe, v):
    T = q_nope.shape[1]
    scale = (MLA_NOPE + MLA_ROPE) ** -0.5
    kpos = jnp.arange(T)

    def one_block(args):
        qs, qn, qp = args
        s = (jnp.einsum('bqhd,bkhd->bhqk', qn, k_nope, preferred_element_type=jnp.float32)
             + jnp.einsum('bqhd,bkd->bhqk', qp, k_pe, preferred_element_type=jnp.float32)) * scale
        qpos = qs + jnp.arange(Q_BLOCK)
        s = jnp.where(kpos[None, :] <= qpos[:, None], s, NEG)
        p = jax.nn.softmax(s, axis=-1).astype(v.dtype)
        return jnp.einsum('bhqk,bkhd->bqhd', p, v)

    starts = jnp.arange(T // Q_BLOCK) * Q_BLOCK
    return from_blocks(lax.map(one_block, (starts, to_blocks(q_nope), to_blocks(q_pe))))


def compress(kv, pe, w1, b1, w2):
    B, T, G, D = kv.shape
    n_cmp = (T - L_CMP) // S_CMP + 1
    idx = np.arange(n_cmp)[:, None] * S_CMP + np.arange(L_CMP)[None, :]
    blk = kv[:, idx] + pe[:, None, :]
    blk = blk.transpose(0, 1, 3, 2, 4).reshape(B, n_cmp, G, L_CMP * D)
    return jax.nn.gelu(blk @ w1 + b1) @ w2


def nsa_attention(q, k_c, v_c, k_s, v_s, k_w, v_w, gates,
                  pe_k, k_w1, k_b1, k_w2, pe_v, v_w1, v_b1, v_w2):
    B, T = q.shape[:2]
    G, HPG, D = NSA_KV_HEADS, NSA_HPG, NSA_HD
    scale = D ** -0.5
    qg = q.reshape(B, T, G, HPG, D)
    tpos = jnp.arange(T)
    n_cmp = (T - L_CMP) // S_CMP + 1
    n_slc = T // L_SLC
    n_sel = min(N_SEL, n_slc)

    kc = compress(k_c, pe_k, k_w1, k_b1, k_w2)
    vc = compress(v_c, pe_v, v_w1, v_b1, v_w2)
    cmp_start = np.arange(n_cmp) * S_CMP
    valid = jnp.asarray(cmp_start + L_CMP - 1)[None, :] <= tpos[:, None]
    s = jnp.einsum('btghd,bcgd->bghtc', qg, kc, preferred_element_type=jnp.float32) * scale
    p_cmp = jax.nn.softmax(jnp.where(valid, s, NEG), axis=-1) * valid
    o_c = jnp.einsum('bghtc,bcgd->btghd', p_cmp.astype(vc.dtype), vc)

    blk = np.arange(n_slc)
    overlap = ((cmp_start[:, None] < (blk[None, :] + 1) * L_SLC)
               & (cmp_start[:, None] + L_CMP > blk[None, :] * L_SLC)).astype(np.float32)
    imp = jnp.einsum('bghtc,cj->btgj', p_cmp, jnp.asarray(overlap))
    cur = (tpos // L_SLC)[:, None]
    jb = jnp.arange(n_slc)[None, :]
    forced = (jb == 0) | (jb == cur) | (jb == cur - 1)
    causal = jb <= cur
    imp = jnp.where(forced[:, None], BIG, jnp.where(causal[:, None], imp, NEG))
    _, sel = lax.top_k(imp, n_sel)

    k_sb = k_s.reshape(B, n_slc, L_SLC, G, D).transpose(0, 3, 1, 2, 4)
    v_sb = v_s.reshape(B, n_slc, L_SLC, G, D).transpose(0, 3, 1, 2, 4)
    k_wp = jnp.pad(k_w, ((0, 0), (WINDOW, 0), (0, 0), (0, 0)))
    v_wp = jnp.pad(v_w, ((0, 0), (WINDOW, 0), (0, 0), (0, 0)))
    span = WINDOW + Q_BLOCK
    bi = jnp.arange(B)[:, None, None, None]
    gi = jnp.arange(G)[None, None, :, None]
    n_keys = n_sel * L_SLC

    def one_block(args):
        qs, qb, sb = args
        qpos = qs + jnp.arange(Q_BLOCK)
        ks = k_sb[bi, gi, sb].reshape(B, Q_BLOCK, G, n_keys, D)
        vs = v_sb[bi, gi, sb].reshape(B, Q_BLOCK, G, n_keys, D)
        kpos = (sb[..., None] * L_SLC + jnp.arange(L_SLC)).reshape(B, Q_BLOCK, G, n_keys)
        m_s = (kpos <= qpos[None, :, None, None]).transpose(0, 2, 1, 3)[:, :, None]
        s_s = jnp.einsum('bqghd,bqgkd->bghqk', qb, ks, preferred_element_type=jnp.float32) * scale
        p_s = jax.nn.softmax(jnp.where(m_s, s_s, NEG), axis=-1).astype(vs.dtype)
        o_s = jnp.einsum('bghqk,bqgkd->bqghd', p_s, vs)
        kw = lax.dynamic_slice_in_dim(k_wp, qs, span, axis=1)
        vw = lax.dynamic_slice_in_dim(v_wp, qs, span, axis=1)
        kpos_w = qs - WINDOW + jnp.arange(span)
        m_w = ((kpos_w[None, :] <= qpos[:, None]) & (kpos_w[None, :] > qpos[:, None] - WINDOW)
               & (kpos_w[None, :] >= 0))
        s_w = jnp.einsum('bqghd,bkgd->bghqk', qb, kw, preferred_element_type=jnp.float32) * scale
        p_w = jax.nn.softmax(jnp.where(m_w, s_w, NEG), axis=-1).astype(vw.dtype)
        o_w = jnp.einsum('bghqk,bkgd->bqghd', p_w, vw)
        return o_s, o_w

    starts = jnp.arange(T // Q_BLOCK) * Q_BLOCK
    o_s, o_w = lax.map(one_block, (starts, to_blocks(qg), to_blocks(sel)))
    o_s, o_w = from_blocks(o_s), from_blocks(o_w)
    g = gates.reshape(B, T, G, HPG, 3)
    o = g[..., 0:1] * o_c + g[..., 1:2] * o_s + g[..., 2:3] * o_w
    return o.reshape(B, T, NSA_HEADS * D)


def token_mixer(x, w_in, q_norm_g, w_uq, kv_norm_g, w_ukv,
                cmp_pe_k, cmp_k_w1, cmp_k_b1, cmp_k_w2, cmp_pe_v, cmp_v_w1, cmp_v_b1, cmp_v_w2,
                w_proj_mla, w_proj_nsa, w_out, cos_m, sin_m, cos_n, sin_n):
    B, T, _ = x.shape
    offsets = np.cumsum(SPLITS)[:-1].tolist()
    c_q, c_kv, k_pe, q_n, kv_n, g_n, gate_m, gate_n = jnp.split(x @ w_in, offsets, axis=-1)

    q = (rms_norm(c_q, q_norm_g) @ w_uq).reshape(B, T, MLA_HEADS, MLA_NOPE + MLA_ROPE)
    q_nope, q_pe = q[..., :MLA_NOPE], apply_rope(q[..., MLA_NOPE:], cos_m, sin_m)
    kv = (rms_norm(c_kv, kv_norm_g) @ w_ukv).reshape(B, T, MLA_HEADS, MLA_NOPE + MLA_V)
    k_nope, v_m = kv[..., :MLA_NOPE], kv[..., MLA_NOPE:]
    k_pe = apply_rope(k_pe[:, :, None, :], cos_m, sin_m)[:, :, 0]
    o_m = mla_attention(q_nope, q_pe, k_nope, k_pe, v_m).reshape(B, T, MLA_HEADS * MLA_V)

    qn = partial_rope(q_n.reshape(B, T, NSA_HEADS, NSA_HD), cos_n, sin_n)
    kvs = kv_n.reshape(B, T, 6, NSA_KV_HEADS, NSA_HD)
    k_c = partial_rope(kvs[:, :, 0], cos_n, sin_n)
    k_s = partial_rope(kvs[:, :, 2], cos_n, sin_n)
    k_w = partial_rope(kvs[:, :, 4], cos_n, sin_n)
    gates = jax.nn.sigmoid(g_n.reshape(B, T, NSA_HEADS, 3))
    o_n = nsa_attention(qn, k_c, kvs[:, :, 1], k_s, kvs[:, :, 3], k_w, kvs[:, :, 5], gates,
                        cmp_pe_k, cmp_k_w1, cmp_k_b1, cmp_k_w2, cmp_pe_v, cmp_v_w1, cmp_v_b1, cmp_v_w2)

    y = jax.nn.sigmoid(gate_m) * (o_m @ w_proj_mla) + jax.nn.sigmoid(gate_n) * (o_n @ w_proj_nsa)
    return y @ w_out


def setup_inputs(seed: int = 0) -> dict:
    key = jax.random.key(seed)
    ks = iter(jax.random.split(key, 64))

    def w(shape, fan_in, scale=1.0):
        return jax.random.normal(next(ks), (DEPTH,) + shape, jnp.float32) * (scale * fan_in ** -0.5)

    def gain(n):
        return 1.0 + 0.02 * jax.random.normal(next(ks), (DEPTH, n), jnp.float32)

    def small(shape, s=0.02):
        return s * jax.random.normal(next(ks), (DEPTH,) + shape, jnp.float32)

    return {
        'x': jax.random.normal(next(ks), (BATCH, SEQ, D_MODEL), jnp.float32),
        'ln_f1_g': gain(D_MODEL), 'ln_f1_b': small((D_MODEL,)),
        'ffn1_wg': w((D_MODEL, D_FF), D_MODEL), 'ffn1_wu': w((D_MODEL, D_FF), D_MODEL),
        'ffn1_wd': w((D_FF, D_MODEL), D_FF, BETA),
        'w_in': w((D_MODEL, D_IN), D_MODEL),
        'q_norm_g': gain(MLA_Q_RANK), 'w_uq': w((MLA_Q_RANK, MLA_HEADS * (MLA_NOPE + MLA_ROPE)), MLA_Q_RANK),
        'kv_norm_g': gain(MLA_KV_RANK), 'w_ukv': w((MLA_KV_RANK, MLA_HEADS * (MLA_NOPE + MLA_V)), MLA_KV_RANK),
        'cmp_pe_k': small((L_CMP, NSA_HD), 0.1), 'cmp_k_w1': w((L_CMP * NSA_HD, CMP_HIDDEN), L_CMP * NSA_HD),
        'cmp_k_b1': small((CMP_HIDDEN,)), 'cmp_k_w2': w((CMP_HIDDEN, NSA_HD), CMP_HIDDEN),
        'cmp_pe_v': small((L_CMP, NSA_HD), 0.1), 'cmp_v_w1': w((L_CMP * NSA_HD, CMP_HIDDEN), L_CMP * NSA_HD),
        'cmp_v_b1': small((CMP_HIDDEN,)), 'cmp_v_w2': w((CMP_HIDDEN, NSA_HD), CMP_HIDDEN),
        'w_proj_mla': w((MLA_HEADS * MLA_V, D_MODEL), MLA_HEADS * MLA_V),
        'w_proj_nsa': w((NSA_HEADS * NSA_HD, D_MODEL), NSA_HEADS * NSA_HD),
        'w_out': w((D_MODEL, D_MODEL), D_MODEL, BETA),
        'ln_mix_g': gain(D_MODEL), 'ln_mix_b': small((D_MODEL,)),
        'ffn2_wg': w((D_MODEL, D_FF), D_MODEL), 'ffn2_wu': w((D_MODEL, D_FF), D_MODEL),
        'ffn2_wd': w((D_FF, D_MODEL), D_FF, BETA),
        'ln_f2_g': gain(D_MODEL), 'ln_f2_b': small((D_MODEL,)),
    }


def reference(x, ln_f1_g, ln_f1_b, ffn1_wg, ffn1_wu, ffn1_wd, w_in, q_norm_g, w_uq, kv_norm_g, w_ukv,
              cmp_pe_k, cmp_k_w1, cmp_k_b1, cmp_k_w2, cmp_pe_v, cmp_v_w1, cmp_v_b1, cmp_v_w2,
              w_proj_mla, w_proj_nsa, w_out, ln_mix_g, ln_mix_b,
              ffn2_wg, ffn2_wu, ffn2_wd, ln_f2_g, ln_f2_b):
    T = x.shape[1]
    cos_m, sin_m = rope_tables(MLA_ROPE, T)
    cos_n, sin_n = rope_tables(NSA_ROT, T)
    for l in range(DEPTH):
        x = layer_norm(ALPHA * x + 0.5 * swiglu(x, ffn1_wg[l], ffn1_wu[l], ffn1_wd[l]), ln_f1_g[l], ln_f1_b[l])
        mix = token_mixer(x, w_in[l], q_norm_g[l], w_uq[l], kv_norm_g[l], w_ukv[l],
                          cmp_pe_k[l], cmp_k_w1[l], cmp_k_b1[l], cmp_k_w2[l],
                          cmp_pe_v[l], cmp_v_w1[l], cmp_v_b1[l], cmp_v_w2[l],
                          w_proj_mla[l], w_proj_nsa[l], w_out[l], cos_m, sin_m, cos_n, sin_n)
        x = layer_norm(ALPHA * x + mix, ln_mix_g[l], ln_mix_b[l])
        x = layer_norm(ALPHA * x + 0.5 * swiglu(x, ffn2_wg[l], ffn2_wu[l], ffn2_wd[l]), ln_f2_g[l], ln_f2_b[l])
    return x
```

```cpp
#include <hip/hip_runtime.h>
#include <hip/hip_cooperative_groups.h>
#include <stdint.h>
#include <stdio.h>
namespace cg = cooperative_groups;

#ifndef MULTI
#define MULTI 0
#endif

typedef unsigned short u16;
typedef __attribute__((ext_vector_type(8))) short bf16x8;
typedef __attribute__((ext_vector_type(4))) short s16x4;
typedef __attribute__((ext_vector_type(16))) float f32x16;
typedef __attribute__((ext_vector_type(4))) unsigned u32x4;
typedef __attribute__((ext_vector_type(2))) unsigned u32x2;
typedef __attribute__((ext_vector_type(2))) __bf16 bf2_t;
#define DI __device__ __forceinline__
#define MFMA(a, b, c) __builtin_amdgcn_mfma_f32_32x32x16_bf16((a), (b), (c), 0, 0, 0)
#define UNROLL _Pragma("unroll")

constexpr int NB = 8, T = 4096, DM = 1024, M = NB * T, FF = 2816;
constexpr float ALPHA = 1.4142135623730951f;
constexpr float NEGF = -1e30f;
constexpr float LOG2E = 1.4426950408889634f;

constexpr size_t W_UP1 = 0;
constexpr size_t W_DN1 = W_UP1 + (size_t)5632 * 1024;
constexpr size_t W_IN = W_DN1 + (size_t)1024 * 2816;
constexpr size_t W_UQ = W_IN + (size_t)3840 * 1024;
constexpr size_t W_UKV = W_UQ + (size_t)768 * 256;
constexpr size_t W_CK1 = W_UKV + (size_t)1024 * 128;
constexpr size_t W_CK2 = W_CK1 + (size_t)128 * 2048;
constexpr size_t W_CV1 = W_CK2 + (size_t)64 * 128;
constexpr size_t W_CV2 = W_CV1 + (size_t)128 * 2048;
constexpr size_t W_PM = W_CV2 + (size_t)64 * 128;
constexpr size_t W_PN = W_PM + (size_t)1024 * 512;
constexpr size_t W_OUT = W_PN + (size_t)1024 * 512;
constexpr size_t W_UP2 = W_OUT + (size_t)1024 * 1024;
constexpr size_t W_DN2 = W_UP2 + (size_t)5632 * 1024;
constexpr size_t W_LAYER = W_DN2 + (size_t)1024 * 2816;

constexpr size_t al256(size_t x) { return (x + 255) & ~(size_t)255; }
constexpr size_t OFF_W = 0;
constexpr size_t OFF_BIAS = al256(OFF_W + 2 * W_LAYER * 2);
constexpr size_t OFF_COSN = al256(OFF_BIAS + 2 * 2 * 128 * 4);
constexpr size_t OFF_SINN = OFF_COSN + (size_t)T * 8 * 4;
constexpr size_t OFF_COSM = OFF_SINN + (size_t)T * 8 * 4;
constexpr size_t OFF_SINM = OFF_COSM + (size_t)T * 16 * 4;
constexpr size_t OFF_CNT = OFF_SINM + (size_t)T * 16 * 4;
constexpr size_t OFF_XB = al256(OFF_CNT + 256);
constexpr size_t OFF_KM = OFF_XB;
constexpr size_t OFF_VM = OFF_XB + (size_t)M * 512 * 2;
constexpr size_t OFF_BIG = al256(OFF_XB + (size_t)M * 1024 * 2);
constexpr size_t OFF_H = OFF_BIG;
constexpr size_t OFF_CQ = OFF_BIG;
constexpr size_t OFF_CKV = OFF_CQ + (size_t)M * 256 * 2;
constexpr size_t OFF_QN = OFF_CKV + (size_t)M * 128 * 2;
constexpr size_t OFF_KV6 = OFF_QN + (size_t)M * 512 * 2;
constexpr size_t OFF_KPE = OFF_KV6 + (size_t)6 * M * 128 * 2;
constexpr size_t OFF_GATES = OFF_KPE + (size_t)M * 32 * 2;
constexpr size_t OFF_QM = OFF_GATES + (size_t)M * 24 * 4;
constexpr size_t OFF_GM = OFF_QM + (size_t)M * 768 * 2;
constexpr size_t OFF_GN = OFF_GM + (size_t)M * 1024 * 2;
constexpr size_t OFF_KC = OFF_GN + (size_t)M * 1024 * 2;
constexpr size_t OFF_VC = OFF_KC + (size_t)16 * 256 * 64 * 2;
constexpr size_t OFF_MIXEND = OFF_VC + (size_t)16 * 256 * 64 * 2 + 65536;
constexpr size_t OFF_HEND = OFF_H + (size_t)M * FF * 2;
constexpr size_t WS_NEED = OFF_MIXEND > OFF_HEND ? OFF_MIXEND : OFF_HEND;

constexpr int SMEM_BYTES = 73728 + 4096;

struct Params {
  const float* in[29];
  float* out;
  char* ws;
};

DI int ltid() {
  int t = __builtin_amdgcn_workitem_id_x();
  asm volatile("" : "+v"(t));
  return t;
}
DI float bf2f(u16 h) { return __uint_as_float(((unsigned)h) << 16); }
DI unsigned pk2(float a, float b) {
  bf2_t v;
  v[0] = (__bf16)a;
  v[1] = (__bf16)b;
  return __builtin_bit_cast(unsigned, v);
}
DI u16 f2bf(float a) { return (u16)(pk2(a, 0.f) & 0xffffu); }
DI float ex2(float x) { return __builtin_amdgcn_exp2f(x); }
DI float sigmoidf_(float x) { return 1.f / (1.f + __expf(-x)); }
DI bf16x8 pack8(const f32x16& v, int st) {
  u32x4 p;
  p[0] = pk2(v[8 * st + 0], v[8 * st + 1]);
  p[1] = pk2(v[8 * st + 2], v[8 * st + 3]);
  p[2] = pk2(v[8 * st + 4], v[8 * st + 5]);
  p[3] = pk2(v[8 * st + 6], v[8 * st + 7]);
  return __builtin_bit_cast(bf16x8, p);
}
DI s16x4 tr_read(const char* p) {
  return __builtin_amdgcn_ds_read_tr16_b64_v4i16((__attribute__((address_space(3))) s16x4*)(p));
}
DI void zero16(f32x16& v) {
  UNROLL for (int i = 0; i < 16; ++i) v[i] = 0.f;
}

DI void gemm_main(const u16* __restrict__ A, int lda, const u16* __restrict__ Bt, int ldb, int K,
                  f32x16 (&acc)[2][2], char* smem) {
  const int tid = ltid(), lane = tid & 63, w = tid >> 6, wr = w >> 1, wc = w & 1;
  const int lrow = tid >> 3, lch = tid & 7;
  const u16* ga = A + (size_t)lrow * lda + lch * 8;
  const u16* gb = Bt + (size_t)lrow * ldb + lch * 8;
  u32x4 ra[4], rb[4];
  UNROLL for (int i = 0; i < 4; ++i) {
    ra[i] = *(const u32x4*)(ga + (size_t)(32 * i) * lda);
    rb[i] = *(const u32x4*)(gb + (size_t)(32 * i) * ldb);
  }
  {
    char* pa = smem + lrow * 144 + lch * 16;
    UNROLL for (int i = 0; i < 4; ++i) {
      *(u32x4*)(pa + i * 32 * 144) = ra[i];
      *(u32x4*)(pa + 18432 + i * 32 * 144) = rb[i];
    }
  }
  __syncthreads();
  const int nk = K >> 6;
  for (int kt = 0; kt < nk; ++kt) {
    const bool more = (kt + 1 < nk);
    if (more) {
      const int k0 = (kt + 1) << 6;
      UNROLL for (int i = 0; i < 4; ++i) {
        ra[i] = *(const u32x4*)(ga + (size_t)(32 * i) * lda + k0);
        rb[i] = *(const u32x4*)(gb + (size_t)(32 * i) * ldb + k0);
      }
    }
    const char* pa = smem + (kt & 1) * 36864 + (wr * 64 + (lane & 31)) * 144 + (lane >> 5) * 16;
    const char* pb = smem + (kt & 1) * 36864 + 18432 + (wc * 64 + (lane & 31)) * 144 + (lane >> 5) * 16;
    UNROLL for (int ks = 0; ks < 4; ++ks) {
      bf16x8 a0 = *(const bf16x8*)(pa + ks * 32);
      bf16x8 a1 = *(const bf16x8*)(pa + 32 * 144 + ks * 32);
      bf16x8 b0 = *(const bf16x8*)(pb + ks * 32);
      bf16x8 b1 = *(const bf16x8*)(pb + 32 * 144 + ks * 32);
      acc[0][0] = MFMA(a0, b0, acc[0][0]);
      acc[0][1] = MFMA(a0, b1, acc[0][1]);
      acc[1][0] = MFMA(a1, b0, acc[1][0]);
      acc[1][1] = MFMA(a1, b1, acc[1][1]);
    }
    if (more) {
      char* pw = smem + ((kt + 1) & 1) * 36864 + lrow * 144 + lch * 16;
      UNROLL for (int i = 0; i < 4; ++i) {
        *(u32x4*)(pw + i * 32 * 144) = ra[i];
        *(u32x4*)(pw + 18432 + i * 32 * 144) = rb[i];
      }
    }
    __syncthreads();
  }
}

#define EPI_VARS const int tid = ltid(), lane = tid & 63, w = tid >> 6, wr = w >> 1, wc = w & 1, l31 = lane & 31, hh = lane >> 5; (void)l31; (void)hh; (void)wr; (void)wc;
#define EROW(mi, i) (wr * 64 + (mi) * 32 + 8 * ((i) >> 2) + 4 * hh + ((i) & 3))

DI void convT(const float* __restrict__ src0, const float* __restrict__ src1, int ldsrc, int K, int Nout,
                      int kind, const float* __restrict__ scale, u16* __restrict__ dst, char* smem) {
  float* t = (float*)smem;
  const int tid = ltid();
  const int tiles_n = Nout >> 6, tiles_k = K >> 6;
  for (int tile = blockIdx.x; tile < tiles_n * tiles_k; tile += gridDim.x) {
    const int tn = tile % tiles_n, tk = tile / tiles_n;
    {
      const int nn = tid & 63, n = tn * 64 + nn;
      const float* src = src0;
      int col = n;
      if (kind == 1) {
        const int j = n >> 7, r = n & 127, q = r >> 5, e = r & 31;
        col = 64 * j + 32 * (q >> 1) + e;
        src = (q & 1) ? src1 : src0;
      } else if (kind == 2) {
        if (n < 384) col = n;
        else if (n < 896) col = 416 + (n - 384);
        else if (n < 1664) col = 928 + (n - 896);
        else if (n < 2688) col = 1720 + (n - 1664);
        else if (n < 3712) col = 2744 + (n - 2688);
        else if (n < 3744) col = 384 + (n - 3712);
        else if (n < 3768) col = 1696 + (n - 3744);
        else col = -1;
      } else if (kind == 3) {
        if (n < 512) col = (n >> 6) * 96 + (n & 63);
        else col = ((n - 512) >> 5) * 96 + 64 + ((n - 512) & 31);
      }
      UNROLL for (int i = 0; i < 16; ++i) {
        const int kk = (tid >> 6) + 4 * i, k = tk * 64 + kk;
        float v = 0.f;
        if (col >= 0) v = src[(size_t)k * ldsrc + col];
        if (scale) v *= scale[k];
        t[kk * 65 + nn] = v;
      }
    }
    __syncthreads();
    {
      const int k8 = (tid & 7) * 8;
      UNROLL for (int i = 0; i < 2; ++i) {
        const int n2 = (tid >> 3) + 32 * i;
        u32x4 o;
        o[0] = pk2(t[(k8 + 0) * 65 + n2], t[(k8 + 1) * 65 + n2]);
        o[1] = pk2(t[(k8 + 2) * 65 + n2], t[(k8 + 3) * 65 + n2]);
        o[2] = pk2(t[(k8 + 4) * 65 + n2], t[(k8 + 5) * 65 + n2]);
        o[3] = pk2(t[(k8 + 6) * 65 + n2], t[(k8 + 7) * 65 + n2]);
        *(u32x4*)(dst + (size_t)(tn * 64 + n2) * K + tk * 64 + k8) = o;
      }
    }
    __syncthreads();
  }
}

DI void phase_init(const Params& p, char* smem) {
  const int tid = ltid();
  const size_t gtid = (size_t)blockIdx.x * 256 + tid, gsz = (size_t)gridDim.x * 256;
  if (blockIdx.x == 0 && tid < 64) ((int*)(p.ws + OFF_CNT))[tid] = 0;
  {
    const float4* xs = (const float4*)p.in[0];
    float4* xd = (float4*)p.out;
    u32x2* xb = (u32x2*)(p.ws + OFF_XB);
    for (size_t i = gtid; i < (size_t)M * DM / 4; i += gsz) {
      float4 v = xs[i];
      xd[i] = v;
      u32x2 o;
      o[0] = pk2(v.x, v.y);
      o[1] = pk2(v.z, v.w);
      xb[i] = o;
    }
  }
  {
    float* cn = (float*)(p.ws + OFF_COSN);
    float* sn = (float*)(p.ws + OFF_SINN);
    float* cm = (float*)(p.ws + OFF_COSM);
    float* sm = (float*)(p.ws + OFF_SINM);
    for (size_t i = gtid; i < (size_t)T * 24; i += gsz) {
      const int t = (int)(i / 24), j = (int)(i % 24);
      if (j < 8) {
        const float inv = (float)(1.0 / pow(500000.0, (double)(2 * j) / 16.0));
        const float ang = (float)t * inv;
        cn[t * 8 + j] = (float)cos((double)ang);
        sn[t * 8 + j] = (float)sin((double)ang);
      } else {
        const int m = j - 8;
        const float inv = (float)(1.0 / pow(500000.0, (double)(2 * m) / 32.0));
        const float ang = (float)t * inv;
        cm[t * 16 + m] = (float)cos((double)ang);
        sm[t * 16 + m] = (float)sin((double)ang);
      }
    }
  }
  if (blockIdx.x < 4) {
    const int layer = blockIdx.x >> 1, kv = blockIdx.x & 1;
    const float* pe = p.in[kv ? 15 : 11] + (size_t)layer * 2048;
    const float* w1 = p.in[kv ? 16 : 12] + (size_t)layer * 2048 * 128;
    const float* b1 = p.in[kv ? 17 : 13] + (size_t)layer * 128;
    float* red = (float*)smem;
    const int n = tid & 127, half = tid >> 7;
    float s = 0.f;
    for (int kk = half * 1024; kk < half * 1024 + 1024; ++kk) s += pe[kk] * w1[(size_t)kk * 128 + n];
    red[tid] = s;
    __syncthreads();
    if (tid < 128) ((float*)(p.ws + OFF_BIAS))[(layer * 2 + kv) * 128 + n] = red[tid] + red[tid + 128] + b1[n];
    __syncthreads();
  }
  for (int job = 0; job < 28; ++job) {
    const int layer = job / 14, jj = job % 14;
    u16* wl = (u16*)(p.ws + OFF_W) + (size_t)layer * W_LAYER;
    const float* s0 = nullptr; const float* s1 = nullptr; const float* sc = nullptr;
    int ldsrc = 0, K = 0, Nout = 0, kind = 0; size_t woff = 0;
    switch (jj) {
      case 0: s0 = p.in[3] + (size_t)layer * DM * FF; s1 = p.in[4] + (size_t)layer * DM * FF; ldsrc = FF; K = 1024; Nout = 5632; kind = 1; woff = W_UP1; break;
      case 1: s0 = p.in[5] + (size_t)layer * FF * DM; ldsrc = DM; K = FF; Nout = 1024; woff = W_DN1; break;
      case 2: s0 = p.in[6] + (size_t)layer * DM * 3768; ldsrc = 3768; K = 1024; Nout = 3840; kind = 2; woff = W_IN; break;
      case 3: s0 = p.in[8] + (size_t)layer * 256 * 768; ldsrc = 768; K = 256; Nout = 768; kind = 3; sc = p.in[7] + layer * 256; woff = W_UQ; break;
      case 4: s0 = p.in[10] + (size_t)layer * 128 * 1024; ldsrc = 1024; K = 128; Nout = 1024; sc = p.in[9] + layer * 128; woff = W_UKV; break;
      case 5: s0 = p.in[12] + (size_t)layer * 2048 * 128; ldsrc = 128; K = 2048; Nout = 128; woff = W_CK1; break;
      case 6: s0 = p.in[14] + (size_t)layer * 128 * 64; ldsrc = 64; K = 128; Nout = 64; woff = W_CK2; break;
      case 7: s0 = p.in[16] + (size_t)layer * 2048 * 128; ldsrc = 128; K = 2048; Nout = 128; woff = W_CV1; break;
      case 8: s0 = p.in[18] + (size_t)layer * 128 * 64; ldsrc = 64; K = 128; Nout = 64; woff = W_CV2; break;
      case 9: s0 = p.in[19] + (size_t)layer * 512 * 1024; ldsrc = 1024; K = 512; Nout = 1024; woff = W_PM; break;
      case 10: s0 = p.in[20] + (size_t)layer * 512 * 1024; ldsrc = 1024; K = 512; Nout = 1024; woff = W_PN; break;
      case 11: s0 = p.in[21] + (size_t)layer * 1024 * 1024; ldsrc = 1024; K = 1024; Nout = 1024; woff = W_OUT; break;
      case 12: s0 = p.in[24] + (size_t)layer * DM * FF; s1 = p.in[25] + (size_t)layer * DM * FF; ldsrc = FF; K = 1024; Nout = 5632; kind = 1; woff = W_UP2; break;
      default: s0 = p.in[26] + (size_t)layer * FF * DM; ldsrc = DM; K = FF; Nout = 1024; woff = W_DN2; break;
    }
    convT(s0, s1, ldsrc, K, Nout, kind, sc, wl + woff, smem);
  }
}

DI void phase_ffn_up(const Params& p, int layer, int which, char* smem) {
  EPI_VARS
  const u16* A = (const u16*)(p.ws + OFF_XB);
  const u16* W = (const u16*)(p.ws + OFF_W) + (size_t)layer * W_LAYER + (which ? W_UP2 : W_UP1);
  u16* H = (u16*)(p.ws + OFF_H);
  const int ntn = 44, ntiles = 256 * ntn;
  for (int tile = blockIdx.x; tile < ntiles; tile += gridDim.x) {
    const int tm = tile / ntn, tn = tile % ntn;
    f32x16 acc[2][2];
    UNROLL for (int a = 0; a < 2; ++a) UNROLL for (int b = 0; b < 2; ++b) zero16(acc[a][b]);
    gemm_main(A + (size_t)tm * 128 * 1024, 1024, W + (size_t)tn * 128 * 1024, 1024, 1024, acc, smem);
    UNROLL for (int mi = 0; mi < 2; ++mi) UNROLL for (int i = 0; i < 16; ++i) {
      const int row = tm * 128 + EROW(mi, i);
      const float g = acc[mi][0][i], u = acc[mi][1][i];
      const float h = g / (1.f + __expf(-g)) * u;
      H[(size_t)row * FF + tn * 64 + wc * 32 + l31] = f2bf(h);
    }
  }
}

DI void phase_resid(const Params& p, const u16* A, int lda, int K, const u16* W, float coef, char* smem) {
  EPI_VARS
  float* X = p.out;
  const int ntn = 8, ntiles = 256 * ntn;
  for (int tile = blockIdx.x; tile < ntiles; tile += gridDim.x) {
    const int tm = tile / ntn, tn = tile % ntn;
    f32x16 acc[2][2];
    UNROLL for (int a = 0; a < 2; ++a) UNROLL for (int b = 0; b < 2; ++b) zero16(acc[a][b]);
    gemm_main(A + (size_t)tm * 128 * lda, lda, W + (size_t)tn * 128 * K, K, K, acc, smem);
    UNROLL for (int mi = 0; mi < 2; ++mi) UNROLL for (int ni = 0; ni < 2; ++ni) UNROLL for (int i = 0; i < 16; ++i) {
      const int row = tm * 128 + EROW(mi, i);
      const size_t idx = (size_t)row * DM + tn * 128 + wc * 64 + ni * 32 + l31;
      if ((i & 3) == 0) asm volatile("" ::: "memory");
      X[idx] = ALPHA * X[idx] + coef * acc[mi][ni][i];
    }
  }
}

DI void phase_ln(const Params& p, const float* g, const float* b) {
  const int tid = ltid(), lane = tid & 63, w = tid >> 6;
  float* X = p.out;
  u16* Xb = (u16*)(p.ws + OFF_XB);
  float4 gv[4], bv[4];
  UNROLL for (int i = 0; i < 4; ++i) {
    gv[i] = *(const float4*)(g + i * 256 + lane * 4);
    bv[i] = *(const float4*)(b + i * 256 + lane * 4);
  }
  for (int row = blockIdx.x * 4 + w; row < M; row += gridDim.x * 4) {
    float4 v[4];
    float s = 0.f;
    UNROLL for (int i = 0; i < 4; ++i) {
      v[i] = *(const float4*)(X + (size_t)row * DM + i * 256 + lane * 4);
      s += v[i].x + v[i].y + v[i].z + v[i].w;
    }
    UNROLL for (int o = 32; o >= 1; o >>= 1) s += __shfl_xor(s, o);
    const float mu = s * (1.f / 1024.f);
    float q = 0.f;
    UNROLL for (int i = 0; i < 4; ++i) {
      v[i].x -= mu; v[i].y -= mu; v[i].z -= mu; v[i].w -= mu;
      q += v[i].x * v[i].x + v[i].y * v[i].y + v[i].z * v[i].z + v[i].w * v[i].w;
    }
    UNROLL for (int o = 32; o >= 1; o >>= 1) q += __shfl_xor(q, o);
    const float rstd = rsqrtf(q * (1.f / 1024.f) + 1e-5f);
    UNROLL for (int i = 0; i < 4; ++i) {
      float4 y;
      y.x = v[i].x * rstd * gv[i].x + bv[i].x;
      y.y = v[i].y * rstd * gv[i].y + bv[i].y;
      y.z = v[i].z * rstd * gv[i].z + bv[i].z;
      y.w = v[i].w * rstd * gv[i].w + bv[i].w;
      *(float4*)(X + (size_t)row * DM + i * 256 + lane * 4) = y;
      u32x2 o;
      o[0] = pk2(y.x, y.y);
      o[1] = pk2(y.z, y.w);
      *(u32x2*)(Xb + (size_t)row * DM + i * 256 + lane * 4) = o;
    }
  }
}

DI void phase_win(const Params& p, int layer, char* smem) {
  EPI_VARS
  const u16* A = (const u16*)(p.ws + OFF_XB);
  const u16* W = (const u16*)(p.ws + OFF_W) + (size_t)layer * W_LAYER + W_IN;
  u16* CQ = (u16*)(p.ws + OFF_CQ);
  u16* CKV = (u16*)(p.ws + OFF_CKV);
  u16* QN = (u16*)(p.ws + OFF_QN);
  u16* KV6 = (u16*)(p.ws + OFF_KV6);
  u16* KPE = (u16*)(p.ws + OFF_KPE);
  float* GATES = (float*)(p.ws + OFF_GATES);
  u16* GM = (u16*)(p.ws + OFF_GM);
  u16* GN = (u16*)(p.ws + OFF_GN);
  const float* COSN = (const float*)(p.ws + OFF_COSN);
  const float* SINN = (const float*)(p.ws + OFF_SINN);
  const float* COSM = (const float*)(p.ws + OFF_COSM);
  const float* SINM = (const float*)(p.ws + OFF_SINM);
  const int ntn = 30, ntiles = 256 * ntn;
  for (int tile = blockIdx.x; tile < ntiles; tile += gridDim.x) {
    const int tm = tile / ntn, tn = tile % ntn;
    f32x16 acc[2][2];
    UNROLL for (int a = 0; a < 2; ++a) UNROLL for (int b = 0; b < 2; ++b) zero16(acc[a][b]);
    gemm_main(A + (size_t)tm * 128 * 1024, 1024, W + (size_t)tn * 128 * 1024, 1024, 1024, acc, smem);
    if (tn < 3) {
      u16* dst = tn < 2 ? CQ : CKV;
      const int ld = tn < 2 ? 256 : 128, cb = tn < 2 ? tn * 128 : 0;
      UNROLL for (int mi = 0; mi < 2; ++mi) UNROLL for (int ni = 0; ni < 2; ++ni) UNROLL for (int i = 0; i < 16; ++i) {
        const int row = tm * 128 + EROW(mi, i);
        dst[(size_t)row * ld + cb + wc * 64 + ni * 32 + l31] = f2bf(acc[mi][ni][i]);
      }
    } else if (tn < 13) {
      const bool isq = tn < 7;
      const int j = tn - 7;
      const bool rope_on = isq || ((j & 1) == 0);
      UNROLL for (int mi = 0; mi < 2; ++mi) UNROLL for (int i = 0; i < 16; ++i) {
        const int row = tm * 128 + EROW(mi, i);
        const int t = row & (T - 1), b = row >> 12;
        float v0 = acc[mi][0][i];
        const float pr = __shfl_xor(v0, 8);
        if (rope_on && l31 < 16) {
          const float cs = COSN[t * 8 + (l31 & 7)], sn = SINN[t * 8 + (l31 & 7)];
          v0 = (l31 < 8) ? (v0 * cs - pr * sn) : (v0 * cs + pr * sn);
        }
        size_t base;
        if (isq) base = (size_t)row * 512 + (2 * (tn - 3) + wc) * 64;
        else base = ((size_t)((j * NB + b) * 2 + wc) * T + t) * 64;
        u16* dst = isq ? QN : KV6;
        dst[base + l31] = f2bf(v0);
        dst[base + 32 + l31] = f2bf(acc[mi][1][i]);
      }
    } else if (tn < 29) {
      u16* dst = tn < 21 ? GM : GN;
      const int cb = (tn < 21 ? tn - 13 : tn - 21) * 128;
      UNROLL for (int mi = 0; mi < 2; ++mi) UNROLL for (int ni = 0; ni < 2; ++ni) UNROLL for (int i = 0; i < 16; ++i) {
        const int row = tm * 128 + EROW(mi, i);
        dst[(size_t)row * 1024 + cb + wc * 64 + ni * 32 + l31] = f2bf(sigmoidf_(acc[mi][ni][i]));
      }
    } else {
      if (wc == 0) {
        UNROLL for (int mi = 0; mi < 2; ++mi) UNROLL for (int i = 0; i < 16; ++i) {
          const int row = tm * 128 + EROW(mi, i);
          const int t = row & (T - 1);
          float v0 = acc[mi][0][i];
          const float pr = __shfl_xor(v0, 16);
          const float cs = COSM[t * 16 + (l31 & 15)], sn = SINM[t * 16 + (l31 & 15)];
          v0 = (l31 < 16) ? (v0 * cs - pr * sn) : (v0 * cs + pr * sn);
          KPE[(size_t)row * 32 + l31] = f2bf(v0);
          if (l31 < 24) GATES[(size_t)row * 24 + l31] = sigmoidf_(acc[mi][1][i]);
        }
      }
    }
  }
}

DI float gelu_tanh(float x) {
  const float u = 0.7978845608028654f * (x + 0.044715f * x * x * x);
  return 0.5f * x * (1.f + tanhf(u));
}

DI void phase_up_cmp(const Params& p, int layer, char* smem) {
  EPI_VARS
  const u16* WL = (const u16*)(p.ws + OFF_W) + (size_t)layer * W_LAYER;
  float* rstd = (float*)(smem + 73728);
  const float* COSM = (const float*)(p.ws + OFF_COSM);
  const float* SINM = (const float*)(p.ws + OFF_SINM);
  const int ntasks = 64 + 1536 + 2048;
  for (int task = blockIdx.x; task < ntasks; task += gridDim.x) {
    f32x16 acc[2][2];
    UNROLL for (int a = 0; a < 2; ++a) UNROLL for (int b = 0; b < 2; ++b) zero16(acc[a][b]);
    if (task < 64) {
      const int kv = task >> 5, bg = (task >> 1) & 15, mt = task & 1;
      const u16* A = (const u16*)(p.ws + OFF_KV6) + ((size_t)(kv * 16 + bg) * T) * 64 + (size_t)mt * 128 * 1024;
      const u16* W1 = WL + (kv ? W_CV1 : W_CK1);
      const u16* W2 = WL + (kv ? W_CV2 : W_CK2);
      const float* bias = (const float*)(p.ws + OFF_BIAS) + (layer * 2 + kv) * 128;
      u16* dst = (u16*)(p.ws + (kv ? OFF_VC : OFF_KC)) + (size_t)bg * 256 * 64;
      gemm_main(A, 1024, W1, 2048, 2048, acc, smem);
      UNROLL for (int mi = 0; mi < 2; ++mi) UNROLL for (int ni = 0; ni < 2; ++ni) UNROLL for (int i = 0; i < 16; ++i) {
        const int r = EROW(mi, i), c = wc * 64 + ni * 32 + l31;
        *(u16*)(smem + r * 272 + c * 2) = f2bf(gelu_tanh(acc[mi][ni][i] + bias[c]));
      }
      __syncthreads();
      f32x16 a2[2];
      zero16(a2[0]);
      zero16(a2[1]);
      UNROLL for (int ks = 0; ks < 8; ++ks) {
        bf16x8 af = *(const bf16x8*)(smem + (32 * w + l31) * 272 + ks * 32 + hh * 16);
        bf16x8 b0 = *(const bf16x8*)(W2 + (size_t)(l31) * 128 + ks * 16 + hh * 8);
        bf16x8 b1 = *(const bf16x8*)(W2 + (size_t)(32 + l31) * 128 + ks * 16 + hh * 8);
        a2[0] = MFMA(af, b0, a2[0]);
        a2[1] = MFMA(af, b1, a2[1]);
      }
      UNROLL for (int ni = 0; ni < 2; ++ni) UNROLL for (int i = 0; i < 16; ++i) {
        const int c = mt * 128 + 32 * w + 8 * (i >> 2) + 4 * hh + (i & 3);
        dst[(size_t)c * 64 + ni * 32 + l31] = (c == 255) ? (u16)0 : f2bf(a2[ni][i]);
      }
      __syncthreads();
    } else if (task < 64 + 1536) {
      const int tt = task - 64, tm = tt / 6, tn = tt % 6;
      const u16* A = (const u16*)(p.ws + OFF_CQ) + (size_t)tm * 128 * 256;
      {
        const int r = tid >> 1, hf = tid & 1;
        const u16* ar = A + (size_t)r * 256 + hf * 128;
        float ss = 0.f;
        UNROLL for (int c = 0; c < 16; ++c) {
          u32x4 v = *(const u32x4*)(ar + c * 8);
          UNROLL for (int e = 0; e < 4; ++e) {
            const float lo = __uint_as_float(v[e] << 16), hi = __uint_as_float(v[e] & 0xffff0000u);
            ss += lo * lo + hi * hi;
          }
        }
        ss += __shfl_xor(ss, 1);
        if (hf == 0) rstd[r] = rsqrtf(ss * (1.f / 256.f) + 1e-6f);
      }
      gemm_main(A, 256, WL + W_UQ + (size_t)tn * 128 * 256, 256, 256, acc, smem);
      u16* QM = (u16*)(p.ws + OFF_QM);
      UNROLL for (int mi = 0; mi < 2; ++mi) UNROLL for (int ni = 0; ni < 2; ++ni) UNROLL for (int i = 0; i < 16; ++i) {
        const int r = EROW(mi, i), row = tm * 128 + r;
        float v = acc[mi][ni][i] * rstd[r];
        const float pr = __shfl_xor(v, 16);
        if (tn >= 4) {
          const int t = row & (T - 1);
          const float cs = COSM[t * 16 + (l31 & 15)], sn = SINM[t * 16 + (l31 & 15)];
          v = (l31 < 16) ? (v * cs - pr * sn) : (v * cs + pr * sn);
        }
        QM[(size_t)row * 768 + tn * 128 + wc * 64 + ni * 32 + l31] = f2bf(v);
      }
      __syncthreads();
    } else {
      const int tt = task - 64 - 1536, tm = tt >> 3, tn = tt & 7;
      const u16* A = (const u16*)(p.ws + OFF_CKV) + (size_t)tm * 128 * 128;
      {
        const int r = tid >> 1, hf = tid & 1;
        const u16* ar = A + (size_t)r * 128 + hf * 64;
        float ss = 0.f;
        UNROLL for (int c = 0; c < 8; ++c) {
          u32x4 v = *(const u32x4*)(ar + c * 8);
          UNROLL for (int e = 0; e < 4; ++e) {
            const float lo = __uint_as_float(v[e] << 16), hi = __uint_as_float(v[e] & 0xffff0000u);
            ss += lo * lo + hi * hi;
          }
        }
        ss += __shfl_xor(ss, 1);
        if (hf == 0) rstd[r] = rsqrtf(ss * (1.f / 128.f) + 1e-6f);
      }
      gemm_main(A, 128, WL + W_UKV + (size_t)tn * 128 * 128, 128, 128, acc, smem);
      u16* dst = (u16*)(p.ws + (wc == 0 ? OFF_KM : OFF_VM));
      UNROLL for (int mi = 0; mi < 2; ++mi) UNROLL for (int ni = 0; ni < 2; ++ni) UNROLL for (int i = 0; i < 16; ++i) {
        const int r = EROW(mi, i), row = tm * 128 + r;
        const int t = row & (T - 1), b = row >> 12;
        dst[((size_t)(b * 8 + tn) * T + t) * 64 + ni * 32 + l31] = f2bf(acc[mi][ni][i] * rstd[r]);
      }
      __syncthreads();
    }
  }
}

template <int NKS, int KSTR, int MODE>
DI void attn_tile(const char* sK, const char* sV, const bf16x8 (&qf)[2][NKS], f32x16 (&o)[2][2], float (&mrun)[2],
                  float (&lrun)[2], float sl2, int lane, int kbase, const int (&tq)[2], bool need_mask,
                  const bool (&selb)[2]) {
  const int hh = lane >> 5, r = lane & 31;
  const int blk = (lane >> 4) & 1, q4 = (lane & 15) >> 2, p4 = lane & 3;
  const int sw = (q4 >> 1) & 1;
  UNROLL for (int kt2 = 0; kt2 < 2; ++kt2) {
    f32x16 s[2];
    zero16(s[0]);
    zero16(s[1]);
    {
      const char* pk = sK + (32 * kt2 + r) * KSTR + hh * 16;
      UNROLL for (int ks = 0; ks < NKS; ++ks) {
        bf16x8 kf = *(const bf16x8*)(pk + ks * 32);
        s[0] = MFMA(kf, qf[0][ks], s[0]);
        s[1] = MFMA(kf, qf[1][ks], s[1]);
      }
    }
    UNROLL for (int qt = 0; qt < 2; ++qt) {
      float mx = NEGF;
      if (need_mask) {
        UNROLL for (int i = 0; i < 16; ++i) {
          const int key = kbase + 32 * kt2 + 8 * (i >> 2) + 4 * hh + (i & 3);
          bool ok = key <= tq[qt];
          if (MODE == 2) ok = ok && (key > tq[qt] - 512);
          if (MODE == 1) ok = ok && selb[qt];
          const float x = ok ? s[qt][i] * sl2 : NEGF;
          s[qt][i] = x;
          mx = fmaxf(mx, x);
        }
      } else {
        UNROLL for (int i = 0; i < 16; ++i) {
          float x = s[qt][i] * sl2;
          if (MODE == 1) x = selb[qt] ? x : NEGF;
          s[qt][i] = x;
          mx = fmaxf(mx, x);
        }
      }
      mx = fmaxf(mx, __shfl_xor(mx, 32));
      const float mnew = fmaxf(mrun[qt], mx);
      const float alpha = ex2(mrun[qt] - mnew);
      mrun[qt] = mnew;
      float ls = 0.f;
      UNROLL for (int i = 0; i < 16; ++i) {
        const float pv = ex2(s[qt][i] - mnew);
        s[qt][i] = pv;
        ls += pv;
      }
      lrun[qt] = lrun[qt] * alpha + ls;
      UNROLL for (int dt = 0; dt < 2; ++dt) UNROLL for (int i = 0; i < 16; ++i) o[qt][dt][i] *= alpha;
    }
    UNROLL for (int st = 0; st < 2; ++st) {
      const bf16x8 pf0 = pack8(s[0], st), pf1 = pack8(s[1], st);
      const int key0 = 32 * kt2 + 16 * st + 4 * hh + q4;
      UNROLL for (int dt = 0; dt < 2; ++dt) {
        const char* pv = sV + key0 * 128 + ((dt ^ sw) * 64) + (16 * blk + 4 * p4) * 2;
        const s16x4 lo = tr_read(pv), hi = tr_read(pv + 8 * 128);
        const bf16x8 vf = __builtin_shufflevector(lo, hi, 0, 1, 2, 3, 4, 5, 6, 7);
        o[0][dt] = MFMA(vf, pf0, o[0][dt]);
        o[1][dt] = MFMA(vf, pf1, o[1][dt]);
      }
    }
  }
}

DI void mla_task(const Params& p, int task, char* smem) {
  const int tid = ltid(), lane = tid & 63, w = tid >> 6, l31 = lane & 31, hh = lane >> 5;
  const int qb = 15 - (task >> 6), bh = task & 63, b = bh >> 3, h = bh & 7;
  const int q0 = qb * 256;
  u16* QM = (u16*)(p.ws + OFF_QM);
  const u16* KM = (const u16*)(p.ws + OFF_KM) + (size_t)bh * T * 64;
  const u16* VM = (const u16*)(p.ws + OFF_VM) + (size_t)bh * T * 64;
  const u16* KPE = (const u16*)(p.ws + OFF_KPE) + (size_t)b * T * 32;
  bf16x8 qf[2][6];
  int tq[2];
  UNROLL for (int qt = 0; qt < 2; ++qt) {
    tq[qt] = q0 + 64 * w + 32 * qt + l31;
    const u16* base = QM + (size_t)(b * T + tq[qt]) * 768;
    UNROLL for (int ks = 0; ks < 4; ++ks) qf[qt][ks] = *(const bf16x8*)(base + h * 64 + 16 * ks + 8 * hh);
    UNROLL for (int ks = 0; ks < 2; ++ks) qf[qt][4 + ks] = *(const bf16x8*)(base + 512 + h * 32 + 16 * ks + 8 * hh);
  }
  f32x16 o[2][2];
  UNROLL for (int a = 0; a < 2; ++a) UNROLL for (int c = 0; c < 2; ++c) zero16(o[a][c]);
  float mrun[2] = {NEGF, NEGF}, lrun[2] = {0.f, 0.f};
  const bool selb[2] = {true, true};
  const float sl2 = 0.10206207261596575f * LOG2E;
  const int nkt = (q0 >> 6) + 4, my_last = (q0 >> 6) + w;
  u32x4 rk[3], rv[2];
  auto gload = [&](int kt) {
    UNROLL for (int i = 0; i < 3; ++i) {
      const int c = tid + 256 * i, key = c / 12, ch = c % 12;
      const u16* src = (ch < 8) ? (KM + (size_t)(64 * kt + key) * 64 + ch * 8)
                                : (KPE + (size_t)(64 * kt + key) * 32 + (ch - 8) * 8);
      rk[i] = *(const u32x4*)src;
    }
    UNROLL for (int i = 0; i < 2; ++i) {
      const int c = tid + 256 * i, key = c >> 3, ch = c & 7;
      rv[i] = *(const u32x4*)(VM + (size_t)(64 * kt + key) * 64 + ch * 8);
    }
  };
  auto sstore = [&](int s) {
    UNROLL for (int i = 0; i < 3; ++i) {
      const int c = tid + 256 * i, key = c / 12, ch = c % 12;
      *(u32x4*)(smem + s * 13312 + key * 208 + ch * 16) = rk[i];
    }
    UNROLL for (int i = 0; i < 2; ++i) {
      const int c = tid + 256 * i, key = c >> 3, ch = c & 7;
      *(u32x4*)(smem + 26624 + s * 8192 + key * 128 + ((ch ^ (4 * ((key >> 1) & 1))) * 16)) = rv[i];
    }
  };
  gload(0);
  sstore(0);
  __syncthreads();
  for (int kt = 0; kt < nkt; ++kt) {
    const bool more = kt + 1 < nkt;
    if (more) gload(kt + 1);
    if (kt <= my_last) {
      const bool need_mask = (64 * kt + 63 > q0 + 64 * w);
      attn_tile<6, 208, 0>(smem + (kt & 1) * 13312, smem + 26624 + (kt & 1) * 8192, qf, o, mrun, lrun, sl2, lane,
                           64 * kt, tq, need_mask, selb);
    }
    if (more) sstore((kt + 1) & 1);
    __syncthreads();
  }
  UNROLL for (int qt = 0; qt < 2; ++qt) {
    const float lt = lrun[qt] + __shfl_xor(lrun[qt], 32);
    const float inv = 1.f / lt;
    u16* dst = QM + (size_t)(b * T + tq[qt]) * 768 + h * 64;
    UNROLL for (int dt = 0; dt < 2; ++dt) UNROLL for (int g4 = 0; g4 < 4; ++g4) {
      u32x2 v;
      v[0] = pk2(o[qt][dt][4 * g4 + 0] * inv, o[qt][dt][4 * g4 + 1] * inv);
      v[1] = pk2(o[qt][dt][4 * g4 + 2] * inv, o[qt][dt][4 * g4 + 3] * inv);
      *(u32x2*)(dst + 32 * dt + 8 * g4 + 4 * hh) = v;
    }
  }
}

template <int MODE>
DI void nsa_flash(const u16* __restrict__ Kg, const u16* __restrict__ Vg, int kt_lo, int kt_hi, int cur,
                  const bf16x8 (&qf)[2][4], f32x16 (&o)[2][2], float (&mrun)[2], float (&lrun)[2], float sl2,
                  const int (&tq)[2], const unsigned long long (&sel)[2], char* smem) {
  const int tid = ltid(), lane = tid & 63;
  u32x4 rk[2], rv[2];
  auto gload = [&](int kt) {
    UNROLL for (int i = 0; i < 2; ++i) {
      const int c = tid + 256 * i;
      rk[i] = *(const u32x4*)(Kg + (size_t)kt * 4096 + c * 8);
      rv[i] = *(const u32x4*)(Vg + (size_t)kt * 4096 + c * 8);
    }
  };
  auto sstore = [&](int s) {
    UNROLL for (int i = 0; i < 2; ++i) {
      const int c = tid + 256 * i, key = c >> 3, ch = c & 7;
      *(u32x4*)(smem + s * 9216 + key * 144 + ch * 16) = rk[i];
      *(u32x4*)(smem + 18432 + s * 8192 + key * 128 + ((ch ^ (4 * ((key >> 1) & 1))) * 16)) = rv[i];
    }
  };
  gload(kt_lo);
  sstore(0);
  __syncthreads();
  for (int kt = kt_lo; kt <= kt_hi; ++kt) {
    const int s = (kt - kt_lo) & 1;
    const bool more = kt < kt_hi;
    if (more) gload(kt + 1);
    bool selb[2] = {true, true};
    if (MODE == 1) {
      selb[0] = (sel[0] >> kt) & 1ull;
      selb[1] = (sel[1] >> kt) & 1ull;
    }
    const bool need_mask = (kt == cur) || (MODE == 2 && kt == cur - 8);
    attn_tile<4, 144, MODE>(smem + s * 9216, smem + 18432 + s * 8192, qf, o, mrun, lrun, sl2, lane, 64 * kt, tq,
                            need_mask, selb);
    if (more) sstore(s ^ 1);
    __syncthreads();
  }
}

DI void nsa_task(const Params& p, int task, char* smem) {
  const int tid = ltid(), lane = tid & 63, w = tid >> 6, l31 = lane & 31, hh = lane >> 5;
  const int cur = 63 - (task >> 4), bg = task & 15, b = bg >> 1, g = bg & 1;
  u16* QN = (u16*)(p.ws + OFF_QN);
  const u16* KV6 = (const u16*)(p.ws + OFF_KV6);
  const float* GATES = (const float*)(p.ws + OFF_GATES);
  const u16* KC = (const u16*)(p.ws + OFF_KC) + (size_t)bg * 256 * 64;
  const u16* VC = (const u16*)(p.ws + OFF_VC) + (size_t)bg * 256 * 64;
  const int head = 4 * g + (l31 & 3);
  bf16x8 qf[2][4];
  int tq[2];
  UNROLL for (int qt = 0; qt < 2; ++qt) {
    tq[qt] = 64 * cur + 16 * w + 8 * qt + (l31 >> 2);
    const u16* base = QN + (size_t)(b * T + tq[qt]) * 512 + head * 64;
    UNROLL for (int ks = 0; ks < 4; ++ks) qf[qt][ks] = *(const bf16x8*)(base + 16 * ks + 8 * hh);
  }
  const float sl2 = 0.125f * LOG2E;
  unsigned long long sel[2] = {~0ull, ~0ull};
  char* R1 = smem;
  char* R2 = smem + 36864;
  float* impw = (float*)(smem + 69632) + w * 512;
  {
    UNROLL for (int i = 0; i < 8; ++i) {
      const int c = tid + 256 * i, key = c >> 3, ch = c & 7;
      u32x4 kk = *(const u32x4*)(KC + (size_t)c * 8);
      u32x4 vv = *(const u32x4*)(VC + (size_t)c * 8);
      *(u32x4*)(R1 + (key >> 6) * 9216 + (key & 63) * 144 + ch * 16) = kk;
      *(u32x4*)(R2 + (key >> 6) * 8192 + (key & 63) * 128 + ((ch ^ (4 * ((key >> 1) & 1))) * 16)) = vv;
    }
    __syncthreads();
    const int blk = (lane >> 4) & 1, q4 = (lane & 15) >> 2, p4 = lane & 3, sw = (q4 >> 1) & 1;
    UNROLL for (int qt = 0; qt < 2; ++qt) {
      const int cmax = (tq[qt] - 31) >> 4;
      float mx = NEGF;
      UNROLL for (int a = 0; a < 8; ++a) {
        f32x16 sa;
        zero16(sa);
        const char* pk = R1 + (a >> 1) * 9216 + (32 * (a & 1) + l31) * 144 + hh * 16;
        UNROLL for (int ks = 0; ks < 4; ++ks) {
          bf16x8 kf = *(const bf16x8*)(pk + ks * 32);
          sa = MFMA(kf, qf[qt][ks], sa);
        }
        UNROLL for (int i = 0; i < 16; ++i) {
          const int c = 32 * a + 8 * (i >> 2) + 4 * hh + (i & 3);
          const float x = (c <= cmax) ? sa[i] * sl2 : NEGF;
          mx = fmaxf(mx, x);
        }
      }
      mx = fmaxf(mx, __shfl_xor(mx, 32));
      float sum = 0.f;
      float impv[32];
      float lastprev = 0.f;
      f32x16 oc[2];
      zero16(oc[0]);
      zero16(oc[1]);
      UNROLL for (int a = 0; a < 8; ++a) {
        f32x16 sa;
        zero16(sa);
        const char* pk = R1 + (a >> 1) * 9216 + (32 * (a & 1) + l31) * 144 + hh * 16;
        UNROLL for (int ks = 0; ks < 4; ++ks) {
          bf16x8 kf = *(const bf16x8*)(pk + ks * 32);
          sa = MFMA(kf, qf[qt][ks], sa);
        }
        UNROLL for (int i = 0; i < 16; ++i) {
          const int c = 32 * a + 8 * (i >> 2) + 4 * hh + (i & 3);
          const float pv = (c <= cmax) ? ex2(sa[i] * sl2 - mx) : 0.f;
          sa[i] = pv;
          sum += pv;
        }
        UNROLL for (int q = 0; q < 4; ++q) {
          const float g4 = sa[4 * q] + sa[4 * q + 1] + sa[4 * q + 2] + sa[4 * q + 3];
          const float lastcur = sa[4 * q + 3];
          const float tosend = hh ? lastprev : lastcur;
          const float recv = __shfl_xor(tosend, 32);
          impv[4 * a + q] = g4 + recv;
          lastprev = lastcur;
        }
        UNROLL for (int st = 0; st < 2; ++st) {
          const bf16x8 pf = pack8(sa, st);
          const int key0 = 32 * (a & 1) + 16 * st + 4 * hh + q4;
          UNROLL for (int dt = 0; dt < 2; ++dt) {
            const char* pv = R2 + (a >> 1) * 8192 + key0 * 128 + ((dt ^ sw) * 64) + (16 * blk + 4 * p4) * 2;
            const s16x4 lo = tr_read(pv), hi = tr_read(pv + 8 * 128);
            const bf16x8 vf = __builtin_shufflevector(lo, hi, 0, 1, 2, 3, 4, 5, 6, 7);
            oc[dt] = MFMA(vf, pf, oc[dt]);
          }
        }
      }
      sum += __shfl_xor(sum, 32);
      const float inv = sum > 0.f ? 1.f / sum : 0.f;
      UNROLL for (int gi = 0; gi < 32; ++gi) {
        float im = impv[gi] * inv;
        im += __shfl_xor(im, 1);
        im += __shfl_xor(im, 2);
        if ((l31 & 3) == (gi & 3)) impw[(l31 >> 2) * 64 + 2 * gi + hh] = im;
      }
      __syncthreads();
      if (cur >= 16) {
        UNROLL for (int t8 = 0; t8 < 8; ++t8) {
          float v = impw[t8 * 64 + lane];
          const int j = lane;
          if (j == 0 || j == cur || j == cur - 1) v = 1e30f;
          else if (j > cur) v = NEGF;
          int rank = 0;
          UNROLL for (int jp = 0; jp < 64; ++jp) {
            const float vp = __int_as_float(__builtin_amdgcn_readlane(__float_as_int(v), jp));
            rank += ((vp > v) || (vp == v && jp < j)) ? 1 : 0;
          }
          const unsigned long long mk = __ballot(rank < 16);
          if ((l31 >> 2) == t8) sel[qt] = mk;
        }
      }
      __syncthreads();
      const float g0 = GATES[(size_t)(b * T + tq[qt]) * 24 + head * 3 + 0] * inv;
      u16* dst = QN + (size_t)(b * T + tq[qt]) * 512 + head * 64;
      UNROLL for (int dt = 0; dt < 2; ++dt) UNROLL for (int g4 = 0; g4 < 4; ++g4) {
        u32x2 v;
        v[0] = pk2(oc[dt][4 * g4 + 0] * g0, oc[dt][4 * g4 + 1] * g0);
        v[1] = pk2(oc[dt][4 * g4 + 2] * g0, oc[dt][4 * g4 + 3] * g0);
        *(u32x2*)(dst + 32 * dt + 8 * g4 + 4 * hh) = v;
      }
    }
    __syncthreads();
  }
  UNROLL for (int br = 1; br <= 2; ++br) {
    f32x16 o[2][2];
    UNROLL for (int a = 0; a < 2; ++a) UNROLL for (int c = 0; c < 2; ++c) zero16(o[a][c]);
    float mrun[2] = {NEGF, NEGF}, lrun[2] = {0.f, 0.f};
    const u16* Kg = KV6 + ((size_t)((2 * br) * 16 + bg) * T) * 64;
    const u16* Vg = KV6 + ((size_t)((2 * br + 1) * 16 + bg) * T) * 64;
    if (br == 1) nsa_flash<1>(Kg, Vg, 0, cur, cur, qf, o, mrun, lrun, sl2, tq, sel, smem);
    else nsa_flash<2>(Kg, Vg, cur > 8 ? cur - 8 : 0, cur, cur, qf, o, mrun, lrun, sl2, tq, sel, smem);
    UNROLL for (int qt = 0; qt < 2; ++qt) {
      const float lt = lrun[qt] + __shfl_xor(lrun[qt], 32);
      const float gt = GATES[(size_t)(b * T + tq[qt]) * 24 + head * 3 + br];
      const float inv = gt / lt;
      u16* dst = QN + (size_t)(b * T + tq[qt]) * 512 + head * 64;
      UNROLL for (int dt = 0; dt < 2; ++dt) UNROLL for (int g4 = 0; g4 < 4; ++g4) {
        u32x2* pd = (u32x2*)(dst + 32 * dt + 8 * g4 + 4 * hh);
        const u32x2 old = *pd;
        u32x2 v;
        v[0] = pk2(o[qt][dt][4 * g4 + 0] * inv + __uint_as_float(old[0] << 16),
                   o[qt][dt][4 * g4 + 1] * inv + __uint_as_float(old[0] & 0xffff0000u));
        v[1] = pk2(o[qt][dt][4 * g4 + 2] * inv + __uint_as_float(old[1] << 16),
                   o[qt][dt][4 * g4 + 3] * inv + __uint_as_float(old[1] & 0xffff0000u));
        *pd = v;
      }
    }
  }
}

DI void phase_attn(const Params& p, int layer, char* smem) {
  int* cnt = (int*)(p.ws + OFF_CNT) + layer;
  int* s_task = (int*)(smem + 73728 + 2048);
  for (;;) {
    if (ltid() == 0) *s_task = atomicAdd(cnt, 1);
    __syncthreads();
    const int task = *s_task;
    __syncthreads();
    if (task >= 2048) break;
    if (task < 1024) mla_task(p, task, smem);
    else nsa_task(p, task - 1024, smem);
  }
}

DI void phase_proj(const Params& p, int layer, char* smem) {
  EPI_VARS
  const u16* WL = (const u16*)(p.ws + OFF_W) + (size_t)layer * W_LAYER;
  const u16* OM = (const u16*)(p.ws + OFF_QM);
  const u16* ON = (const u16*)(p.ws + OFF_QN);
  u16* GM = (u16*)(p.ws + OFF_GM);
  const u16* GN = (const u16*)(p.ws + OFF_GN);
  const int ntn = 8, ntiles = 256 * ntn;
  for (int tile = blockIdx.x; tile < ntiles; tile += gridDim.x) {
    const int tm = tile / ntn, tn = tile % ntn;
    f32x16 acc[2][2];
    UNROLL for (int a = 0; a < 2; ++a) UNROLL for (int b = 0; b < 2; ++b) zero16(acc[a][b]);
    gemm_main(OM + (size_t)tm * 128 * 768, 768, WL + W_PM + (size_t)tn * 128 * 512, 512, 512, acc, smem);
    UNROLL for (int mi = 0; mi < 2; ++mi) UNROLL for (int ni = 0; ni < 2; ++ni) UNROLL for (int i = 0; i < 16; ++i) {
      if ((i & 3) == 0) asm volatile("" ::: "memory");
      const int row = tm * 128 + EROW(mi, i);
      const size_t idx = (size_t)row * 1024 + tn * 128 + wc * 64 + ni * 32 + l31;
      acc[mi][ni][i] *= bf2f(GM[idx]) / bf2f(GN[idx]);
    }
    gemm_main(ON + (size_t)tm * 128 * 512, 512, WL + W_PN + (size_t)tn * 128 * 512, 512, 512, acc, smem);
    UNROLL for (int mi = 0; mi < 2; ++mi) UNROLL for (int ni = 0; ni < 2; ++ni) UNROLL for (int i = 0; i < 16; ++i) {
      const int row = tm * 128 + EROW(mi, i);
      const size_t idx = (size_t)row * 1024 + tn * 128 + wc * 64 + ni * 32 + l31;
      if ((i & 3) == 0) asm volatile("" ::: "memory");
      const float y = bf2f(GN[idx]) * acc[mi][ni][i];
      GM[idx] = f2bf(y);
    }
  }
}

DI void run_phase(const Params& p_in, int ph, char* smem) {
  Params p = p_in;
  asm volatile("" : "+s"(p.ws), "+s"(p.out));
  if (ph == 0) { phase_init(p, smem); return; }
  const int layer = (ph - 1) / 12, sub = (ph - 1) % 12;
  const u16* WL = (const u16*)(p.ws + OFF_W) + (size_t)layer * W_LAYER;
  switch (sub) {
    case 0: phase_ffn_up(p, layer, 0, smem); break;
    case 1: phase_resid(p, (const u16*)(p.ws + OFF_H), FF, FF, WL + W_DN1, 0.5f, smem); break;
    case 2: phase_ln(p, p.in[1] + layer * DM, p.in[2] + layer * DM); break;
    case 3: phase_win(p, layer, smem); break;
    case 4: phase_up_cmp(p, layer, smem); break;
    case 5: phase_attn(p, layer, smem); break;
    case 6: phase_proj(p, layer, smem); break;
    case 7: phase_resid(p, (const u16*)(p.ws + OFF_GM), 1024, 1024, WL + W_OUT, 1.0f, smem); break;
    case 8: phase_ln(p, p.in[22] + layer * DM, p.in[23] + layer * DM); break;
    case 9: phase_ffn_up(p, layer, 1, smem); break;
    case 10: phase_resid(p, (const u16*)(p.ws + OFF_H), FF, FF, WL + W_DN2, 0.5f, smem); break;
    case 11: phase_ln(p, p.in[27] + layer * DM, p.in[28] + layer * DM); break;
  }
}

__global__ void __launch_bounds__(256, 1) mega(Params p, int ph_lo, int ph_hi) {
  __shared__ __attribute__((aligned(16))) char smem[SMEM_BYTES];
  cg::grid_group grid = cg::this_grid();
  for (int ph = ph_lo; ph < ph_hi; ++ph) {
    if (ph > ph_lo) grid.sync();
    run_phase(p, ph, smem);
  }
}

extern "C" void kernel_launch(void* const* d_in, const int* in_sizes, int n_in, void* d_out, int out_size, void* d_ws,
                              size_t ws_size, hipStream_t stream) {
  Params p{};
  for (int i = 0; i < 29; ++i) p.in[i] = (const float*)d_in[i];
  p.out = (float*)d_out;
  p.ws = (char*)d_ws;
  if (ws_size < WS_NEED) fprintf(stderr, "workspace too small: %zu < %zu\n", ws_size, (size_t)WS_NEED);
  static int grid_blocks = 0;
  if (!grid_blocks) {
    int dev = 0, cus = 0, per_cu = 0;
    hipGetDevice(&dev);
    hipDeviceGetAttribute(&cus, hipDeviceAttributeMultiprocessorCount, dev);
    hipOccupancyMaxActiveBlocksPerMultiprocessor(&per_cu, mega, 256, 0);
    if (per_cu < 1) per_cu = 1;
    if (per_cu > 2) per_cu = 2;
    grid_blocks = cus * per_cu;
  }
  const int NPH = 25;
#if MULTI
  for (int ph = 0; ph < NPH; ++ph) {
    hipLaunchKernelGGL(mega, dim3(grid_blocks), dim3(256), 0, stream, p, ph, ph + 1);
  }
#else
  int lo = 0, hi = NPH;
  void* args[] = {&p, &lo, &hi};
  hipError_t e = hipLaunchCooperativeKernel((void*)mega, dim3(grid_blocks), dim3(256), args, 0, stream);
  if (e != hipSuccess) fprintf(stderr, "cooperative launch failed: %s (grid %d)\n", hipGetErrorString(e), grid_blocks);
#endif
}
```

```cpp
#include <hip/hip_runtime.h>
#include <hip/hip_cooperative_groups.h>
#include <stdint.h>
#include <stdio.h>
namespace cg = cooperative_groups;

#ifndef MULTI
#define MULTI 0
#endif

typedef unsigned short u16;
typedef __attribute__((ext_vector_type(8))) short bf16x8;
typedef __attribute__((ext_vector_type(4))) short s16x4;
typedef __attribute__((ext_vector_type(16))) float f32x16;
typedef __attribute__((ext_vector_type(4))) unsigned u32x4;
typedef __attribute__((ext_vector_type(2))) unsigned u32x2;
typedef __attribute__((ext_vector_type(2))) __bf16 bf2_t;
#define DI __device__ __forceinline__
#define MFMA(a, b, c) __builtin_amdgcn_mfma_f32_32x32x16_bf16((a), (b), (c), 0, 0, 0)
#define UNROLL _Pragma("unroll")

constexpr int NB = 8, T = 4096, DM = 1024, M = NB * T, FF = 2816;
constexpr float ALPHA = 1.4142135623730951f;
constexpr float NEGF = -1e30f;
constexpr float LOG2E = 1.4426950408889634f;

constexpr size_t W_UP1 = 0;
constexpr size_t W_DN1 = W_UP1 + (size_t)5632 * 1024;
constexpr size_t W_IN = W_DN1 + (size_t)1024 * 2816;
constexpr size_t W_UQ = W_IN + (size_t)3840 * 1024;
constexpr size_t W_UKV = W_UQ + (size_t)768 * 256;
constexpr size_t W_CK1 = W_UKV + (size_t)1024 * 128;
constexpr size_t W_CK2 = W_CK1 + (size_t)128 * 2048;
constexpr size_t W_CV1 = W_CK2 + (size_t)64 * 128;
constexpr size_t W_CV2 = W_CV1 + (size_t)128 * 2048;
constexpr size_t W_PM = W_CV2 + (size_t)64 * 128;
constexpr size_t W_PN = W_PM + (size_t)1024 * 512;
constexpr size_t W_OUT = W_PN + (size_t)1024 * 512;
constexpr size_t W_UP2 = W_OUT + (size_t)1024 * 1024;
constexpr size_t W_DN2 = W_UP2 + (size_t)5632 * 1024;
constexpr size_t W_LAYER = W_DN2 + (size_t)1024 * 2816;

constexpr size_t al256(size_t x) { return (x + 255) & ~(size_t)255; }
constexpr size_t OFF_W = 0;
constexpr size_t OFF_BIAS = al256(OFF_W + 2 * W_LAYER * 2);
constexpr size_t OFF_COSN = al256(OFF_BIAS + 2 * 2 * 128 * 4);
constexpr size_t OFF_SINN = OFF_COSN + (size_t)T * 8 * 4;
constexpr size_t OFF_COSM = OFF_SINN + (size_t)T * 8 * 4;
constexpr size_t OFF_SINM = OFF_COSM + (size_t)T * 16 * 4;
constexpr size_t OFF_CNT = OFF_SINM + (size_t)T * 16 * 4;
constexpr size_t OFF_XB = al256(OFF_CNT + 256);
constexpr size_t OFF_KM = OFF_XB;
constexpr size_t OFF_VM = OFF_XB + (size_t)M * 512 * 2;
constexpr size_t OFF_BIG = al256(OFF_XB + (size_t)M * 1024 * 2);
constexpr size_t OFF_H = OFF_BIG;
constexpr size_t OFF_CQ = OFF_BIG;
constexpr size_t OFF_CKV = OFF_CQ + (size_t)M * 256 * 2;
constexpr size_t OFF_QN = OFF_CKV + (size_t)M * 128 * 2;
constexpr size_t OFF_KV6 = OFF_QN + (size_t)M * 512 * 2;
constexpr size_t OFF_KPE = OFF_KV6 + (size_t)6 * M * 128 * 2;
constexpr size_t OFF_GATES = OFF_KPE + (size_t)M * 32 * 2;
constexpr size_t OFF_QM = OFF_GATES + (size_t)M * 24 * 4;
constexpr size_t OFF_GM = OFF_QM + (size_t)M * 768 * 2;
constexpr size_t OFF_GN = OFF_GM + (size_t)M * 1024 * 2;
constexpr size_t OFF_KC = OFF_GN + (size_t)M * 1024 * 2;
constexpr size_t OFF_VC = OFF_KC + (size_t)16 * 256 * 64 * 2;
constexpr size_t OFF_MIXEND = OFF_VC + (size_t)16 * 256 * 64 * 2 + 65536;
constexpr size_t OFF_HEND = OFF_H + (size_t)M * FF * 2;
constexpr size_t WS_NEED = OFF_MIXEND > OFF_HEND ? OFF_MIXEND : OFF_HEND;

constexpr int SMEM_BYTES = 69632 + 8192 + 512 + 64;

struct Params {
  const float* in[29];
  float* out;
  char* ws;
};

DI int ltid() {
  int t = __builtin_amdgcn_workitem_id_x();
  asm volatile("" : "+v"(t));
  return t;
}
DI float bf2f(u16 h) { return __uint_as_float(((unsigned)h) << 16); }
DI unsigned pk2(float a, float b) {
  bf2_t v;
  v[0] = (__bf16)a;
  v[1] = (__bf16)b;
  return __builtin_bit_cast(unsigned, v);
}
DI u16 f2bf(float a) { return (u16)(pk2(a, 0.f) & 0xffffu); }
DI float ex2(float x) { return __builtin_amdgcn_exp2f(x); }
DI float sigmoidf_(float x) { return 1.f / (1.f + __expf(-x)); }
DI bf16x8 pack8(const f32x16& v, int st) {
  u32x4 p;
  p[0] = pk2(v[8 * st + 0], v[8 * st + 1]);
  p[1] = pk2(v[8 * st + 2], v[8 * st + 3]);
  p[2] = pk2(v[8 * st + 4], v[8 * st + 5]);
  p[3] = pk2(v[8 * st + 6], v[8 * st + 7]);
  return __builtin_bit_cast(bf16x8, p);
}
DI s16x4 tr_read(const char* p) {
  return __builtin_amdgcn_ds_read_tr16_b64_v4i16((__attribute__((address_space(3))) s16x4*)(p));
}
DI void zero16(f32x16& v) {
  float z = 0.f;
  asm volatile("" : "+v"(z));
  UNROLL for (int i = 0; i < 16; ++i) v[i] = z;
}

DI void gemm_main(const u16* __restrict__ A, int lda, const u16* __restrict__ Bt, int ldb, int K,
                  f32x16 (&acc)[2][2], char* smem) {
  const int tid = ltid(), lane = tid & 63, w = tid >> 6, wr = w >> 1, wc = w & 1;
  const int lrow = tid >> 3, lch = tid & 7;
  const u16* ga = A + (size_t)lrow * lda + lch * 8;
  const u16* gb = Bt + (size_t)lrow * ldb + lch * 8;
  u32x4 ra[4], rb[4];
  UNROLL for (int i = 0; i < 4; ++i) {
    ra[i] = *(const u32x4*)(ga + (size_t)(32 * i) * lda);
    rb[i] = *(const u32x4*)(gb + (size_t)(32 * i) * ldb);
  }
  {
    char* pa = smem + lrow * 144 + lch * 16;
    UNROLL for (int i = 0; i < 4; ++i) {
      *(u32x4*)(pa + i * 32 * 144) = ra[i];
      *(u32x4*)(pa + 18432 + i * 32 * 144) = rb[i];
    }
  }
  __syncthreads();
  const int nk = K >> 6;
  _Pragma("unroll 1") for (int kt = 0; kt < nk; ++kt) {
    const bool more = (kt + 1 < nk);
    if (more) {
      const int k0 = (kt + 1) << 6;
      UNROLL for (int i = 0; i < 4; ++i) {
        ra[i] = *(const u32x4*)(ga + (size_t)(32 * i) * lda + k0);
        rb[i] = *(const u32x4*)(gb + (size_t)(32 * i) * ldb + k0);
      }
    }
    const char* pa = smem + (kt & 1) * 36864 + (wr * 64 + (lane & 31)) * 144 + (lane >> 5) * 16;
    const char* pb = smem + (kt & 1) * 36864 + 18432 + (wc * 64 + (lane & 31)) * 144 + (lane >> 5) * 16;
    UNROLL for (int ks = 0; ks < 4; ++ks) {
      bf16x8 a0 = *(const bf16x8*)(pa + ks * 32);
      bf16x8 a1 = *(const bf16x8*)(pa + 32 * 144 + ks * 32);
      bf16x8 b0 = *(const bf16x8*)(pb + ks * 32);
      bf16x8 b1 = *(const bf16x8*)(pb + 32 * 144 + ks * 32);
      acc[0][0] = MFMA(a0, b0, acc[0][0]);
      acc[0][1] = MFMA(a0, b1, acc[0][1]);
      acc[1][0] = MFMA(a1, b0, acc[1][0]);
      acc[1][1] = MFMA(a1, b1, acc[1][1]);
    }
    if (more) {
      char* pw = smem + ((kt + 1) & 1) * 36864 + lrow * 144 + lch * 16;
      UNROLL for (int i = 0; i < 4; ++i) {
        *(u32x4*)(pw + i * 32 * 144) = ra[i];
        *(u32x4*)(pw + 18432 + i * 32 * 144) = rb[i];
      }
    }
    __syncthreads();
  }
}

#define EPI_VARS const int tid = ltid(), lane = tid & 63, w = tid >> 6, wr = w >> 1, wc = w & 1, l31 = lane & 31, hh = lane >> 5; (void)l31; (void)hh; (void)wr; (void)wc;
#define EROW(mi, i) (wr * 64 + (mi) * 32 + 8 * ((i) >> 2) + 4 * hh + ((i) & 3))

DI void convT(const float* __restrict__ src0, const float* __restrict__ src1, int ldsrc, int K, int Nout,
                      int kind, const float* __restrict__ scale, u16* __restrict__ dst, char* smem) {
  float* t = (float*)smem;
  const int tid = ltid();
  const int tiles_n = Nout >> 6, tiles_k = K >> 6;
  for (int tile = blockIdx.x; tile < tiles_n * tiles_k; tile += gridDim.x) {
    const int tn = tile % tiles_n, tk = tile / tiles_n;
    {
      const int nn = tid & 63, n = tn * 64 + nn;
      const float* src = src0;
      int col = n;
      if (kind == 1) {
        const int j = n >> 7, r = n & 127, q = r >> 5, e = r & 31;
        col = 64 * j + 32 * (q >> 1) + e;
        src = (q & 1) ? src1 : src0;
      } else if (kind == 2) {
        if (n < 384) col = n;
        else if (n < 896) col = 416 + (n - 384);
        else if (n < 1664) col = 928 + (n - 896);
        else if (n < 2688) col = 1720 + (n - 1664);
        else if (n < 3712) col = 2744 + (n - 2688);
        else if (n < 3744) col = 384 + (n - 3712);
        else if (n < 3768) col = 1696 + (n - 3744);
        else col = -1;
      } else if (kind == 3) {
        if (n < 512) col = (n >> 6) * 96 + (n & 63);
        else col = ((n - 512) >> 5) * 96 + 64 + ((n - 512) & 31);
      }
      UNROLL for (int i = 0; i < 16; ++i) {
        const int kk = (tid >> 6) + 4 * i, k = tk * 64 + kk;
        float v = 0.f;
        if (col >= 0) v = src[(size_t)k * ldsrc + col];
        if (scale) v *= scale[k];
        t[kk * 65 + nn] = v;
      }
    }
    __syncthreads();
    {
      const int k8 = (tid & 7) * 8;
      UNROLL for (int i = 0; i < 2; ++i) {
        const int n2 = (tid >> 3) + 32 * i;
        u32x4 o;
        o[0] = pk2(t[(k8 + 0) * 65 + n2], t[(k8 + 1) * 65 + n2]);
        o[1] = pk2(t[(k8 + 2) * 65 + n2], t[(k8 + 3) * 65 + n2]);
        o[2] = pk2(t[(k8 + 4) * 65 + n2], t[(k8 + 5) * 65 + n2]);
        o[3] = pk2(t[(k8 + 6) * 65 + n2], t[(k8 + 7) * 65 + n2]);
        *(u32x4*)(dst + (size_t)(tn * 64 + n2) * K + tk * 64 + k8) = o;
      }
    }
    __syncthreads();
  }
}

DI void phase_init(const Params& p, char* smem) {
  const int tid = ltid();
  const size_t gtid = (size_t)blockIdx.x * 256 + tid, gsz = (size_t)gridDim.x * 256;
  if (blockIdx.x == 0 && tid < 64) ((int*)(p.ws + OFF_CNT))[tid] = 0;
  {
    const float4* xs = (const float4*)p.in[0];
    float4* xd = (float4*)p.out;
    u32x2* xb = (u32x2*)(p.ws + OFF_XB);
    for (size_t i = gtid; i < (size_t)M * DM / 4; i += gsz) {
      float4 v = xs[i];
      xd[i] = v;
      u32x2 o;
      o[0] = pk2(v.x, v.y);
      o[1] = pk2(v.z, v.w);
      xb[i] = o;
    }
  }
  {
    float* cn = (float*)(p.ws + OFF_COSN);
    float* sn = (float*)(p.ws + OFF_SINN);
    float* cm = (float*)(p.ws + OFF_COSM);
    float* sm = (float*)(p.ws + OFF_SINM);
    for (size_t i = gtid; i < (size_t)T * 24; i += gsz) {
      const int t = (int)(i / 24), j = (int)(i % 24);
      if (j < 8) {
        const float inv = (float)(1.0 / pow(500000.0, (double)(2 * j) / 16.0));
        const float ang = (float)t * inv;
        cn[t * 8 + j] = (float)cos((double)ang);
        sn[t * 8 + j] = (float)sin((double)ang);
      } else {
        const int m = j - 8;
        const float inv = (float)(1.0 / pow(500000.0, (double)(2 * m) / 32.0));
        const float ang = (float)t * inv;
        cm[t * 16 + m] = (float)cos((double)ang);
        sm[t * 16 + m] = (float)sin((double)ang);
      }
    }
  }
  if (blockIdx.x < 4) {
    const int layer = blockIdx.x >> 1, kv = blockIdx.x & 1;
    const float* pe = p.in[kv ? 15 : 11] + (size_t)layer * 2048;
    const float* w1 = p.in[kv ? 16 : 12] + (size_t)layer * 2048 * 128;
    const float* b1 = p.in[kv ? 17 : 13] + (size_t)layer * 128;
    float* red = (float*)smem;
    const int n = tid & 127, half = tid >> 7;
    float s = 0.f;
    for (int kk = half * 1024; kk < half * 1024 + 1024; ++kk) s += pe[kk] * w1[(size_t)kk * 128 + n];
    red[tid] = s;
    __syncthreads();
    if (tid < 128) ((float*)(p.ws + OFF_BIAS))[(layer * 2 + kv) * 128 + n] = red[tid] + red[tid + 128] + b1[n];
    __syncthreads();
  }
  for (int job = 0; job < 28; ++job) {
    const int layer = job / 14, jj = job % 14;
    u16* wl = (u16*)(p.ws + OFF_W) + (size_t)layer * W_LAYER;
    const float* s0 = nullptr; const float* s1 = nullptr; const float* sc = nullptr;
    int ldsrc = 0, K = 0, Nout = 0, kind = 0; size_t woff = 0;
    switch (jj) {
      case 0: s0 = p.in[3] + (size_t)layer * DM * FF; s1 = p.in[4] + (size_t)layer * DM * FF; ldsrc = FF; K = 1024; Nout = 5632; kind = 1; woff = W_UP1; break;
      case 1: s0 = p.in[5] + (size_t)layer * FF * DM; ldsrc = DM; K = FF; Nout = 1024; woff = W_DN1; break;
      case 2: s0 = p.in[6] + (size_t)layer * DM * 3768; ldsrc = 3768; K = 1024; Nout = 3840; kind = 2; woff = W_IN; break;
      case 3: s0 = p.in[8] + (size_t)layer * 256 * 768; ldsrc = 768; K = 256; Nout = 768; kind = 3; sc = p.in[7] + layer * 256; woff = W_UQ; break;
      case 4: s0 = p.in[10] + (size_t)layer * 128 * 1024; ldsrc = 1024; K = 128; Nout = 1024; sc = p.in[9] + layer * 128; woff = W_UKV; break;
      case 5: s0 = p.in[12] + (size_t)layer * 2048 * 128; ldsrc = 128; K = 2048; Nout = 128; woff = W_CK1; break;
      case 6: s0 = p.in[14] + (size_t)layer * 128 * 64; ldsrc = 64; K = 128; Nout = 64; woff = W_CK2; break;
      case 7: s0 = p.in[16] + (size_t)layer * 2048 * 128; ldsrc = 128; K = 2048; Nout = 128; woff = W_CV1; break;
      case 8: s0 = p.in[18] + (size_t)layer * 128 * 64; ldsrc = 64; K = 128; Nout = 64; woff = W_CV2; break;
      case 9: s0 = p.in[19] + (size_t)layer * 512 * 1024; ldsrc = 1024; K = 512; Nout = 1024; woff = W_PM; break;
      case 10: s0 = p.in[20] + (size_t)layer * 512 * 1024; ldsrc = 1024; K = 512; Nout = 1024; woff = W_PN; break;
      case 11: s0 = p.in[21] + (size_t)layer * 1024 * 1024; ldsrc = 1024; K = 1024; Nout = 1024; woff = W_OUT; break;
      case 12: s0 = p.in[24] + (size_t)layer * DM * FF; s1 = p.in[25] + (size_t)layer * DM * FF; ldsrc = FF; K = 1024; Nout = 5632; kind = 1; woff = W_UP2; break;
      default: s0 = p.in[26] + (size_t)layer * FF * DM; ldsrc = DM; K = FF; Nout = 1024; woff = W_DN2; break;
    }
    convT(s0, s1, ldsrc, K, Nout, kind, sc, wl + woff, smem);
  }
}

DI void phase_ffn_up(const Params& p, int layer, int which, char* smem) {
  EPI_VARS
  const u16* A = (const u16*)(p.ws + OFF_XB);
  const u16* W = (const u16*)(p.ws + OFF_W) + (size_t)layer * W_LAYER + (which ? W_UP2 : W_UP1);
  u16* H = (u16*)(p.ws + OFF_H);
  const int ntn = 44, ntiles = 256 * ntn;
  for (int tile = blockIdx.x; tile < ntiles; tile += gridDim.x) {
    const int tm = tile / ntn, tn = tile % ntn;
    f32x16 acc[2][2];
    UNROLL for (int a = 0; a < 2; ++a) UNROLL for (int b = 0; b < 2; ++b) zero16(acc[a][b]);
    gemm_main(A + (size_t)tm * 128 * 1024, 1024, W + (size_t)tn * 128 * 1024, 1024, 1024, acc, smem);
    UNROLL for (int mi = 0; mi < 2; ++mi) UNROLL for (int i = 0; i < 16; ++i) {
      const int row = tm * 128 + EROW(mi, i);
      const float g = acc[mi][0][i], u = acc[mi][1][i];
      const float h = g / (1.f + __expf(-g)) * u;
      H[(size_t)row * FF + tn * 64 + wc * 32 + l31] = f2bf(h);
    }
  }
}

DI void phase_resid(const Params& p, const u16* A, int lda, int K, const u16* W, float coef, char* smem) {
  EPI_VARS
  float* X = p.out;
  const int ntn = 8, ntiles = 256 * ntn;
  for (int tile = blockIdx.x; tile < ntiles; tile += gridDim.x) {
    const int tm = tile / ntn, tn = tile % ntn;
    f32x16 acc[2][2];
    UNROLL for (int a = 0; a < 2; ++a) UNROLL for (int b = 0; b < 2; ++b) zero16(acc[a][b]);
    gemm_main(A + (size_t)tm * 128 * lda, lda, W + (size_t)tn * 128 * K, K, K, acc, smem);
    UNROLL for (int mi = 0; mi < 2; ++mi) UNROLL for (int ni = 0; ni < 2; ++ni) UNROLL for (int i = 0; i < 16; ++i) {
      const int row = tm * 128 + EROW(mi, i);
      const size_t idx = (size_t)row * DM + tn * 128 + wc * 64 + ni * 32 + l31;
      if ((i & 3) == 0) asm volatile("" ::: "memory");
      X[idx] = ALPHA * X[idx] + coef * acc[mi][ni][i];
    }
  }
}

DI void phase_ln(const Params& p, const float* g, const float* b) {
  const int tid = ltid(), lane = tid & 63, w = tid >> 6;
  float* X = p.out;
  u16* Xb = (u16*)(p.ws + OFF_XB);
  float4 gv[4], bv[4];
  UNROLL for (int i = 0; i < 4; ++i) {
    gv[i] = *(const float4*)(g + i * 256 + lane * 4);
    bv[i] = *(const float4*)(b + i * 256 + lane * 4);
  }
  for (int row = blockIdx.x * 4 + w; row < M; row += gridDim.x * 4) {
    float4 v[4];
    float s = 0.f;
    UNROLL for (int i = 0; i < 4; ++i) {
      v[i] = *(const float4*)(X + (size_t)row * DM + i * 256 + lane * 4);
      s += v[i].x + v[i].y + v[i].z + v[i].w;
    }
    UNROLL for (int o = 32; o >= 1; o >>= 1) s += __shfl_xor(s, o);
    const float mu = s * (1.f / 1024.f);
    float q = 0.f;
    UNROLL for (int i = 0; i < 4; ++i) {
      v[i].x -= mu; v[i].y -= mu; v[i].z -= mu; v[i].w -= mu;
      q += v[i].x * v[i].x + v[i].y * v[i].y + v[i].z * v[i].z + v[i].w * v[i].w;
    }
    UNROLL for (int o = 32; o >= 1; o >>= 1) q += __shfl_xor(q, o);
    const float rstd = rsqrtf(q * (1.f / 1024.f) + 1e-5f);
    UNROLL for (int i = 0; i < 4; ++i) {
      float4 y;
      y.x = v[i].x * rstd * gv[i].x + bv[i].x;
      y.y = v[i].y * rstd * gv[i].y + bv[i].y;
      y.z = v[i].z * rstd * gv[i].z + bv[i].z;
      y.w = v[i].w * rstd * gv[i].w + bv[i].w;
      *(float4*)(X + (size_t)row * DM + i * 256 + lane * 4) = y;
      u32x2 o;
      o[0] = pk2(y.x, y.y);
      o[1] = pk2(y.z, y.w);
      *(u32x2*)(Xb + (size_t)row * DM + i * 256 + lane * 4) = o;
    }
  }
}

DI void phase_win(const Params& p, int layer, char* smem) {
  EPI_VARS
  const u16* A = (const u16*)(p.ws + OFF_XB);
  const u16* W = (const u16*)(p.ws + OFF_W) + (size_t)layer * W_LAYER + W_IN;
  u16* CQ = (u16*)(p.ws + OFF_CQ);
  u16* CKV = (u16*)(p.ws + OFF_CKV);
  u16* QN = (u16*)(p.ws + OFF_QN);
  u16* KV6 = (u16*)(p.ws + OFF_KV6);
  u16* KPE = (u16*)(p.ws + OFF_KPE);
  float* GATES = (float*)(p.ws + OFF_GATES);
  u16* GM = (u16*)(p.ws + OFF_GM);
  u16* GN = (u16*)(p.ws + OFF_GN);
  const float* COSN = (const float*)(p.ws + OFF_COSN);
  const float* SINN = (const float*)(p.ws + OFF_SINN);
  const float* COSM = (const float*)(p.ws + OFF_COSM);
  const float* SINM = (const float*)(p.ws + OFF_SINM);
  const int ntn = 30, ntiles = 256 * ntn;
  for (int tile = blockIdx.x; tile < ntiles; tile += gridDim.x) {
    const int tm = tile / ntn, tn = tile % ntn;
    f32x16 acc[2][2];
    UNROLL for (int a = 0; a < 2; ++a) UNROLL for (int b = 0; b < 2; ++b) zero16(acc[a][b]);
    gemm_main(A + (size_t)tm * 128 * 1024, 1024, W + (size_t)tn * 128 * 1024, 1024, 1024, acc, smem);
    if (tn < 3) {
      u16* dst = tn < 2 ? CQ : CKV;
      const int ld = tn < 2 ? 256 : 128, cb = tn < 2 ? tn * 128 : 0;
      UNROLL for (int mi = 0; mi < 2; ++mi) UNROLL for (int ni = 0; ni < 2; ++ni) UNROLL for (int i = 0; i < 16; ++i) {
        const int row = tm * 128 + EROW(mi, i);
        dst[(size_t)row * ld + cb + wc * 64 + ni * 32 + l31] = f2bf(acc[mi][ni][i]);
      }
    } else if (tn < 13) {
      const bool isq = tn < 7;
      const int j = tn - 7;
      const bool rope_on = isq || ((j & 1) == 0);
      UNROLL for (int mi = 0; mi < 2; ++mi) UNROLL for (int i = 0; i < 16; ++i) {
        const int row = tm * 128 + EROW(mi, i);
        const int t = row & (T - 1), b = row >> 12;
        float v0 = acc[mi][0][i];
        const float pr = __shfl_xor(v0, 8);
        if (rope_on && l31 < 16) {
          const float cs = COSN[t * 8 + (l31 & 7)], sn = SINN[t * 8 + (l31 & 7)];
          v0 = (l31 < 8) ? (v0 * cs - pr * sn) : (v0 * cs + pr * sn);
        }
        size_t base;
        if (isq) base = (size_t)row * 512 + (2 * (tn - 3) + wc) * 64;
        else base = ((size_t)((j * NB + b) * 2 + wc) * T + t) * 64;
        u16* dst = isq ? QN : KV6;
        dst[base + l31] = f2bf(v0);
        dst[base + 32 + l31] = f2bf(acc[mi][1][i]);
      }
    } else if (tn < 29) {
      u16* dst = tn < 21 ? GM : GN;
      const int cb = (tn < 21 ? tn - 13 : tn - 21) * 128;
      UNROLL for (int mi = 0; mi < 2; ++mi) UNROLL for (int ni = 0; ni < 2; ++ni) UNROLL for (int i = 0; i < 16; ++i) {
        const int row = tm * 128 + EROW(mi, i);
        dst[(size_t)row * 1024 + cb + wc * 64 + ni * 32 + l31] = f2bf(sigmoidf_(acc[mi][ni][i]));
      }
    } else {
      if (wc == 0) {
        UNROLL for (int mi = 0; mi < 2; ++mi) UNROLL for (int i = 0; i < 16; ++i) {
          const int row = tm * 128 + EROW(mi, i);
          const int t = row & (T - 1);
          float v0 = acc[mi][0][i];
          const float pr = __shfl_xor(v0, 16);
          const float cs = COSM[t * 16 + (l31 & 15)], sn = SINM[t * 16 + (l31 & 15)];
          v0 = (l31 < 16) ? (v0 * cs - pr * sn) : (v0 * cs + pr * sn);
          KPE[(size_t)row * 32 + l31] = f2bf(v0);
          if (l31 < 24) GATES[(size_t)row * 24 + l31] = sigmoidf_(acc[mi][1][i]);
        }
      }
    }
  }
}

DI float gelu_tanh(float x) {
  const float u = 0.7978845608028654f * (x + 0.044715f * x * x * x);
  return 0.5f * x * (1.f + tanhf(u));
}

DI void phase_up_cmp(const Params& p, int layer, char* smem) {
  EPI_VARS
  const u16* WL = (const u16*)(p.ws + OFF_W) + (size_t)layer * W_LAYER;
  float* rstd = (float*)(smem + 73728);
  const float* COSM = (const float*)(p.ws + OFF_COSM);
  const float* SINM = (const float*)(p.ws + OFF_SINM);
  const int ntasks = 64 + 1536 + 2048;
  for (int task = blockIdx.x; task < ntasks; task += gridDim.x) {
    f32x16 acc[2][2];
    UNROLL for (int a = 0; a < 2; ++a) UNROLL for (int b = 0; b < 2; ++b) zero16(acc[a][b]);
    if (task < 64) {
      const int kv = task >> 5, bg = (task >> 1) & 15, mt = task & 1;
      const u16* A = (const u16*)(p.ws + OFF_KV6) + ((size_t)(kv * 16 + bg) * T) * 64 + (size_t)mt * 128 * 1024;
      const u16* W1 = WL + (kv ? W_CV1 : W_CK1);
      const u16* W2 = WL + (kv ? W_CV2 : W_CK2);
      const float* bias = (const float*)(p.ws + OFF_BIAS) + (layer * 2 + kv) * 128;
      u16* dst = (u16*)(p.ws + (kv ? OFF_VC : OFF_KC)) + (size_t)bg * 256 * 64;
      gemm_main(A, 1024, W1, 2048, 2048, acc, smem);
      UNROLL for (int mi = 0; mi < 2; ++mi) UNROLL for (int ni = 0; ni < 2; ++ni) UNROLL for (int i = 0; i < 16; ++i) {
        const int r = EROW(mi, i), c = wc * 64 + ni * 32 + l31;
        *(u16*)(smem + r * 272 + c * 2) = f2bf(gelu_tanh(acc[mi][ni][i] + bias[c]));
      }
      __syncthreads();
      f32x16 a2[2];
      zero16(a2[0]);
      zero16(a2[1]);
      UNROLL for (int ks = 0; ks < 8; ++ks) {
        bf16x8 af = *(const bf16x8*)(smem + (32 * w + l31) * 272 + ks * 32 + hh * 16);
        bf16x8 b0 = *(const bf16x8*)(W2 + (size_t)(l31) * 128 + ks * 16 + hh * 8);
        bf16x8 b1 = *(const bf16x8*)(W2 + (size_t)(32 + l31) * 128 + ks * 16 + hh * 8);
        a2[0] = MFMA(af, b0, a2[0]);
        a2[1] = MFMA(af, b1, a2[1]);
      }
      UNROLL for (int ni = 0; ni < 2; ++ni) UNROLL for (int i = 0; i < 16; ++i) {
        const int c = mt * 128 + 32 * w + 8 * (i >> 2) + 4 * hh + (i & 3);
        dst[(size_t)c * 64 + ni * 32 + l31] = (c == 255) ? (u16)0 : f2bf(a2[ni][i]);
      }
      __syncthreads();
    } else if (task < 64 + 1536) {
      const int tt = task - 64, tm = tt / 6, tn = tt % 6;
      const u16* A = (const u16*)(p.ws + OFF_CQ) + (size_t)tm * 128 * 256;
      {
        const int r = tid >> 1, hf = tid & 1;
        const u16* ar = A + (size_t)r * 256 + hf * 128;
        float ss = 0.f;
        UNROLL for (int c = 0; c < 16; ++c) {
          u32x4 v = *(const u32x4*)(ar + c * 8);
          UNROLL for (int e = 0; e < 4; ++e) {
            const float lo = __uint_as_float(v[e] << 16), hi = __uint_as_float(v[e] & 0xffff0000u);
            ss += lo * lo + hi * hi;
          }
        }
        ss += __shfl_xor(ss, 1);
        if (hf == 0) rstd[r] = rsqrtf(ss * (1.f / 256.f) + 1e-6f);
      }
      gemm_main(A, 256, WL + W_UQ + (size_t)tn * 128 * 256, 256, 256, acc, smem);
      u16* QM = (u16*)(p.ws + OFF_QM);
      UNROLL for (int mi = 0; mi < 2; ++mi) UNROLL for (int ni = 0; ni < 2; ++ni) UNROLL for (int i = 0; i < 16; ++i) {
        const int r = EROW(mi, i), row = tm * 128 + r;
        float v = acc[mi][ni][i] * rstd[r];
        const float pr = __shfl_xor(v, 16);
        if (tn >= 4) {
          const int t = row & (T - 1);
          const float cs = COSM[t * 16 + (l31 & 15)], sn = SINM[t * 16 + (l31 & 15)];
          v = (l31 < 16) ? (v * cs - pr * sn) : (v * cs + pr * sn);
        }
        QM[(size_t)row * 768 + tn * 128 + wc * 64 + ni * 32 + l31] = f2bf(v);
      }
      __syncthreads();
    } else {
      const int tt = task - 64 - 1536, tm = tt >> 3, tn = tt & 7;
      const u16* A = (const u16*)(p.ws + OFF_CKV) + (size_t)tm * 128 * 128;
      {
        const int r = tid >> 1, hf = tid & 1;
        const u16* ar = A + (size_t)r * 128 + hf * 64;
        float ss = 0.f;
        UNROLL for (int c = 0; c < 8; ++c) {
          u32x4 v = *(const u32x4*)(ar + c * 8);
          UNROLL for (int e = 0; e < 4; ++e) {
            const float lo = __uint_as_float(v[e] << 16), hi = __uint_as_float(v[e] & 0xffff0000u);
            ss += lo * lo + hi * hi;
          }
        }
        ss += __shfl_xor(ss, 1);
        if (hf == 0) rstd[r] = rsqrtf(ss * (1.f / 128.f) + 1e-6f);
      }
      gemm_main(A, 128, WL + W_UKV + (size_t)tn * 128 * 128, 128, 128, acc, smem);
      u16* dst = (u16*)(p.ws + (wc == 0 ? OFF_KM : OFF_VM));
      UNROLL for (int mi = 0; mi < 2; ++mi) UNROLL for (int ni = 0; ni < 2; ++ni) UNROLL for (int i = 0; i < 16; ++i) {
        const int r = EROW(mi, i), row = tm * 128 + r;
        const int t = row & (T - 1), b = row >> 12;
        dst[((size_t)(b * 8 + tn) * T + t) * 64 + ni * 32 + l31] = f2bf(acc[mi][ni][i] * rstd[r]);
      }
      __syncthreads();
    }
  }
}

template <int NKS, int KSTR, int MODE, int NREG>
DI void attn_tile(const char* sK, const char* sV, const bf16x8 (&qf)[2][4], const char* qlds, f32x16 (&o)[2][2],
                  float (&mrun)[2], float (&lrun)[2], float sl2, int lane, int kbase, const int (&tq)[2],
                  bool need_mask, const bool (&selb)[2]) {
  const int hh = lane >> 5, r = lane & 31;
  const int blk = (lane >> 4) & 1, q4 = (lane & 15) >> 2, p4 = lane & 3;
  const int sw = (q4 >> 1) & 1;
  UNROLL for (int kt2 = 0; kt2 < 2; ++kt2) {
    f32x16 s[2];
    zero16(s[0]);
    zero16(s[1]);
    {
      const char* pk = sK + (32 * kt2 + r) * KSTR + hh * 16;
      UNROLL for (int ks = 0; ks < NKS; ++ks) {
        bf16x8 kf = *(const bf16x8*)(pk + ks * 32);
        if (ks >= NREG) {
          const bf16x8 q0 = *(const bf16x8*)(qlds + (ks - NREG) * 1024);
          const bf16x8 q1 = *(const bf16x8*)(qlds + (NKS - NREG + ks - NREG) * 1024);
          s[0] = MFMA(kf, q0, s[0]);
          s[1] = MFMA(kf, q1, s[1]);
        } else {
          s[0] = MFMA(kf, qf[0][ks < 4 ? ks : 0], s[0]);
          s[1] = MFMA(kf, qf[1][ks < 4 ? ks : 0], s[1]);
        }
      }
    }
    UNROLL for (int qt = 0; qt < 2; ++qt) {
      float mx = NEGF;
      if (need_mask) {
        const int lim = tq[qt] - kbase - 4 * hh;
        UNROLL for (int i = 0; i < 16; ++i) {
          const int kc = 32 * kt2 + 8 * (i >> 2) + (i & 3);
          bool ok = kc <= lim;
          if (MODE == 2) ok = ok && (kc > lim - 512);
          if (MODE == 1) ok = ok && selb[qt];
          const float x = ok ? s[qt][i] * sl2 : NEGF;
          s[qt][i] = x;
          mx = fmaxf(mx, x);
        }
      } else {
        UNROLL for (int i = 0; i < 16; ++i) {
          float x = s[qt][i] * sl2;
          if (MODE == 1) x = selb[qt] ? x : NEGF;
          s[qt][i] = x;
          mx = fmaxf(mx, x);
        }
      }
      mx = fmaxf(mx, __shfl_xor(mx, 32));
      const float mnew = fmaxf(mrun[qt], mx);
      const float alpha = ex2(mrun[qt] - mnew);
      mrun[qt] = mnew;
      float ls = 0.f;
      UNROLL for (int i = 0; i < 16; ++i) {
        const float pv = ex2(s[qt][i] - mnew);
        s[qt][i] = pv;
        ls += pv;
      }
      lrun[qt] = lrun[qt] * alpha + ls;
      UNROLL for (int dt = 0; dt < 2; ++dt) UNROLL for (int i = 0; i < 16; ++i) o[qt][dt][i] *= alpha;
    }
    UNROLL for (int st = 0; st < 2; ++st) {
      const bf16x8 pf0 = pack8(s[0], st), pf1 = pack8(s[1], st);
      const int key0 = 32 * kt2 + 16 * st + 4 * hh + q4;
      UNROLL for (int dt = 0; dt < 2; ++dt) {
        const char* pv = sV + key0 * 128 + ((dt ^ sw) * 64) + (16 * blk + 4 * p4) * 2;
        const s16x4 lo = tr_read(pv), hi = tr_read(pv + 8 * 128);
        const bf16x8 vf = __builtin_shufflevector(lo, hi, 0, 1, 2, 3, 4, 5, 6, 7);
        o[0][dt] = MFMA(vf, pf0, o[0][dt]);
        o[1][dt] = MFMA(vf, pf1, o[1][dt]);
      }
    }
  }
}

DI void mla_task(const Params& p, int task, char* smem) {
  const int tid = ltid(), lane = tid & 63, w = tid >> 6, l31 = lane & 31, hh = lane >> 5;
  const int qb = 15 - (task >> 6), bh = task & 63, b = bh >> 3, h = bh & 7;
  const int q0 = qb * 256;
  u16* QM = (u16*)(p.ws + OFF_QM);
  const u16* KM = (const u16*)(p.ws + OFF_KM) + (size_t)bh * T * 64;
  const u16* VM = (const u16*)(p.ws + OFF_VM) + (size_t)bh * T * 64;
  const u16* KPE = (const u16*)(p.ws + OFF_KPE) + (size_t)b * T * 32;
  bf16x8 qf[2][4];
  int tq[2];
  const char* qlds = smem + 43008 + w * 4096 + lane * 16;
  UNROLL for (int qt = 0; qt < 2; ++qt) {
    tq[qt] = q0 + 64 * w + 32 * qt + l31;
    const u16* base = QM + (size_t)(b * T + tq[qt]) * 768;
    UNROLL for (int ks = 0; ks < 4; ++ks) qf[qt][ks] = *(const bf16x8*)(base + h * 64 + 16 * ks + 8 * hh);
    UNROLL for (int ks = 0; ks < 2; ++ks)
      *(bf16x8*)(smem + 43008 + w * 4096 + lane * 16 + (qt * 2 + ks) * 1024) = *(const bf16x8*)(base + 512 + h * 32 + 16 * ks + 8 * hh);
  }
  f32x16 o[2][2];
  UNROLL for (int a = 0; a < 2; ++a) UNROLL for (int c = 0; c < 2; ++c) zero16(o[a][c]);
  float mrun[2] = {NEGF, NEGF}, lrun[2] = {0.f, 0.f};
  const bool selb[2] = {true, true};
  const float sl2 = 0.10206207261596575f * LOG2E;
  const int nkt = (q0 >> 6) + 4, my_last = (q0 >> 6) + w;
  u32x4 rk[3], rv[2];
  const unsigned offa = (unsigned)tid * 16u;
  const unsigned offp = (unsigned)tid * 16u;
  auto gload = [&](int kt) {
    const char* kb = (const char*)(KM + (size_t)kt * 4096);
    const char* vb = (const char*)(VM + (size_t)kt * 4096);
    const char* pb = (const char*)(KPE + (size_t)kt * 2048);
    rk[0] = *(const u32x4*)(kb + offa);
    rk[1] = *(const u32x4*)(kb + offa + 4096u);
    rk[2] = *(const u32x4*)(pb + offp);
    rv[0] = *(const u32x4*)(vb + offa);
    rv[1] = *(const u32x4*)(vb + offa + 4096u);
  };
  auto sstore = [&](int s) {
    UNROLL for (int i = 0; i < 2; ++i) {
      const int c = tid + 256 * i, key = c >> 3, ch = c & 7;
      *(u32x4*)(smem + s * 13312 + key * 208 + ch * 16) = rk[i];
      *(u32x4*)(smem + 26624 + s * 8192 + key * 128 + ((ch ^ (4 * ((key >> 1) & 1))) * 16)) = rv[i];
    }
    *(u32x4*)(smem + s * 13312 + (tid >> 2) * 208 + 128 + (tid & 3) * 16) = rk[2];
  };
  gload(0);
  sstore(0);
  __syncthreads();
  _Pragma("unroll 1") for (int kt = 0; kt < nkt; ++kt) {
    const bool more = kt + 1 < nkt;
    if (more) gload(kt + 1);
    if (kt <= my_last) {
      const bool need_mask = (64 * kt + 63 > q0 + 64 * w);
      attn_tile<6, 208, 0, 4>(smem + (kt & 1) * 13312, smem + 26624 + (kt & 1) * 8192, qf, qlds, o, mrun, lrun, sl2, lane,
                           64 * kt, tq, need_mask, selb);
    }
    if (more) sstore((kt + 1) & 1);
    __syncthreads();
  }
  UNROLL for (int qt = 0; qt < 2; ++qt) {
    const float lt = lrun[qt] + __shfl_xor(lrun[qt], 32);
    const float inv = 1.f / lt;
    u16* dst = QM + (size_t)(b * T + tq[qt]) * 768 + h * 64;
    UNROLL for (int dt = 0; dt < 2; ++dt) UNROLL for (int g4 = 0; g4 < 4; ++g4) {
      u32x2 v;
      v[0] = pk2(o[qt][dt][4 * g4 + 0] * inv, o[qt][dt][4 * g4 + 1] * inv);
      v[1] = pk2(o[qt][dt][4 * g4 + 2] * inv, o[qt][dt][4 * g4 + 3] * inv);
      *(u32x2*)(dst + 32 * dt + 8 * g4 + 4 * hh) = v;
    }
  }
}

template <int MODE>
DI void nsa_flash(const u16* __restrict__ Kg, const u16* __restrict__ Vg, int kt_lo, int kt_hi, int cur,
                  f32x16 (&o)[2][2], float (&mrun)[2], float (&lrun)[2], float sl2,
                  const int (&tq)[2], char* smem) {
  const bf16x8 qdummy[2][4] = {};
  const char* qlds = smem + 36864 + (ltid() >> 6) * 8192 + (ltid() & 63) * 16;
  const int tid = ltid(), lane = tid & 63;
  const unsigned* selw = (const unsigned*)(smem + 69632 + 8192);
  u32x4 rk[2], rv[2];
  const unsigned offa = (unsigned)tid * 16u;
  auto gload = [&](int kt) {
    const char* kb = (const char*)(Kg + (size_t)kt * 4096);
    const char* vb = (const char*)(Vg + (size_t)kt * 4096);
    rk[0] = *(const u32x4*)(kb + offa);
    rk[1] = *(const u32x4*)(kb + offa + 4096u);
    rv[0] = *(const u32x4*)(vb + offa);
    rv[1] = *(const u32x4*)(vb + offa + 4096u);
  };
  auto sstore = [&](int s) {
    UNROLL for (int i = 0; i < 2; ++i) {
      const int c = tid + 256 * i, key = c >> 3, ch = c & 7;
      *(u32x4*)(smem + s * 9216 + key * 144 + ch * 16) = rk[i];
      *(u32x4*)(smem + 18432 + s * 8192 + key * 128 + ((ch ^ (4 * ((key >> 1) & 1))) * 16)) = rv[i];
    }
  };
  gload(kt_lo);
  sstore(0);
  __syncthreads();
  _Pragma("unroll 1") for (int kt = kt_lo; kt <= kt_hi; ++kt) {
    const int s = (kt - kt_lo) & 1;
    const bool more = kt < kt_hi;
    if (more) gload(kt + 1);
    bool selb[2] = {true, true};
    if (MODE == 1) {
      selb[0] = (selw[(tq[0] & 63) * 2 + (kt >> 5)] >> (kt & 31)) & 1u;
      selb[1] = (selw[(tq[1] & 63) * 2 + (kt >> 5)] >> (kt & 31)) & 1u;
    }
    const bool need_mask = (kt == cur) || (MODE == 2 && kt == cur - 8);
    attn_tile<4, 144, MODE, 0>(smem + s * 9216, smem + 18432 + s * 8192, qdummy, qlds, o, mrun, lrun, sl2, lane,
                                  64 * kt, tq, need_mask, selb);
    if (more) sstore(s ^ 1);
    __syncthreads();
  }
}

DI void nsa_task(const Params& p, int task, char* smem) {
  const int tid = ltid(), lane = tid & 63, w = tid >> 6, l31 = lane & 31, hh = lane >> 5;
  const int cur = 63 - (task >> 4), bg = task & 15, b = bg >> 1, g = bg & 1;
  u16* QN = (u16*)(p.ws + OFF_QN);
  const u16* KV6 = (const u16*)(p.ws + OFF_KV6);
  const float* GATES = (const float*)(p.ws + OFF_GATES);
  const u16* KC = (const u16*)(p.ws + OFF_KC) + (size_t)bg * 256 * 64;
  const u16* VC = (const u16*)(p.ws + OFF_VC) + (size_t)bg * 256 * 64;
  const int head = 4 * g + (l31 & 3);
  bf16x8 qf[2][4];
  int tq[2];
  UNROLL for (int qt = 0; qt < 2; ++qt) {
    tq[qt] = 64 * cur + 16 * w + 8 * qt + (l31 >> 2);
    const u16* base = QN + (size_t)(b * T + tq[qt]) * 512 + head * 64;
    UNROLL for (int ks = 0; ks < 4; ++ks) qf[qt][ks] = *(const bf16x8*)(base + 16 * ks + 8 * hh);
  }
  const float sl2 = 0.125f * LOG2E;
  unsigned long long* selm = (unsigned long long*)(smem + 69632 + 8192);
  char* R1 = smem;
  char* R2 = smem + 36864;
  float* impw = (float*)(smem + 69632) + w * 512;
  {
    UNROLL for (int i = 0; i < 8; ++i) {
      const int c = tid + 256 * i, key = c >> 3, ch = c & 7;
      u32x4 kk = *(const u32x4*)(KC + (size_t)c * 8);
      u32x4 vv = *(const u32x4*)(VC + (size_t)c * 8);
      *(u32x4*)(R1 + (key >> 6) * 9216 + (key & 63) * 144 + ch * 16) = kk;
      *(u32x4*)(R2 + (key >> 6) * 8192 + (key & 63) * 128 + ((ch ^ (4 * ((key >> 1) & 1))) * 16)) = vv;
    }
    __syncthreads();
    const int blk = (lane >> 4) & 1, q4 = (lane & 15) >> 2, p4 = lane & 3, sw = (q4 >> 1) & 1;
    UNROLL for (int qt = 0; qt < 2; ++qt) {
      const int cmh = ((tq[qt] - 31) >> 4) - 4 * hh;
      float mx = NEGF, lsum = 0.f;
      UNROLL for (int a = 0; a < 8; ++a) {
        f32x16 sa;
        zero16(sa);
        const char* pk = R1 + (a >> 1) * 9216 + (32 * (a & 1) + l31) * 144 + hh * 16;
        UNROLL for (int ks = 0; ks < 4; ++ks) {
          bf16x8 kf = *(const bf16x8*)(pk + ks * 32);
          sa = MFMA(kf, qf[qt][ks], sa);
        }
        float tm = NEGF;
        UNROLL for (int i = 0; i < 16; ++i) {
          const int c = 32 * a + 8 * (i >> 2) + (i & 3);
          const float x = (c <= cmh) ? sa[i] * sl2 : NEGF;
          sa[i] = x;
          tm = fmaxf(tm, x);
        }
        const float mnew = fmaxf(mx, tm);
        float ts = 0.f;
        UNROLL for (int i = 0; i < 16; ++i) ts += ex2(sa[i] - mnew);
        lsum = lsum * ex2(mx - mnew) + ts;
        mx = mnew;
        __builtin_amdgcn_sched_barrier(0);
      }
      {
        const float mo = __shfl_xor(mx, 32), lo = __shfl_xor(lsum, 32);
        const float mt = fmaxf(mx, mo);
        lsum = lsum * ex2(mx - mt) + lo * ex2(mo - mt);
        mx = mt;
      }
      const float inv = (mx > -1e29f) ? 1.f / lsum : 0.f;
      float lastprev = 0.f;
      f32x16 oc[2];
      zero16(oc[0]);
      zero16(oc[1]);
      UNROLL for (int a = 0; a < 8; ++a) {
        f32x16 sa;
        zero16(sa);
        const char* pk = R1 + (a >> 1) * 9216 + (32 * (a & 1) + l31) * 144 + hh * 16;
        UNROLL for (int ks = 0; ks < 4; ++ks) {
          bf16x8 kf = *(const bf16x8*)(pk + ks * 32);
          sa = MFMA(kf, qf[qt][ks], sa);
        }
        UNROLL for (int i = 0; i < 16; ++i) {
          const int c = 32 * a + 8 * (i >> 2) + (i & 3);
          sa[i] = (c <= cmh) ? ex2(sa[i] * sl2 - mx) * inv : 0.f;
        }
        UNROLL for (int q = 0; q < 4; ++q) {
          const int gi = 4 * a + q;
          const float g4 = sa[4 * q] + sa[4 * q + 1] + sa[4 * q + 2] + sa[4 * q + 3];
          const float lastcur = sa[4 * q + 3];
          const float tosend = hh ? lastprev : lastcur;
          const float recv = __shfl_xor(tosend, 32);
          float im = g4 + recv;
          im += __shfl_xor(im, 1);
          im += __shfl_xor(im, 2);
          if ((l31 & 3) == (gi & 3)) impw[(l31 >> 2) * 64 + 2 * gi + hh] = im;
          lastprev = lastcur;
        }
        UNROLL for (int st = 0; st < 2; ++st) {
          const bf16x8 pf = pack8(sa, st);
          const int key0 = 32 * (a & 1) + 16 * st + 4 * hh + q4;
          UNROLL for (int dt = 0; dt < 2; ++dt) {
            const char* pv = R2 + (a >> 1) * 8192 + key0 * 128 + ((dt ^ sw) * 64) + (16 * blk + 4 * p4) * 2;
            const s16x4 lo = tr_read(pv), hi = tr_read(pv + 8 * 128);
            const bf16x8 vf = __builtin_shufflevector(lo, hi, 0, 1, 2, 3, 4, 5, 6, 7);
            oc[dt] = MFMA(vf, pf, oc[dt]);
          }
        }
        __builtin_amdgcn_sched_barrier(0);
      }
      __syncthreads();
      if (cur >= 16) {
        _Pragma("unroll 1") for (int t8 = 0; t8 < 8; ++t8) {
          float v = impw[t8 * 64 + lane];
          const int j = lane;
          if (j == 0 || j == cur || j == cur - 1) v = 1e30f;
          else if (j > cur) v = NEGF;
          int rank = 0;
          UNROLL for (int jp = 0; jp < 64; ++jp) {
            const float vp = __int_as_float(__builtin_amdgcn_readlane(__float_as_int(v), jp));
            rank += ((vp > v) || (vp == v && jp < j)) ? 1 : 0;
          }
          const unsigned long long mk = __ballot(rank < 16);
          if (lane == 0) selm[16 * w + 8 * qt + t8] = mk;
        }
      } else {
        if (lane < 8) selm[16 * w + 8 * qt + lane] = ~0ull;
      }
      __syncthreads();
      int zq = 0;
      asm volatile("" : "+v"(zq));
      const int rowq = b * T + tq[qt] + zq;
      const float g0 = GATES[(size_t)rowq * 24 + head * 3 + 0];
      u16* dst = QN + (size_t)rowq * 512 + head * 64;
      UNROLL for (int dt = 0; dt < 2; ++dt) UNROLL for (int g4 = 0; g4 < 4; ++g4) {
        u32x2 v;
        v[0] = pk2(oc[dt][4 * g4 + 0] * g0, oc[dt][4 * g4 + 1] * g0);
        v[1] = pk2(oc[dt][4 * g4 + 2] * g0, oc[dt][4 * g4 + 3] * g0);
        *(u32x2*)(dst + 32 * dt + 8 * g4 + 4 * hh) = v;
      }
    }
    __syncthreads();
  }
  {
    char* qdst = smem + 36864 + w * 8192 + lane * 16;
    UNROLL for (int qt = 0; qt < 2; ++qt) UNROLL for (int ks = 0; ks < 4; ++ks) *(bf16x8*)(qdst + (qt * 4 + ks) * 1024) = qf[qt][ks];
  }
  __syncthreads();
  UNROLL for (int br = 1; br <= 2; ++br) {
    f32x16 o[2][2];
    UNROLL for (int a = 0; a < 2; ++a) UNROLL for (int c = 0; c < 2; ++c) zero16(o[a][c]);
    float mrun[2] = {NEGF, NEGF}, lrun[2] = {0.f, 0.f};
    const u16* Kg = KV6 + ((size_t)((2 * br) * 16 + bg) * T) * 64;
    const u16* Vg = KV6 + ((size_t)((2 * br + 1) * 16 + bg) * T) * 64;
    if (br == 1) nsa_flash<1>(Kg, Vg, 0, cur, cur, o, mrun, lrun, sl2, tq, smem);
    else nsa_flash<2>(Kg, Vg, cur > 8 ? cur - 8 : 0, cur, cur, o, mrun, lrun, sl2, tq, smem);
    UNROLL for (int qt = 0; qt < 2; ++qt) {
      const float lt = lrun[qt] + __shfl_xor(lrun[qt], 32);
      int zq = 0;
      asm volatile("" : "+v"(zq));
      const int rowq = b * T + tq[qt] + zq;
      const float gt = GATES[(size_t)rowq * 24 + head * 3 + br];
      const float inv = gt / lt;
      u16* dst = QN + (size_t)rowq * 512 + head * 64;
      UNROLL for (int dt = 0; dt < 2; ++dt) UNROLL for (int g4 = 0; g4 < 4; ++g4) {
        u32x2* pd = (u32x2*)(dst + 32 * dt + 8 * g4 + 4 * hh);
        const u32x2 old = *pd;
        u32x2 v;
        v[0] = pk2(o[qt][dt][4 * g4 + 0] * inv + __uint_as_float(old[0] << 16),
                   o[qt][dt][4 * g4 + 1] * inv + __uint_as_float(old[0] & 0xffff0000u));
        v[1] = pk2(o[qt][dt][4 * g4 + 2] * inv + __uint_as_float(old[1] << 16),
                   o[qt][dt][4 * g4 + 3] * inv + __uint_as_float(old[1] & 0xffff0000u));
        *pd = v;
      }
    }
  }
}

DI void phase_attn(const Params& p, int layer, char* smem) {
  int* cnt = (int*)(p.ws + OFF_CNT) + layer;
  int* s_task = (int*)(smem + 69632 + 8192 + 512);
  for (;;) {
    if (ltid() == 0) *s_task = atomicAdd(cnt, 1);
    __syncthreads();
    const int task = *s_task;
    __syncthreads();
    if (task >= 2048) break;
    if (task < 1024) mla_task(p, task, smem);
    else nsa_task(p, task - 1024, smem);
  }
}

DI void phase_proj(const Params& p, int layer, char* smem) {
  EPI_VARS
  const u16* WL = (const u16*)(p.ws + OFF_W) + (size_t)layer * W_LAYER;
  const u16* OM = (const u16*)(p.ws + OFF_QM);
  const u16* ON = (const u16*)(p.ws + OFF_QN);
  u16* GM = (u16*)(p.ws + OFF_GM);
  const u16* GN = (const u16*)(p.ws + OFF_GN);
  const int ntn = 8, ntiles = 256 * ntn;
  for (int tile = blockIdx.x; tile < ntiles; tile += gridDim.x) {
    const int tm = tile / ntn, tn = tile % ntn;
    f32x16 acc[2][2];
    UNROLL for (int a = 0; a < 2; ++a) UNROLL for (int b = 0; b < 2; ++b) zero16(acc[a][b]);
    gemm_main(OM + (size_t)tm * 128 * 768, 768, WL + W_PM + (size_t)tn * 128 * 512, 512, 512, acc, smem);
    {
      int z1 = 0;
      asm volatile("" : "+v"(z1)::"memory");
      UNROLL for (int mi = 0; mi < 2; ++mi) UNROLL for (int ni = 0; ni < 2; ++ni) UNROLL for (int i = 0; i < 16; ++i) {
        if ((i & 3) == 0) asm volatile("" ::: "memory");
        const int row = tm * 128 + EROW(mi, i) + z1;
        const size_t idx = (size_t)row * 1024 + tn * 128 + wc * 64 + ni * 32 + l31;
        acc[mi][ni][i] *= bf2f(GM[idx]) * __builtin_amdgcn_rcpf(bf2f(GN[idx]));
      }
    }
    gemm_main(ON + (size_t)tm * 128 * 512, 512, WL + W_PN + (size_t)tn * 128 * 512, 512, 512, acc, smem);
    int z2 = 0;
    asm volatile("" : "+v"(z2)::"memory");
    UNROLL for (int mi = 0; mi < 2; ++mi) UNROLL for (int ni = 0; ni < 2; ++ni) UNROLL for (int i = 0; i < 16; ++i) {
      const int row = tm * 128 + EROW(mi, i) + z2;
      const size_t idx = (size_t)row * 1024 + tn * 128 + wc * 64 + ni * 32 + l31;
      if ((i & 3) == 0) asm volatile("" ::: "memory");
      const float y = bf2f(GN[idx]) * acc[mi][ni][i];
      GM[idx] = f2bf(y);
    }
  }
}

#define GSYNC grid.sync()
#define LAYER(layer)                                                                                              \
  {                                                                                                               \
    const u16* WL = (const u16*)(p.ws + OFF_W) + (size_t)(layer) * W_LAYER;                                       \
    phase_ffn_up(p, layer, 0, smem); GSYNC;                                                                       \
    phase_resid(p, (const u16*)(p.ws + OFF_H), FF, FF, WL + W_DN1, 0.5f, smem); GSYNC;                            \
    phase_ln(p, p.in[1] + (layer) * DM, p.in[2] + (layer) * DM); GSYNC;                                           \
    phase_win(p, layer, smem); GSYNC;                                                                             \
    phase_up_cmp(p, layer, smem); GSYNC;                                                                          \
    phase_attn(p, layer, smem); GSYNC;                                                                            \
    phase_proj(p, layer, smem); GSYNC;                                                                            \
    phase_resid(p, (const u16*)(p.ws + OFF_GM), 1024, 1024, WL + W_OUT, 1.0f, smem); GSYNC;                       \
    phase_ln(p, p.in[22] + (layer) * DM, p.in[23] + (layer) * DM); GSYNC;                                         \
    phase_ffn_up(p, layer, 1, smem); GSYNC;                                                                       \
    phase_resid(p, (const u16*)(p.ws + OFF_H), FF, FF, WL + W_DN2, 0.5f, smem); GSYNC;                            \
    phase_ln(p, p.in[27] + (layer) * DM, p.in[28] + (layer) * DM);                                                \
  }

__global__ void __launch_bounds__(256, 2) mega(Params p) {
  __shared__ __attribute__((aligned(16))) char smem[SMEM_BYTES];
  cg::grid_group grid = cg::this_grid();
  phase_init(p, smem);
  GSYNC;
  LAYER(0)
  GSYNC;
  LAYER(1)
}

extern "C" void kernel_launch(void* const* d_in, const int* in_sizes, int n_in, void* d_out, int out_size, void* d_ws,
                              size_t ws_size, hipStream_t stream) {
  Params p{};
  for (int i = 0; i < 29; ++i) p.in[i] = (const float*)d_in[i];
  p.out = (float*)d_out;
  p.ws = (char*)d_ws;
  if (ws_size < WS_NEED) fprintf(stderr, "workspace too small: %zu < %zu\n", ws_size, (size_t)WS_NEED);
  static int grid_blocks = 0;
  if (!grid_blocks) {
    int dev = 0, cus = 0, per_cu = 0;
    hipGetDevice(&dev);
    hipDeviceGetAttribute(&cus, hipDeviceAttributeMultiprocessorCount, dev);
    hipOccupancyMaxActiveBlocksPerMultiprocessor(&per_cu, mega, 256, 0);
    if (per_cu < 1) per_cu = 1;
    if (per_cu > 2) per_cu = 2;
    grid_blocks = cus * per_cu;
  }
  void* args[] = {&p};
  hipError_t e = hipLaunchCooperativeKernel((void*)mega, dim3(grid_blocks), dim3(256), args, 0, stream);
  if (e != hipSuccess) fprintf(stderr, "cooperative launch failed: %s (grid %d)\n", hipGetErrorString(e), grid_blocks);
}
```

```cpp
#include <hip/hip_runtime.h>
#include <hip/hip_cooperative_groups.h>
#include <stdint.h>
#include <stdio.h>
namespace cg = cooperative_groups;

#ifndef MULTI
#define MULTI 0
#endif

typedef unsigned short u16;
typedef __attribute__((ext_vector_type(8))) short bf16x8;
typedef __attribute__((ext_vector_type(4))) short s16x4;
typedef __attribute__((ext_vector_type(16))) float f32x16;
typedef __attribute__((ext_vector_type(4))) unsigned u32x4;
typedef __attribute__((ext_vector_type(2))) unsigned u32x2;
typedef __attribute__((ext_vector_type(2))) __bf16 bf2_t;
#define DI __device__ __forceinline__
#define MFMA(a, b, c) __builtin_amdgcn_mfma_f32_32x32x16_bf16((a), (b), (c), 0, 0, 0)
#define UNROLL _Pragma("unroll")

constexpr int NB = 8, T = 4096, DM = 1024, M = NB * T, FF = 2816;
constexpr float ALPHA = 1.4142135623730951f;
constexpr float NEGF = -1e30f;
constexpr float NEGR = -30000.f;
constexpr float LOG2E = 1.4426950408889634f;

constexpr size_t W_UP1 = 0;
constexpr size_t W_DN1 = W_UP1 + (size_t)5632 * 1024;
constexpr size_t W_IN = W_DN1 + (size_t)1024 * 2816;
constexpr size_t W_UQ = W_IN + (size_t)3840 * 1024;
constexpr size_t W_UKV = W_UQ + (size_t)768 * 256;
constexpr size_t W_CK1 = W_UKV + (size_t)1024 * 128;
constexpr size_t W_CK2 = W_CK1 + (size_t)128 * 2048;
constexpr size_t W_CV1 = W_CK2 + (size_t)64 * 128;
constexpr size_t W_CV2 = W_CV1 + (size_t)128 * 2048;
constexpr size_t W_PM = W_CV2 + (size_t)64 * 128;
constexpr size_t W_PN = W_PM + (size_t)1024 * 512;
constexpr size_t W_OUT = W_PN + (size_t)1024 * 512;
constexpr size_t W_UP2 = W_OUT + (size_t)1024 * 1024;
constexpr size_t W_DN2 = W_UP2 + (size_t)5632 * 1024;
constexpr size_t W_LAYER = W_DN2 + (size_t)1024 * 2816;

constexpr size_t al256(size_t x) { return (x + 255) & ~(size_t)255; }
constexpr size_t OFF_W = 0;
constexpr size_t OFF_BIAS = al256(OFF_W + 2 * W_LAYER * 2);
constexpr size_t OFF_COSN = al256(OFF_BIAS + 2 * 2 * 128 * 4);
constexpr size_t OFF_SINN = OFF_COSN + (size_t)T * 8 * 4;
constexpr size_t OFF_COSM = OFF_SINN + (size_t)T * 8 * 4;
constexpr size_t OFF_SINM = OFF_COSM + (size_t)T * 16 * 4;
constexpr size_t OFF_CNT = OFF_SINM + (size_t)T * 16 * 4;
constexpr size_t OFF_BAR = al256(OFF_CNT + 256);
constexpr size_t OFF_PART = al256(OFF_BAR + 3456 * 4);
constexpr size_t OFF_XB = al256(OFF_PART + (size_t)4 * 128 * 128 * 4);
constexpr size_t OFF_KM = OFF_XB;
constexpr size_t OFF_VM = OFF_XB + (size_t)M * 512 * 2;
constexpr size_t OFF_BIG = al256(OFF_XB + (size_t)M * 1024 * 2);
constexpr size_t OFF_H = OFF_BIG;
constexpr size_t OFF_CQ = OFF_BIG;
constexpr size_t OFF_CKV = OFF_CQ + (size_t)M * 256 * 2;
constexpr size_t OFF_QN = OFF_CKV + (size_t)M * 128 * 2;
constexpr size_t OFF_KV6 = OFF_QN + (size_t)M * 512 * 2;
constexpr size_t OFF_KPE = OFF_KV6 + (size_t)6 * M * 128 * 2;
constexpr size_t OFF_GATES = OFF_KPE + (size_t)M * 32 * 2;
constexpr size_t OFF_QM = OFF_GATES + (size_t)M * 24 * 4;
constexpr size_t OFF_GM = OFF_QM + (size_t)M * 768 * 2;
constexpr size_t OFF_GN = OFF_GM + (size_t)M * 1024 * 2;
constexpr size_t OFF_KC = OFF_GN + (size_t)M * 1024 * 2;
constexpr size_t OFF_VC = OFF_KC + (size_t)16 * 256 * 64 * 2;
constexpr size_t OFF_OM = al256(OFF_VC + (size_t)16 * 256 * 64 * 2 + 65536);
constexpr size_t OFF_ON = OFF_OM + (size_t)M * 512 * 2;
constexpr size_t OFF_MIXEND = OFF_ON + (size_t)M * 512 * 2;
constexpr size_t OFF_HEND = OFF_H + (size_t)M * FF * 2;
constexpr size_t WS_NEED = OFF_MIXEND > OFF_HEND ? OFF_MIXEND : OFF_HEND;

constexpr int VSMEM = 69632 + 8192 + 512;
constexpr int SMEM_BYTES = 2 * VSMEM + 64;

struct Params {
  const float* in[29];
  float* out;
  char* ws;
};

DI int ltid() {
  int t = __builtin_amdgcn_workitem_id_x() & 255;
  asm volatile("" : "+v"(t));
  return t;
}
DI size_t lz() {
  size_t z = 0;
  asm volatile("" : "+s"(z));
  return z;
}
DI int vhalf() {
  int t = __builtin_amdgcn_workitem_id_x();
  asm volatile("" : "+v"(t));
  return __builtin_amdgcn_readfirstlane(t >> 8);
}
DI int vbid() { return (int)blockIdx.x * 2 + vhalf(); }
DI int nvb() { return (int)gridDim.x * 2; }
typedef __attribute__((ext_vector_type(4))) float f32x4_nt;
DI float bf2f(u16 h) { return __uint_as_float(((unsigned)h) << 16); }
DI unsigned pk2(float a, float b) {
  bf2_t v;
  v[0] = (__bf16)a;
  v[1] = (__bf16)b;
  return __builtin_bit_cast(unsigned, v);
}
DI u16 f2bf(float a) { return (u16)(pk2(a, 0.f) & 0xffffu); }
DI float ex2(float x) { return __builtin_amdgcn_exp2f(x); }
DI float sigmoidf_(float x) { return __builtin_amdgcn_rcpf(1.f + __expf(-x)); }
DI bf16x8 pack8(const f32x16& v, int st) {
  u32x4 p;
  p[0] = pk2(v[8 * st + 0], v[8 * st + 1]);
  p[1] = pk2(v[8 * st + 2], v[8 * st + 3]);
  p[2] = pk2(v[8 * st + 4], v[8 * st + 5]);
  p[3] = pk2(v[8 * st + 6], v[8 * st + 7]);
  return __builtin_bit_cast(bf16x8, p);
}
DI s16x4 tr_read(const char* p) {
  return __builtin_amdgcn_ds_read_tr16_b64_v4i16((__attribute__((address_space(3))) s16x4*)(p));
}
DI float xh_max(float x) {
  const auto r = __builtin_amdgcn_permlane32_swap(__float_as_uint(x), __float_as_uint(x), false, false);
  return fmaxf(__uint_as_float(r[0]), __uint_as_float(r[1]));
}
DI float xh_sum(float x) {
  const auto r = __builtin_amdgcn_permlane32_swap(__float_as_uint(x), __float_as_uint(x), false, false);
  return __uint_as_float(r[0]) + __uint_as_float(r[1]);
}
DI float xh_get(float x, int hh) {
  const auto r = __builtin_amdgcn_permlane32_swap(__float_as_uint(x), __float_as_uint(x), false, false);
  return hh ? __uint_as_float(r[0]) : __uint_as_float(r[1]);
}
DI float quad_sum(float x) {
  x += __int_as_float(__builtin_amdgcn_update_dpp(0, __float_as_int(x), 0xB1, 0xF, 0xF, true));
  x += __int_as_float(__builtin_amdgcn_update_dpp(0, __float_as_int(x), 0x4E, 0xF, 0xF, true));
  return x;
}
DI void zero16(f32x16& v) {
  float z = 0.f;
  asm volatile("" : "+v"(z));
  UNROLL for (int i = 0; i < 16; ++i) v[i] = z;
}

DI void gemm_main(const u16* __restrict__ A, int lda, const u16* __restrict__ Bt, int ldb, int K,
                  f32x16 (&acc)[2][2], char* smem) {
  const int tid = ltid(), lane = tid & 63, w = tid >> 6, wr = w >> 1, wc = w & 1;
  const int lrow = tid >> 3, lch = tid & 7;
  const u16* ga = A + (size_t)lrow * lda + lch * 8;
  const u16* gb = Bt + (size_t)lrow * ldb + lch * 8;
  u32x4 ra[4], rb[4];
  UNROLL for (int i = 0; i < 4; ++i) {
    ra[i] = *(const u32x4*)(ga + (size_t)(32 * i) * lda);
    rb[i] = *(const u32x4*)(gb + (size_t)(32 * i) * ldb);
  }
  {
    char* pa = smem + lrow * 144 + lch * 16;
    UNROLL for (int i = 0; i < 4; ++i) {
      *(u32x4*)(pa + i * 32 * 144) = ra[i];
      *(u32x4*)(pa + 18432 + i * 32 * 144) = rb[i];
    }
  }
  __syncthreads();
  const int nk = K >> 6;
  _Pragma("unroll 1") for (int kt = 0; kt < nk; ++kt) {
    const bool more = (kt + 1 < nk);
    if (more) {
      const int k0 = (kt + 1) << 6;
      UNROLL for (int i = 0; i < 4; ++i) {
        ra[i] = *(const u32x4*)(ga + (size_t)(32 * i) * lda + k0);
        rb[i] = *(const u32x4*)(gb + (size_t)(32 * i) * ldb + k0);
      }
    }
    const char* pa = smem + (kt & 1) * 36864 + (wr * 64 + (lane & 31)) * 144 + (lane >> 5) * 16;
    const char* pb = smem + (kt & 1) * 36864 + 18432 + (wc * 64 + (lane & 31)) * 144 + (lane >> 5) * 16;
    UNROLL for (int ks = 0; ks < 4; ++ks) {
      bf16x8 a0 = *(const bf16x8*)(pa + ks * 32);
      bf16x8 a1 = *(const bf16x8*)(pa + 32 * 144 + ks * 32);
      bf16x8 b0 = *(const bf16x8*)(pb + ks * 32);
      bf16x8 b1 = *(const bf16x8*)(pb + 32 * 144 + ks * 32);
      acc[0][0] = MFMA(a0, b0, acc[0][0]);
      acc[0][1] = MFMA(a0, b1, acc[0][1]);
      acc[1][0] = MFMA(a1, b0, acc[1][0]);
      acc[1][1] = MFMA(a1, b1, acc[1][1]);
    }
    if (more) {
      char* pw = smem + ((kt + 1) & 1) * 36864 + lrow * 144 + lch * 16;
      UNROLL for (int i = 0; i < 4; ++i) {
        *(u32x4*)(pw + i * 32 * 144) = ra[i];
        *(u32x4*)(pw + 18432 + i * 32 * 144) = rb[i];
      }
    }
    __syncthreads();
  }
}

#define EPI_VARS const int tid = ltid(), lane = tid & 63, w = tid >> 6, wr = w >> 1, wc = w & 1, l31 = lane & 31, hh = lane >> 5; (void)l31; (void)hh; (void)wr; (void)wc;
#define EROW(mi, i) (wr * 64 + (mi) * 32 + 8 * ((i) >> 2) + 4 * hh + ((i) & 3))

DI void convT(const float* __restrict__ src0, const float* __restrict__ src1, int ldsrc, int K, int Nout,
              int kind, const float* __restrict__ scale, u16* __restrict__ dst, char* smem, int slab) {
  float* t = (float*)smem;
  const int tid = ltid();
  const int tiles_n = (Nout + 255) >> 8, tiles_k = K >> 6;
  for (int tile = vbid(); tile < tiles_n * tiles_k; tile += nvb()) {
    const int tn = tile % tiles_n, tk = tile / tiles_n;
    {
      const int nn = tid, n = tn * 256 + nn;
      const float* src = src0;
      int col = n;
      if (kind == 1) {
        const int j = n >> 8, r = n & 255;
        col = 128 * j + (r & 127);
        src = (r >> 7) ? src1 : src0;
      } else if (kind == 2) {
        if (n < 384) col = n;
        else if (n < 896) col = 416 + (n - 384);
        else if (n < 1664) col = 928 + (n - 896);
        else if (n < 2688) col = 1720 + (n - 1664);
        else if (n < 3712) col = 2744 + (n - 2688);
        else if (n < 3744) col = 384 + (n - 3712);
        else if (n < 3768) col = 1696 + (n - 3744);
        else col = -1;
      } else if (kind == 3) {
        if (n < 512) col = (n >> 6) * 96 + (n & 63);
        else col = ((n - 512) >> 5) * 96 + 64 + ((n - 512) & 31);
      }
      if (n >= Nout) col = -1;
      _Pragma("unroll 1") for (int kb = 0; kb < 4; ++kb) {
        float v[16];
        UNROLL for (int i = 0; i < 16; ++i) {
          const int k = tk * 64 + kb * 16 + i;
          v[i] = (col >= 0) ? __builtin_nontemporal_load(src + (size_t)k * ldsrc + col) : 0.f;
          if (scale) v[i] *= scale[k];
        }
        UNROLL for (int i = 0; i < 16; ++i) t[(kb * 16 + i) * 257 + nn] = v[i];
      }
    }
    __syncthreads();
    {
      const int k8 = (tid & 7) * 8;
      UNROLL for (int i = 0; i < 8; ++i) {
        const int n2 = (tid >> 3) + 32 * i, n = tn * 256 + n2;
        if (n < Nout) {
          u32x4 o;
          o[0] = pk2(t[(k8 + 0) * 257 + n2], t[(k8 + 1) * 257 + n2]);
          o[1] = pk2(t[(k8 + 2) * 257 + n2], t[(k8 + 3) * 257 + n2]);
          o[2] = pk2(t[(k8 + 4) * 257 + n2], t[(k8 + 5) * 257 + n2]);
          o[3] = pk2(t[(k8 + 6) * 257 + n2], t[(k8 + 7) * 257 + n2]);
          const size_t di = slab ? ((size_t)(((n >> 8) * (K >> 6) + tk) * 256 + (n & 255)) * 64 + k8) : ((size_t)n * K + tk * 64 + k8);
          *(u32x4*)(dst + di) = o;
        }
      }
    }
    __syncthreads();
  }
}

DI void phase_init(const Params& p, char* smem) {
  const int tid = ltid();
  const size_t gtid = (size_t)vbid() * 256 + tid, gsz = (size_t)nvb() * 256;
  if (vbid() == 0 && tid < 64) ((int*)(p.ws + OFF_CNT))[tid] = 0;
  {
    const float4* xs = (const float4*)p.in[0];
    u32x2* xb = (u32x2*)(p.ws + OFF_XB);
    const size_t n4 = (size_t)M * DM / 4;
    for (size_t i = gtid; i < n4; i += 4 * gsz) {
      float4 v[4];
      UNROLL for (int u = 0; u < 4; ++u) if (i + u * gsz < n4) {
        const f32x4_nt t4 = __builtin_nontemporal_load((const f32x4_nt*)(xs + i + u * gsz));
        v[u] = make_float4(t4[0], t4[1], t4[2], t4[3]);
      }
      UNROLL for (int u = 0; u < 4; ++u) if (i + u * gsz < n4) {
        u32x2 o;
        o[0] = pk2(v[u].x, v[u].y);
        o[1] = pk2(v[u].z, v[u].w);
        xb[i + u * gsz] = o;
      }
    }
  }
  {
    float* cn = (float*)(p.ws + OFF_COSN);
    float* sn = (float*)(p.ws + OFF_SINN);
    float* cm = (float*)(p.ws + OFF_COSM);
    float* sm = (float*)(p.ws + OFF_SINM);
    for (size_t i = gtid; i < (size_t)T * 24; i += gsz) {
      const int t = (int)(i / 24), j = (int)(i % 24);
      if (j < 8) {
        const float inv = (float)(1.0 / pow(500000.0, (double)(2 * j) / 16.0));
        const float ang = (float)t * inv;
        cn[t * 8 + j] = (float)cos((double)ang);
        sn[t * 8 + j] = (float)sin((double)ang);
      } else {
        const int m = j - 8;
        const float inv = (float)(1.0 / pow(500000.0, (double)(2 * m) / 32.0));
        const float ang = (float)t * inv;
        cm[t * 16 + m] = (float)cos((double)ang);
        sm[t * 16 + m] = (float)sin((double)ang);
      }
    }
  }
  for (int u = vbid(); u < 512; u += nvb()) {
    const int job = u >> 7, chunk = u & 127, layer = job >> 1, kv = job & 1;
    const float* pe = p.in[kv ? 15 : 11] + (size_t)layer * 2048;
    const float* w1 = p.in[kv ? 16 : 12] + (size_t)layer * 2048 * 128;
    float* red = (float*)smem;
    const int n = tid & 127, sub = tid >> 7;
    float sacc = 0.f;
    UNROLL for (int i = 0; i < 8; ++i) {
      const int kk = chunk * 16 + sub * 8 + i;
      sacc += pe[kk] * w1[(size_t)kk * 128 + n];
    }
    red[tid] = sacc;
    __syncthreads();
    if (tid < 128) ((float*)(p.ws + OFF_PART))[(size_t)(job * 128 + chunk) * 128 + n] = red[tid] + red[tid + 128];
    __syncthreads();
  }
  for (int job = 0; job < 28; ++job) {
    const int layer = job / 14, jj = job % 14;
    u16* wl = (u16*)(p.ws + OFF_W) + (size_t)layer * W_LAYER;
    const float* s0 = nullptr; const float* s1 = nullptr; const float* sc = nullptr;
    int ldsrc = 0, K = 0, Nout = 0, kind = 0; size_t woff = 0;
    switch (jj) {
      case 0: s0 = p.in[3] + (size_t)layer * DM * FF; s1 = p.in[4] + (size_t)layer * DM * FF; ldsrc = FF; K = 1024; Nout = 5632; kind = 1; woff = W_UP1; break;
      case 1: s0 = p.in[5] + (size_t)layer * FF * DM; ldsrc = DM; K = FF; Nout = 1024; woff = W_DN1; break;
      case 2: s0 = p.in[6] + (size_t)layer * DM * 3768; ldsrc = 3768; K = 1024; Nout = 3840; kind = 2; woff = W_IN; break;
      case 3: s0 = p.in[8] + (size_t)layer * 256 * 768; ldsrc = 768; K = 256; Nout = 768; kind = 3; sc = p.in[7] + layer * 256; woff = W_UQ; break;
      case 4: s0 = p.in[10] + (size_t)layer * 128 * 1024; ldsrc = 1024; K = 128; Nout = 1024; sc = p.in[9] + layer * 128; woff = W_UKV; break;
      case 5: s0 = p.in[12] + (size_t)layer * 2048 * 128; ldsrc = 128; K = 2048; Nout = 128; woff = W_CK1; break;
      case 6: s0 = p.in[14] + (size_t)layer * 128 * 64; ldsrc = 64; K = 128; Nout = 64; woff = W_CK2; break;
      case 7: s0 = p.in[16] + (size_t)layer * 2048 * 128; ldsrc = 128; K = 2048; Nout = 128; woff = W_CV1; break;
      case 8: s0 = p.in[18] + (size_t)layer * 128 * 64; ldsrc = 64; K = 128; Nout = 64; woff = W_CV2; break;
      case 9: s0 = p.in[19] + (size_t)layer * 512 * 1024; ldsrc = 1024; K = 512; Nout = 1024; woff = W_PM; break;
      case 10: s0 = p.in[20] + (size_t)layer * 512 * 1024; ldsrc = 1024; K = 512; Nout = 1024; woff = W_PN; break;
      case 11: s0 = p.in[21] + (size_t)layer * 1024 * 1024; ldsrc = 1024; K = 1024; Nout = 1024; woff = W_OUT; break;
      case 12: s0 = p.in[24] + (size_t)layer * DM * FF; s1 = p.in[25] + (size_t)layer * DM * FF; ldsrc = FF; K = 1024; Nout = 5632; kind = 1; woff = W_UP2; break;
      default: s0 = p.in[26] + (size_t)layer * FF * DM; ldsrc = DM; K = FF; Nout = 1024; woff = W_DN2; break;
    }
    convT(s0, s1, ldsrc, K, Nout, kind, sc, wl + woff, smem, (jj == 1 || jj == 13) ? 1 : 0);
  }
}

namespace pg8 {
#define PG8_LAS __attribute__((address_space(3)))
typedef unsigned short bf16_t;
typedef short bf16x8 __attribute__((ext_vector_type(8)));
typedef float f32x4 __attribute__((ext_vector_type(4)));
typedef unsigned u32x4 __attribute__((ext_vector_type(4)));
constexpr int BM = 256, BK = 64, HALF = 128, HTB = HALF * BK * 2  , STAGE_BYTES = 8 * HTB, NXCD = 8, WGM = 8;

__host__ __device__ __forceinline__ int lds_byte(int r, int c) { const int st = (r >> 4) * 2 + (c >> 5), rr = r & 15, cc = c & 31, ob = rr * 64 + cc * 2; return st * 1024 + (ob ^ (((ob >> 9) & 1) << 5)); }
__host__ __device__ __forceinline__ void stage_rc(int b, int& R, int& C) { const int st = b / 1024, sb = b % 1024, swz = sb ^ (((sb >> 9) & 1) << 5); R = (st >> 1) * 16 + swz / 64; C = (st & 1) * 32 + (swz % 64) / 2; }
__host__ __device__ __forceinline__ int perm32(int rho) { const int n = rho >> 4, i = rho & 15; return 8 * (i >> 2) + 4 * n + (i & 3); }

struct Unit { int pm, pn; };
struct Gemm { const bf16_t* A; const bf16_t* Bt; int M, N, K; };

struct StaticOrder {
    int nM, nN, nwg, G, c;
    __host__ __device__ void init(int M, int N, int G_, int c_) { nM = M / BM; nN = N / BM; nwg = nM * nN; G = G_; c = c_; }
    __host__ __device__ bool next(int i, Unit& u) const {
        const long L = (long)i * G + c; if (L >= nwg) return false;
        int wgid = (int)L; { const int q = nwg / NXCD, r = nwg % NXCD, xcd = wgid % NXCD, off = wgid / NXCD; wgid = (xcd < r ? xcd * (q + 1) : r * (q + 1) + (xcd - r) * q) + off; }
        const int nig = WGM * nN, gid = wgid / nig, fm = gid * WGM, gsz = (nM - fm) < WGM ? (nM - fm) : WGM;
        u.pm = fm + ((wgid % nig) % gsz); u.pn = (wgid % nig) / gsz; return true;
    }
    __device__ __forceinline__ void a_ready(const Unit&) const {}
    __device__ __forceinline__ void done(const Unit&) const {}
};

template <class Epi, class Sched, bool STAMP = false, bool ATILED = false, bool BTILED = false>
__device__ __forceinline__ void gemm_phase(PG8_LAS unsigned char* lds, const Gemm g, const Sched& S, const Epi& E, unsigned long long* stamps) {
    int tid = threadIdx.x; asm volatile("" : "+v"(tid));
    const int wid = __builtin_amdgcn_readfirstlane(tid >> 6), lane = tid & 63, wr = wid >> 2, wc = wid & 3, fr = lane & 15, fq = lane >> 4;
    const int K = g.K, nt = K / BK;
    int ts_lo = 0, ts_hi = 0, nts = 0; const unsigned long long rt_entry = STAMP ? (unsigned long long)wall_clock64() : 0ull;
#define PG8_STAMP() do { if (STAMP && wid == 0 && nts < 64) { const unsigned long long _c = (unsigned long long)clock64(); \
        ts_lo = (lane == nts) ? (int)(unsigned)_c : ts_lo; ts_hi = (lane == nts) ? (int)(unsigned)(_c >> 32) : ts_hi; ++nts; } } while (0)
    PG8_STAMP();
    unsigned voffA[2], voffB[2];
#pragma unroll
    for (int i = 0; i < 2; ++i) { int R, C; stage_rc(tid * 16 + i * 8192, R, C); const int Rb = Epi::PERM ? ((R & ~31) + perm32(R & 31)) : R;
        voffA[i] = (unsigned)(R * (ATILED ? BK : K) + C) * 2u; voffB[i] = (unsigned)(Rb * (BTILED ? BK : K) + C) * 2u; }
    const size_t kstep = (size_t)(BK * 2);
    const size_t hstep = (size_t)HALF * K * 2;
    const size_t tstep = 2 * hstep;
    const size_t kstepA = ATILED ? (size_t)(BM * BK * 2) : kstep, hstepA = ATILED ? (size_t)(HALF * BK * 2) : hstep, tstepA = ATILED ? (size_t)(K / BK) * (size_t)(BM * BK * 2) : tstep;
    const size_t kstepB = BTILED ? (size_t)(BM * BK * 2) : kstep, hstepB = BTILED ? (size_t)(HALF * BK * 2) : hstep, tstepB = BTILED ? (size_t)(K / BK) * (size_t)(BM * BK * 2) : tstep;
    const unsigned ldsw = (unsigned)wid * 1024u;
    const int aoff = lds_byte(wr * 64 + fr, fq * 8), boff = lds_byte(wc * 32 + fr, fq * 8);
#define PG8_SA(b, h) (((b) * 2 + (h)) * HTB)
#define PG8_SB(b, h) ((4 + (b) * 2 + (h)) * HTB)
#define PG8_STAGE(bufoff, gbase, voff) do { _Pragma("unroll") for (int _i = 0; _i < 2; ++_i) \
        __builtin_amdgcn_global_load_lds((const unsigned*)((const char*)(gbase) + (voff)[_i]), (PG8_LAS unsigned*)(lds + (bufoff) + ldsw + _i * 8192), 16, 0, 0); } while (0)
#define PG8_LDA(dst, b, h) do { _Pragma("unroll") for (int m = 0; m < 4; ++m) _Pragma("unroll") for (int k = 0; k < 2; ++k) dst[m][k] = *(const PG8_LAS bf16x8*)(lds + PG8_SA(b, h) + aoff + m * 2048 + k * 1024); } while (0)
#define PG8_LDB(dst, b, h) do { _Pragma("unroll") for (int n = 0; n < 2; ++n) _Pragma("unroll") for (int k = 0; k < 2; ++k) dst[n][k] = *(const PG8_LAS bf16x8*)(lds + PG8_SB(b, h) + boff + n * 2048 + k * 1024); } while (0)
#define PG8_MMA(ai, bj, At, Bt) do { __builtin_amdgcn_s_setprio(1); _Pragma("unroll") for (int m = 0; m < 4; ++m) _Pragma("unroll") for (int n = 0; n < 2; ++n) _Pragma("unroll") for (int k = 0; k < 2; ++k) \
        acc[ai][bj][m][n] = __builtin_amdgcn_mfma_f32_16x16x32_bf16(Bt[n][k], At[m][k], acc[ai][bj][m][n], 0, 0, 0); __builtin_amdgcn_s_setprio(0); } while (0)
#define PG8_WAIT_V(n) asm volatile("s_waitcnt vmcnt(" #n ")" ::: "memory")
#define PG8_WAIT_L(n) asm volatile("s_waitcnt lgkmcnt(" #n ")" ::: "memory")
#define PG8_BAR __builtin_amdgcn_s_barrier()
#define PG8_SCHED __builtin_amdgcn_sched_barrier(0)
    Unit cur, nxt; int ui = 0;
    if (!S.next(0, cur)) return;
    f32x4 acc[2][2][4][2];
#pragma unroll
    for (int a = 0; a < 2; ++a)
#pragma unroll
        for (int b = 0; b < 2; ++b)
#pragma unroll
            for (int m = 0; m < 4; ++m)
#pragma unroll
                for (int n = 0; n < 2; ++n) acc[a][b][m][n] = (f32x4){0.f, 0.f, 0.f, 0.f};
    bf16x8 At[4][2], B0[2][2], B1[2][2];
    const char* cA = (const char*)g.A + (size_t)cur.pm * tstepA; const char* cB = (const char*)g.Bt + (size_t)cur.pn * tstepB;
    S.a_ready(cur);
    PG8_STAGE(PG8_SB(0, 0), cB, voffB); PG8_STAGE(PG8_SA(0, 0), cA, voffA); PG8_STAGE(PG8_SB(0, 1), cB + hstepB, voffB); PG8_STAGE(PG8_SA(0, 1), cA + hstepA, voffA);
    if (wr == 1) PG8_BAR;
    PG8_WAIT_V(4); PG8_BAR;
    PG8_STAGE(PG8_SB(1, 0), cB + kstepB, voffB); PG8_STAGE(PG8_SA(1, 0), cA + kstepA, voffA); PG8_STAGE(PG8_SB(1, 1), cB + hstepB + kstepB, voffB);
    PG8_WAIT_V(6); PG8_BAR;
    PG8_STAMP();
    for (;;) {
        const bool has_next = S.next(ui + 1, nxt);
        const char* nA = has_next ? (const char*)g.A + (size_t)nxt.pm * tstepA : cA; const char* nB = has_next ? (const char*)g.Bt + (size_t)nxt.pn * tstepB : cB;
        for (int t = 0; t < nt; t += 2) {
            const bool last = (t == nt - 2);
            const char* a1 = cA + (size_t)(t + 1) * kstepA;
            const char* a2 = last ? nA : cA + (size_t)(t + 2) * kstepA; const char* b2 = last ? nB : cB + (size_t)(t + 2) * kstepB;
            const char* a3 = a2 + kstepA; const char* b3 = b2 + kstepB;
            if (last && has_next) S.a_ready(nxt);
            PG8_LDB(B0, 0, 0); PG8_SCHED; PG8_LDA(At, 0, 0); PG8_STAGE(PG8_SA(1, 1), a1 + hstepA, voffA);
            PG8_WAIT_L(8); PG8_BAR; PG8_WAIT_L(0); PG8_MMA(0, 0, At, B0); PG8_BAR; PG8_SCHED;
            PG8_LDB(B1, 0, 1); PG8_STAGE(PG8_SB(0, 0), b2, voffB);
            PG8_BAR; PG8_WAIT_L(0); PG8_MMA(0, 1, At, B1); PG8_BAR;
            PG8_LDA(At, 0, 1); PG8_STAGE(PG8_SA(0, 0), a2, voffA);
            PG8_BAR; PG8_WAIT_L(0); PG8_MMA(1, 0, At, B0); PG8_BAR; PG8_SCHED;
            PG8_STAGE(PG8_SB(0, 1), b2 + hstepB, voffB);
            PG8_WAIT_V(6); PG8_BAR; PG8_MMA(1, 1, At, B1); PG8_BAR;
            PG8_LDB(B0, 1, 0); PG8_SCHED; PG8_LDA(At, 1, 0); PG8_STAGE(PG8_SA(0, 1), a2 + hstepA, voffA);
            PG8_WAIT_L(8); PG8_BAR; PG8_WAIT_L(0); PG8_MMA(0, 0, At, B0); PG8_BAR; PG8_SCHED;
            PG8_LDB(B1, 1, 1); PG8_STAGE(PG8_SB(1, 0), b3, voffB);
            PG8_BAR; PG8_WAIT_L(0); PG8_MMA(0, 1, At, B1); PG8_BAR;
            PG8_LDA(At, 1, 1); PG8_STAGE(PG8_SA(1, 0), a3, voffA);
            PG8_BAR; PG8_WAIT_L(0); PG8_MMA(1, 0, At, B0); PG8_BAR; PG8_SCHED;
            PG8_STAGE(PG8_SB(1, 1), b3 + hstepB, voffB);
            PG8_WAIT_V(6); PG8_BAR; PG8_MMA(1, 1, At, B1); PG8_BAR;
        }
        PG8_STAMP();
        if constexpr (!Epi::AFTER_DRAIN) { E(acc, cur, wr, wc, fr, fq); S.done(cur); }
        PG8_STAMP();
        if (!has_next) break;
#pragma unroll
        for (int a = 0; a < 2; ++a)
#pragma unroll
            for (int b = 0; b < 2; ++b)
#pragma unroll
                for (int m = 0; m < 4; ++m)
#pragma unroll
                    for (int n = 0; n < 2; ++n) acc[a][b][m][n] = (f32x4){0.f, 0.f, 0.f, 0.f};
        cur = nxt; cA = nA; cB = nB; ++ui;
    }
    PG8_WAIT_V(0);
    if (wr == 0) PG8_BAR;
    PG8_BAR;
    if constexpr (Epi::AFTER_DRAIN) { E.fused(acc, cur, wr, wc, fr, fq, lds, wid, lane); S.done(cur); }
    PG8_STAMP();
    if (STAMP && wid == 0) { stamps[lane] = lane < nts ? (((unsigned long long)(unsigned)ts_hi << 32) | (unsigned)ts_lo) : 0ull;
        if (lane == 62) stamps[62] = rt_entry; if (lane == 63) stamps[63] = (unsigned long long)wall_clock64(); }
#undef PG8_STAMP
#undef PG8_SA
#undef PG8_SB
#undef PG8_STAGE
#undef PG8_LDA
#undef PG8_LDB
#undef PG8_MMA
#undef PG8_WAIT_V
#undef PG8_WAIT_L
#undef PG8_BAR
#undef PG8_SCHED
}
}

typedef pg8::f32x4 f32x4_t;
DI f32x4_t ld4(const float* p) { return *(const f32x4_t*)p; }

struct EpiSwiglu {
  static constexpr bool PERM = true, AFTER_DRAIN = false;
  u16* H;
  __device__ __forceinline__ void operator()(const f32x4_t (&acc)[2][2][4][2], const pg8::Unit& u, int wr, int wc, int fr, int fq) const {
    u16* base = H + ((size_t)(u.pm * (FF / 64) + 2 * u.pn + (wc >> 1)) * 256) * 64 + (size_t)((wr * 64 + fr) * 64 + (wc & 1) * 32 + fq * 8);
    UNROLL for (int ai = 0; ai < 2; ++ai) UNROLL for (int m = 0; m < 4; ++m) {
      float h[8];
      UNROLL for (int n = 0; n < 2; ++n) UNROLL for (int j = 0; j < 4; ++j) {
        const float g = acc[ai][0][m][n][j], up = acc[ai][1][m][n][j];
        h[4 * n + j] = g * __builtin_amdgcn_rcpf(1.f + __expf(-g)) * up;
      }
      u32x4 o;
      o[0] = pk2(h[0], h[1]); o[1] = pk2(h[2], h[3]); o[2] = pk2(h[4], h[5]); o[3] = pk2(h[6], h[7]);
      *(u32x4*)(base + (ai * 128 + m * 16) * 64) = o;
    }
  }
};

struct EpiResid {
  static constexpr bool PERM = true, AFTER_DRAIN = false;
  const float* Xin; float* X; float coef;
  __device__ __forceinline__ void operator()(const f32x4_t (&acc)[2][2][4][2], const pg8::Unit& u, int wr, int wc, int fr, int fq) const {
    UNROLL for (int ai = 0; ai < 2; ++ai) UNROLL for (int m = 0; m < 4; ++m) {
      const int row = u.pm * 256 + ai * 128 + wr * 64 + m * 16 + fr;
      UNROLL for (int bj = 0; bj < 2; ++bj) {
        const size_t off = (size_t)row * DM + u.pn * 256 + bj * 128 + wc * 32 + fq * 8;
        UNROLL for (int n = 0; n < 2; ++n) {
          f32x4_t x = *(const f32x4_t*)(Xin + off + 4 * n);
          x = x * ALPHA + acc[ai][bj][m][n] * coef;
          *(f32x4_t*)(X + off + 4 * n) = x;
        }
      }
    }
  }
};

struct EpiGate1 {
  static constexpr bool PERM = true, AFTER_DRAIN = false;
  u16* GM;
  __device__ __forceinline__ void operator()(const f32x4_t (&acc)[2][2][4][2], const pg8::Unit& u, int wr, int wc, int fr, int fq) const {
    UNROLL for (int ai = 0; ai < 2; ++ai) UNROLL for (int m = 0; m < 4; ++m) {
      const int row = u.pm * 256 + ai * 128 + wr * 64 + m * 16 + fr;
      UNROLL for (int bj = 0; bj < 2; ++bj) {
        u16* pg = GM + (size_t)row * 1024 + u.pn * 256 + bj * 128 + wc * 32 + fq * 8;
        const u32x4 g = *(const u32x4*)pg;
        u32x4 o;
        UNROLL for (int e = 0; e < 4; ++e) {
          const float lo = __uint_as_float(g[e] << 16) * acc[ai][bj][m][e >> 1][(e & 1) * 2];
          const float hi = __uint_as_float(g[e] & 0xffff0000u) * acc[ai][bj][m][e >> 1][(e & 1) * 2 + 1];
          o[e] = pk2(lo, hi);
        }
        *(u32x4*)pg = o;
      }
    }
  }
};
struct EpiGate2 {
  static constexpr bool PERM = true, AFTER_DRAIN = false;
  const u16* GM; const u16* GN; u16* Y;
  __device__ __forceinline__ void operator()(const f32x4_t (&acc)[2][2][4][2], const pg8::Unit& u, int wr, int wc, int fr, int fq) const {
    UNROLL for (int ai = 0; ai < 2; ++ai) UNROLL for (int m = 0; m < 4; ++m) {
      const int row = u.pm * 256 + ai * 128 + wr * 64 + m * 16 + fr;
      UNROLL for (int bj = 0; bj < 2; ++bj) {
        const size_t off = (size_t)row * 1024 + u.pn * 256 + bj * 128 + wc * 32 + fq * 8;
        const u32x4 t1 = *(const u32x4*)(GM + off);
        const u32x4 g = *(const u32x4*)(GN + off);
        u32x4 o;
        UNROLL for (int e = 0; e < 4; ++e) {
          const float lo = __uint_as_float(t1[e] << 16) + __uint_as_float(g[e] << 16) * acc[ai][bj][m][e >> 1][(e & 1) * 2];
          const float hi = __uint_as_float(t1[e] & 0xffff0000u) + __uint_as_float(g[e] & 0xffff0000u) * acc[ai][bj][m][e >> 1][(e & 1) * 2 + 1];
          o[e] = pk2(lo, hi);
        }
        *(u32x4*)(Y + off) = o;
      }
    }
  }
};

struct EpiWin {
  static constexpr bool PERM = true, AFTER_DRAIN = false;
  char* ws_;
  __device__ __forceinline__ void operator()(const f32x4_t (&acc)[2][2][4][2], const pg8::Unit& u, int wr, int wc, int fr, int fq) const {
    char* ws = ws_ + lz();
    u16* CQ = (u16*)(ws + OFF_CQ);
    u16* CKV = (u16*)(ws + OFF_CKV);
    u16* QN = (u16*)(ws + OFF_QN);
    u16* KV6 = (u16*)(ws + OFF_KV6);
    u16* KPE = (u16*)(ws + OFF_KPE);
    float* GATES = (float*)(ws + OFF_GATES);
    u16* GM = (u16*)(ws + OFF_GM);
    u16* GN = (u16*)(ws + OFF_GN);
    const float* COSN = (const float*)(ws + OFF_COSN);
    const float* SINN = (const float*)(ws + OFF_SINN);
    const float* COSM = (const float*)(ws + OFF_COSM);
    const float* SINM = (const float*)(ws + OFF_SINM);
    UNROLL for (int bj = 0; bj < 2; ++bj) {
      const int hc = 2 * u.pn + bj;
      const int cin = wc * 32 + fq * 8;
      UNROLL for (int ai = 0; ai < 2; ++ai) UNROLL for (int m = 0; m < 4; ++m) {
        const int row = u.pm * 256 + ai * 128 + wr * 64 + m * 16 + fr;
        const int t = row & (T - 1), b = row >> 12;
        float v[8];
        UNROLL for (int n = 0; n < 2; ++n) UNROLL for (int j = 0; j < 4; ++j) v[4 * n + j] = acc[ai][bj][m][n][j];
        if (hc < 3) {
          u16* dst = hc < 2 ? (CQ + (size_t)row * 256 + hc * 128 + cin) : (CKV + (size_t)row * 128 + cin);
          u32x4 o;
          o[0] = pk2(v[0], v[1]); o[1] = pk2(v[2], v[3]); o[2] = pk2(v[4], v[5]); o[3] = pk2(v[6], v[7]);
          *(u32x4*)dst = o;
        } else if (hc < 13) {
          const bool isq = hc < 7;
          const int j6 = hc - 7;
          const bool rope_on = isq || ((j6 & 1) == 0);
          if ((wc & 1) == 0) {
            float pr[8];
            UNROLL for (int e = 0; e < 8; ++e) pr[e] = __shfl_xor(v[e], 16);
            if (rope_on && fq < 2) {
              const f32x4_t c0 = ld4(COSN + t * 8), c1 = ld4(COSN + t * 8 + 4), s0 = ld4(SINN + t * 8), s1 = ld4(SINN + t * 8 + 4);
              UNROLL for (int e = 0; e < 8; ++e) {
                const float cs = e < 4 ? c0[e & 3] : c1[e & 3], sn = e < 4 ? s0[e & 3] : s1[e & 3];
                v[e] = (fq == 0) ? (v[e] * cs - pr[e] * sn) : (v[e] * cs + pr[e] * sn);
              }
            }
          }
          const int d = (wc & 1) * 32 + fq * 8;
          u16* dst = isq ? (QN + (size_t)row * 512 + (2 * (hc - 3) + (wc >> 1)) * 64 + d)
                         : (KV6 + ((size_t)((j6 * NB + b) * 2 + (wc >> 1)) * T + t) * 64 + d);
          u32x4 o;
          o[0] = pk2(v[0], v[1]); o[1] = pk2(v[2], v[3]); o[2] = pk2(v[4], v[5]); o[3] = pk2(v[6], v[7]);
          *(u32x4*)dst = o;
        } else if (hc < 29) {
          u16* dst = (hc < 21 ? GM : GN) + (size_t)row * 1024 + (hc < 21 ? hc - 13 : hc - 21) * 128 + cin;
          u32x4 o;
          o[0] = pk2(sigmoidf_(v[0]), sigmoidf_(v[1])); o[1] = pk2(sigmoidf_(v[2]), sigmoidf_(v[3]));
          o[2] = pk2(sigmoidf_(v[4]), sigmoidf_(v[5])); o[3] = pk2(sigmoidf_(v[6]), sigmoidf_(v[7]));
          *(u32x4*)dst = o;
        } else {
          if (wc == 0) {
            float pr[8];
            UNROLL for (int e = 0; e < 8; ++e) pr[e] = __shfl_xor(v[e], 32);
            const int mb = (fq & 1) * 8;
            const f32x4_t c0 = ld4(COSM + t * 16 + mb), c1 = ld4(COSM + t * 16 + mb + 4), s0 = ld4(SINM + t * 16 + mb), s1 = ld4(SINM + t * 16 + mb + 4);
            UNROLL for (int e = 0; e < 8; ++e) {
              const float cs = e < 4 ? c0[e & 3] : c1[e & 3], sn = e < 4 ? s0[e & 3] : s1[e & 3];
              v[e] = (fq < 2) ? (v[e] * cs - pr[e] * sn) : (v[e] * cs + pr[e] * sn);
            }
            u32x4 o;
            o[0] = pk2(v[0], v[1]); o[1] = pk2(v[2], v[3]); o[2] = pk2(v[4], v[5]); o[3] = pk2(v[6], v[7]);
            *(u32x4*)(KPE + (size_t)row * 32 + fq * 8) = o;
          } else if (wc == 1 && fq < 3) {
            float* dst = GATES + (size_t)row * 24 + fq * 8;
            f32x4_t g0, g1;
            UNROLL for (int e = 0; e < 4; ++e) { g0[e] = sigmoidf_(v[e]); g1[e] = sigmoidf_(v[4 + e]); }
            *(f32x4_t*)dst = g0;
            *(f32x4_t*)(dst + 4) = g1;
          }
        }
      }
    }
  }
};

template <bool ATILED = false, bool BTILED = false, class Epi>
DI void big_gemm(const u16* A, const u16* Bt, int N, int K, const Epi& E, char* smem_blk) {
  pg8::Gemm g{A, Bt, M, N, K};
  pg8::StaticOrder S;
  S.init(M, N, (int)gridDim.x, (int)blockIdx.x);
  pg8::gemm_phase<Epi, pg8::StaticOrder, false, ATILED, BTILED>((PG8_LAS unsigned char*)smem_blk, g, S, E, nullptr);
  __syncthreads();
}

DI void bias_reduce(const Params& p) {
  const int vb = vbid(), tid = ltid();
  if (vb < 4 && tid < 128) {
    const int job = vb, layer = job >> 1, kv = job & 1;
    const float* part = (const float*)(p.ws + OFF_PART) + (size_t)job * 128 * 128;
    float sacc = (p.in[kv ? 17 : 13] + (size_t)layer * 128)[tid];
    for (int ch = 0; ch < 128; ++ch) sacc += part[ch * 128 + tid];
    ((float*)(p.ws + OFF_BIAS))[job * 128 + tid] = sacc;
  }
}

template <bool WXB = true>
DI void phase_ln(const Params& p, const float* g, const float* b) {
  const int tid = ltid(), lane = tid & 63, w = tid >> 6;
  float* X = p.out;
  u16* Xb = (u16*)(p.ws + OFF_XB);
  float4 gv[4], bv[4];
  UNROLL for (int i = 0; i < 4; ++i) {
    gv[i] = *(const float4*)(g + i * 256 + lane * 4);
    bv[i] = *(const float4*)(b + i * 256 + lane * 4);
  }
  for (int row0 = vbid() * 4 + w; row0 < M; row0 += nvb() * 8) {
    int row1 = row0 + nvb() * 4;
    const bool has1 = row1 < M;
    if (!has1) row1 = row0;
    float4 va[4], vc[4];
    UNROLL for (int i = 0; i < 4; ++i) {
      va[i] = *(const float4*)(X + (size_t)row0 * DM + i * 256 + lane * 4);
      vc[i] = *(const float4*)(X + (size_t)row1 * DM + i * 256 + lane * 4);
    }
    float s0 = 0.f, s1 = 0.f;
    UNROLL for (int i = 0; i < 4; ++i) {
      s0 += va[i].x + va[i].y + va[i].z + va[i].w;
      s1 += vc[i].x + vc[i].y + vc[i].z + vc[i].w;
    }
    UNROLL for (int o = 32; o >= 1; o >>= 1) { s0 += __shfl_xor(s0, o); s1 += __shfl_xor(s1, o); }
    const float mu0 = s0 * (1.f / 1024.f), mu1 = s1 * (1.f / 1024.f);
    float q0 = 0.f, q1 = 0.f;
    UNROLL for (int i = 0; i < 4; ++i) {
      va[i].x -= mu0; va[i].y -= mu0; va[i].z -= mu0; va[i].w -= mu0;
      vc[i].x -= mu1; vc[i].y -= mu1; vc[i].z -= mu1; vc[i].w -= mu1;
      q0 += va[i].x * va[i].x + va[i].y * va[i].y + va[i].z * va[i].z + va[i].w * va[i].w;
      q1 += vc[i].x * vc[i].x + vc[i].y * vc[i].y + vc[i].z * vc[i].z + vc[i].w * vc[i].w;
    }
    UNROLL for (int o = 32; o >= 1; o >>= 1) { q0 += __shfl_xor(q0, o); q1 += __shfl_xor(q1, o); }
    const float rstd0 = rsqrtf(q0 * (1.f / 1024.f) + 1e-5f), rstd1 = rsqrtf(q1 * (1.f / 1024.f) + 1e-5f);
#define LN_STORE(V, ROW, RSTD)                                                                   \
  UNROLL for (int i = 0; i < 4; ++i) {                                                            \
    float4 y;                                                                                      \
    y.x = V[i].x * (RSTD) * gv[i].x + bv[i].x;                                                    \
    y.y = V[i].y * (RSTD) * gv[i].y + bv[i].y;                                                    \
    y.z = V[i].z * (RSTD) * gv[i].z + bv[i].z;                                                    \
    y.w = V[i].w * (RSTD) * gv[i].w + bv[i].w;                                                    \
    *(float4*)(X + (size_t)(ROW) * DM + i * 256 + lane * 4) = y;                                  \
    u32x2 o;                                                                                       \
    o[0] = pk2(y.x, y.y);                                                                          \
    o[1] = pk2(y.z, y.w);                                                                          \
    if (WXB) *(u32x2*)(Xb + (size_t)(ROW) * DM + i * 256 + lane * 4) = o;                         \
  }
    LN_STORE(va, row0, rstd0)
    if (has1) { LN_STORE(vc, row1, rstd1) }
#undef LN_STORE
  }
}

DI float gelu_tanh(float x) {
  const float u = 0.7978845608028654f * (x + 0.044715f * x * x * x);
  return x * __builtin_amdgcn_rcpf(1.f + __expf(-2.f * u));
}

DI void phase_up_cmp(const Params& p, int layer, char* smem) {
  EPI_VARS
  const u16* WL = (const u16*)(p.ws + OFF_W) + (size_t)layer * W_LAYER;
  float* rstd = (float*)(smem + 73728);
  const float* COSM = (const float*)(p.ws + OFF_COSM);
  const float* SINM = (const float*)(p.ws + OFF_SINM);
  for (int task = vbid(); task < 64; task += nvb()) {
    char* wsz = p.ws + lz();
    f32x16 acc[2][2];
    UNROLL for (int a = 0; a < 2; ++a) UNROLL for (int b = 0; b < 2; ++b) zero16(acc[a][b]);
      const int kv = task >> 5, bg = (task >> 1) & 15, mt = task & 1;
      const u16* A = (const u16*)(wsz + OFF_KV6) + ((size_t)(kv * 16 + bg) * T) * 64 + (size_t)mt * 128 * 1024;
      const u16* W1 = WL + (kv ? W_CV1 : W_CK1);
      const u16* W2 = WL + (kv ? W_CV2 : W_CK2);
      const float* bias = (const float*)(wsz + OFF_BIAS) + (layer * 2 + kv) * 128;
      u16* dst = (u16*)(wsz + (kv ? OFF_VC : OFF_KC)) + (size_t)bg * 256 * 64;
      gemm_main(A, 1024, W1, 2048, 2048, acc, smem);
      UNROLL for (int mi = 0; mi < 2; ++mi) UNROLL for (int ni = 0; ni < 2; ++ni) UNROLL for (int i = 0; i < 16; ++i) {
        const int r = EROW(mi, i), c = wc * 64 + ni * 32 + l31;
        *(u16*)(smem + r * 272 + c * 2) = f2bf(gelu_tanh(acc[mi][ni][i] + bias[c]));
      }
      __syncthreads();
      f32x16 a2[2];
      zero16(a2[0]);
      zero16(a2[1]);
      UNROLL for (int ks = 0; ks < 8; ++ks) {
        bf16x8 af = *(const bf16x8*)(smem + (32 * w + l31) * 272 + ks * 32 + hh * 16);
        bf16x8 b0 = *(const bf16x8*)(W2 + (size_t)(l31) * 128 + ks * 16 + hh * 8);
        bf16x8 b1 = *(const bf16x8*)(W2 + (size_t)(32 + l31) * 128 + ks * 16 + hh * 8);
        a2[0] = MFMA(af, b0, a2[0]);
        a2[1] = MFMA(af, b1, a2[1]);
      }
      UNROLL for (int ni = 0; ni < 2; ++ni) UNROLL for (int i = 0; i < 16; ++i) {
        const int c = mt * 128 + 32 * w + 8 * (i >> 2) + 4 * hh + (i & 3);
        dst[(size_t)c * 64 + ni * 32 + l31] = (c == 255) ? (u16)0 : f2bf(a2[ni][i]);
      }
      __syncthreads();
  }
  const int nw_small = nvb() > 128 ? nvb() - 64 : nvb();
  const int vb_small = nvb() > 128 ? vbid() - 64 : vbid();
  for (int task = vb_small; task >= 0 && task < 1536; task += nw_small) {
    char* wsz = p.ws + lz();
    f32x16 acc[2][2];
    UNROLL for (int a = 0; a < 2; ++a) UNROLL for (int b = 0; b < 2; ++b) zero16(acc[a][b]);
      const int tt = task, tm = tt / 6, tn = tt % 6;
      const u16* A = (const u16*)(wsz + OFF_CQ) + (size_t)tm * 128 * 256;
      {
        const int r = tid >> 1, hf = tid & 1;
        const u16* ar = A + (size_t)r * 256 + hf * 128;
        float ss = 0.f;
        UNROLL for (int c = 0; c < 16; ++c) {
          u32x4 v = *(const u32x4*)(ar + c * 8);
          UNROLL for (int e = 0; e < 4; ++e) {
            const float lo = __uint_as_float(v[e] << 16), hi = __uint_as_float(v[e] & 0xffff0000u);
            ss += lo * lo + hi * hi;
          }
        }
        ss += __shfl_xor(ss, 1);
        if (hf == 0) rstd[r] = rsqrtf(ss * (1.f / 256.f) + 1e-6f);
      }
      gemm_main(A, 256, WL + W_UQ + (size_t)tn * 128 * 256, 256, 256, acc, smem);
      u16* QM = (u16*)(wsz + OFF_QM);
      UNROLL for (int mi = 0; mi < 2; ++mi) UNROLL for (int ni = 0; ni < 2; ++ni) UNROLL for (int i = 0; i < 16; ++i) {
        const int r = EROW(mi, i), row = tm * 128 + r;
        float v = acc[mi][ni][i] * rstd[r];
        const float pr = __shfl_xor(v, 16);
        if (tn >= 4) {
          const int t = row & (T - 1);
          const float cs = COSM[t * 16 + (l31 & 15)], sn = SINM[t * 16 + (l31 & 15)];
          v = (l31 < 16) ? (v * cs - pr * sn) : (v * cs + pr * sn);
        }
        QM[(size_t)row * 768 + tn * 128 + wc * 64 + ni * 32 + l31] = f2bf(v);
      }
      __syncthreads();
  }
  for (int task = vb_small; task >= 0 && task < 2048; task += nw_small) {
    char* wsz = p.ws + lz();
    f32x16 acc[2][2];
    UNROLL for (int a = 0; a < 2; ++a) UNROLL for (int b = 0; b < 2; ++b) zero16(acc[a][b]);
      const int tt = task, tm = tt >> 3, tn = tt & 7;
      const u16* A = (const u16*)(wsz + OFF_CKV) + (size_t)tm * 128 * 128;
      {
        const int r = tid >> 1, hf = tid & 1;
        const u16* ar = A + (size_t)r * 128 + hf * 64;
        float ss = 0.f;
        UNROLL for (int c = 0; c < 8; ++c) {
          u32x4 v = *(const u32x4*)(ar + c * 8);
          UNROLL for (int e = 0; e < 4; ++e) {
            const float lo = __uint_as_float(v[e] << 16), hi = __uint_as_float(v[e] & 0xffff0000u);
            ss += lo * lo + hi * hi;
          }
        }
        ss += __shfl_xor(ss, 1);
        if (hf == 0) rstd[r] = rsqrtf(ss * (1.f / 128.f) + 1e-6f);
      }
      gemm_main(A, 128, WL + W_UKV + (size_t)tn * 128 * 128, 128, 128, acc, smem);
      u16* dst = (u16*)(wsz + (wc == 0 ? OFF_KM : OFF_VM));
      UNROLL for (int mi = 0; mi < 2; ++mi) UNROLL for (int ni = 0; ni < 2; ++ni) UNROLL for (int i = 0; i < 16; ++i) {
        const int r = EROW(mi, i), row = tm * 128 + r;
        const int t = row & (T - 1), b = row >> 12;
        dst[((size_t)(b * 8 + tn) * T + t) * 64 + ni * 32 + l31] = f2bf(acc[mi][ni][i] * rstd[r]);
      }
      __syncthreads();
  }
}

template <int NKS, int KSTR, int MODE, int NREG>
DI void attn_tile(const char* sK, const char* sV, const bf16x8 (&qf)[2][4], const char* qlds, f32x16 (&o)[2][2],
                  float (&mrun)[2], float (&lrun)[2], float sl2, int lane, int kbase, const int (&tq)[2],
                  bool need_mask, const bool (&selb)[2]) {
  const int hh = lane >> 5, r = lane & 31;
  const int blk = (lane >> 4) & 1, q4 = (lane & 15) >> 2, p4 = lane & 3;
  const int sw = (q4 >> 1) & 1;
  UNROLL for (int kt2 = 0; kt2 < 2; ++kt2) {
    f32x16 s[2];
    UNROLL for (int i = 0; i < 16; ++i) { s[0][i] = 0.f; s[1][i] = 0.f; }
    {
      const char* pk = sK + (32 * kt2 + r) * KSTR + hh * 16;
      bf16x8 kf[2], qa[2], qb[2];
      kf[0] = *(const bf16x8*)(pk);
      if (0 >= NREG) {
        qa[0] = *(const bf16x8*)(qlds + (0 - NREG) * 1024);
        qb[0] = *(const bf16x8*)(qlds + (NKS - NREG + 0 - NREG) * 1024);
      }
      UNROLL for (int ks = 0; ks < NKS; ++ks) {
        const int cb = ks & 1, nb = cb ^ 1;
        if (ks + 1 < NKS) {
          kf[nb] = *(const bf16x8*)(pk + (ks + 1) * 32);
          if (ks + 1 >= NREG) {
            qa[nb] = *(const bf16x8*)(qlds + (ks + 1 - NREG) * 1024);
            qb[nb] = *(const bf16x8*)(qlds + (NKS - NREG + ks + 1 - NREG) * 1024);
          }
        }
        __builtin_amdgcn_sched_barrier(0);
        if (ks >= NREG) {
          s[0] = MFMA(kf[cb], qa[cb], s[0]);
          s[1] = MFMA(kf[cb], qb[cb], s[1]);
        } else {
          s[0] = MFMA(kf[cb], qf[0][ks < 4 ? ks : 0], s[0]);
          s[1] = MFMA(kf[cb], qf[1][ks < 4 ? ks : 0], s[1]);
        }
        __builtin_amdgcn_sched_barrier(0);
      }
    }
    UNROLL for (int qt = 0; qt < 2; ++qt) {
      float mx = NEGR;
      if (need_mask) {
        const int lim = tq[qt] - kbase - 4 * hh;
        UNROLL for (int i = 0; i < 16; ++i) {
          const int kc = 32 * kt2 + 8 * (i >> 2) + (i & 3);
          bool ok = kc <= lim;
          if (MODE == 2) ok = ok && (kc > lim - 512);
          if (MODE == 1) ok = ok && selb[qt];
          const float x = ok ? s[qt][i] : NEGR;
          s[qt][i] = x;
          mx = fmaxf(mx, x);
        }
      } else {
        UNROLL for (int i = 0; i < 16; ++i) {
          float x = s[qt][i];
          if (MODE == 1) {
            x = selb[qt] ? x : NEGR;
            s[qt][i] = x;
          }
          mx = fmaxf(mx, x);
        }
      }
      mx = xh_max(mx);
      const float mnew = fmaxf(mrun[qt], mx * sl2);
      if (__builtin_amdgcn_ballot_w64(mnew != mrun[qt]) != 0ull) {
        const float alpha = ex2(mrun[qt] - mnew);
        mrun[qt] = mnew;
        lrun[qt] *= alpha;
        UNROLL for (int dt = 0; dt < 2; ++dt) UNROLL for (int i = 0; i < 16; ++i) o[qt][dt][i] *= alpha;
      }
      float ls = 0.f;
      UNROLL for (int i = 0; i < 16; ++i) {
        const float pv = ex2(__builtin_fmaf(s[qt][i], sl2, -mnew));
        s[qt][i] = pv;
        ls += pv;
      }
      lrun[qt] += ls;
    }
    {
      bf16x8 pf0[2], pf1[2];
      pf0[0] = pack8(s[0], 0); pf1[0] = pack8(s[1], 0);
      pf0[1] = pack8(s[0], 1); pf1[1] = pack8(s[1], 1);
      s16x4 lo[2], hi[2];
      const char* pvb = sV + (32 * kt2 + 4 * hh + q4) * 128 + (16 * blk + 4 * p4) * 2;
      lo[0] = tr_read(pvb + ((0 ^ sw) * 64));
      hi[0] = tr_read(pvb + ((0 ^ sw) * 64) + 8 * 128);
      UNROLL for (int c = 0; c < 4; ++c) {
        const int st = c >> 1, dt = c & 1, cb = c & 1, nb = cb ^ 1;
        if (c + 1 < 4) {
          const int st1 = (c + 1) >> 1, dt1 = (c + 1) & 1;
          lo[nb] = tr_read(pvb + st1 * 16 * 128 + ((dt1 ^ sw) * 64));
          hi[nb] = tr_read(pvb + st1 * 16 * 128 + ((dt1 ^ sw) * 64) + 8 * 128);
        }
        __builtin_amdgcn_sched_barrier(0);
        const bf16x8 vf = __builtin_shufflevector(lo[cb], hi[cb], 0, 1, 2, 3, 4, 5, 6, 7);
        o[0][dt] = MFMA(vf, pf0[st], o[0][dt]);
        o[1][dt] = MFMA(vf, pf1[st], o[1][dt]);
        __builtin_amdgcn_sched_barrier(0);
      }
    }
  }
}

DI void mla_task(const Params& p, int task, char* smem) {
  const int tid = ltid(), lane = tid & 63, w = tid >> 6, l31 = lane & 31, hh = lane >> 5;
  const int qb = 15 - (task >> 6), bh = task & 63, b = bh >> 3, h = bh & 7;
  const int q0 = qb * 256;
  u16* QM = (u16*)(p.ws + OFF_QM);
  const u16* KM = (const u16*)(p.ws + OFF_KM) + (size_t)bh * T * 64;
  const u16* VM = (const u16*)(p.ws + OFF_VM) + (size_t)bh * T * 64;
  const u16* KPE = (const u16*)(p.ws + OFF_KPE) + (size_t)b * T * 32;
  bf16x8 qf[2][4];
  int tq[2];
  const char* qlds = smem + 43008 + w * 4096 + lane * 16;
  UNROLL for (int qt = 0; qt < 2; ++qt) {
    tq[qt] = q0 + 64 * w + 32 * qt + l31;
    const u16* base = QM + (size_t)(b * T + tq[qt]) * 768;
    UNROLL for (int ks = 0; ks < 4; ++ks) qf[qt][ks] = *(const bf16x8*)(base + h * 64 + 16 * ks + 8 * hh);
    UNROLL for (int ks = 0; ks < 2; ++ks)
      *(bf16x8*)(smem + 43008 + w * 4096 + lane * 16 + (qt * 2 + ks) * 1024) = *(const bf16x8*)(base + 512 + h * 32 + 16 * ks + 8 * hh);
  }
  f32x16 o[2][2];
  UNROLL for (int a = 0; a < 2; ++a) UNROLL for (int c = 0; c < 2; ++c) zero16(o[a][c]);
  float mrun[2] = {NEGF, NEGF}, lrun[2] = {0.f, 0.f};
  const bool selb[2] = {true, true};
  const float sl2 = 0.10206207261596575f * LOG2E;
  const int nkt = (q0 >> 6) + 4, my_last = (q0 >> 6) + w;
  u32x4 rk[3], rv[2];
  const unsigned offa = (unsigned)tid * 16u;
  const unsigned offp = (unsigned)tid * 16u;
  auto gload = [&](int kt) {
    const char* kb = (const char*)(KM + (size_t)kt * 4096);
    const char* vb = (const char*)(VM + (size_t)kt * 4096);
    const char* pb = (const char*)(KPE + (size_t)kt * 2048);
    rk[0] = *(const u32x4*)(kb + offa);
    rk[1] = *(const u32x4*)(kb + offa + 4096u);
    rk[2] = *(const u32x4*)(pb + offp);
    rv[0] = *(const u32x4*)(vb + offa);
    rv[1] = *(const u32x4*)(vb + offa + 4096u);
  };
  auto sstore = [&](int s) {
    UNROLL for (int i = 0; i < 2; ++i) {
      const int c = tid + 256 * i, key = c >> 3, ch = c & 7;
      *(u32x4*)(smem + s * 13312 + key * 208 + ch * 16) = rk[i];
      *(u32x4*)(smem + 26624 + s * 8192 + key * 128 + ((ch ^ (4 * ((key >> 1) & 1))) * 16)) = rv[i];
    }
    *(u32x4*)(smem + s * 13312 + (tid >> 2) * 208 + 128 + (tid & 3) * 16) = rk[2];
  };
  gload(0);
  sstore(0);
  __syncthreads();
  _Pragma("unroll 1") for (int kt = 0; kt < nkt; ++kt) {
    const bool more = kt + 1 < nkt;
    if (more) gload(kt + 1);
    if (kt <= my_last) {
      const bool need_mask = (64 * kt + 63 > q0 + 64 * w);
      attn_tile<6, 208, 0, 4>(smem + (kt & 1) * 13312, smem + 26624 + (kt & 1) * 8192, qf, qlds, o, mrun, lrun, sl2, lane,
                           64 * kt, tq, need_mask, selb);
    }
    if (more) sstore((kt + 1) & 1);
    __syncthreads();
  }
  UNROLL for (int qt = 0; qt < 2; ++qt) {
    const float lt = xh_sum(lrun[qt]);
    const float inv = __builtin_amdgcn_rcpf(lt);
    u16* dst = (u16*)(p.ws + OFF_OM) + (size_t)(b * T + tq[qt]) * 512 + h * 64;
    UNROLL for (int dt = 0; dt < 2; ++dt) UNROLL for (int g4 = 0; g4 < 4; ++g4) {
      u32x2 v;
      v[0] = pk2(o[qt][dt][4 * g4 + 0] * inv, o[qt][dt][4 * g4 + 1] * inv);
      v[1] = pk2(o[qt][dt][4 * g4 + 2] * inv, o[qt][dt][4 * g4 + 3] * inv);
      *(u32x2*)(dst + 32 * dt + 8 * g4 + 4 * hh) = v;
    }
  }
}

template <int MODE>
DI void nsa_flash(const u16* __restrict__ Kg, const u16* __restrict__ Vg, int kt_lo, int kt_hi, int cur,
                  f32x16 (&o)[2][2], float (&mrun)[2], float (&lrun)[2], float sl2,
                  const int (&tq)[2], char* smem) {
  const bf16x8 qdummy[2][4] = {};
  const char* qlds = smem + 36864 + (ltid() >> 6) * 8192 + (ltid() & 63) * 16;
  const int tid = ltid(), lane = tid & 63;
  const unsigned* selw = (const unsigned*)(smem + 69632 + 8192);
  u32x4 rk[2], rv[2];
  const unsigned offa = (unsigned)tid * 16u;
  auto gload = [&](int kt) {
    const char* kb = (const char*)(Kg + (size_t)kt * 4096);
    const char* vb = (const char*)(Vg + (size_t)kt * 4096);
    rk[0] = *(const u32x4*)(kb + offa);
    rk[1] = *(const u32x4*)(kb + offa + 4096u);
    rv[0] = *(const u32x4*)(vb + offa);
    rv[1] = *(const u32x4*)(vb + offa + 4096u);
  };
  auto sstore = [&](int s) {
    UNROLL for (int i = 0; i < 2; ++i) {
      const int c = tid + 256 * i, key = c >> 3, ch = c & 7;
      *(u32x4*)(smem + s * 9216 + key * 144 + ch * 16) = rk[i];
      *(u32x4*)(smem + 18432 + s * 8192 + key * 128 + ((ch ^ (4 * ((key >> 1) & 1))) * 16)) = rv[i];
    }
  };
  gload(kt_lo);
  sstore(0);
  __syncthreads();
  _Pragma("unroll 1") for (int kt = kt_lo; kt <= kt_hi; ++kt) {
    const int s = (kt - kt_lo) & 1;
    const bool more = kt < kt_hi;
    if (more) gload(kt + 1);
    bool selb[2] = {true, true};
    if (MODE == 1) {
      selb[0] = (selw[(tq[0] & 63) * 2 + (kt >> 5)] >> (kt & 31)) & 1u;
      selb[1] = (selw[(tq[1] & 63) * 2 + (kt >> 5)] >> (kt & 31)) & 1u;
    }
    const bool need_mask = (kt == cur) || (MODE == 2 && kt == cur - 8);
    attn_tile<4, 144, MODE, 0>(smem + s * 9216, smem + 18432 + s * 8192, qdummy, qlds, o, mrun, lrun, sl2, lane,
                                  64 * kt, tq, need_mask, selb);
    if (more) sstore(s ^ 1);
    __syncthreads();
  }
}

DI void nsa_task(const Params& p, int task, char* smem) {
  const int tid = ltid(), lane = tid & 63, w = tid >> 6, l31 = lane & 31, hh = lane >> 5;
  const int cur = 63 - (task >> 4), bg = task & 15, b = bg >> 1, g = bg & 1;
  u16* QN = (u16*)(p.ws + OFF_QN);
  const u16* KV6 = (const u16*)(p.ws + OFF_KV6);
  const float* GATES = (const float*)(p.ws + OFF_GATES);
  const u16* KC = (const u16*)(p.ws + OFF_KC) + (size_t)bg * 256 * 64;
  const u16* VC = (const u16*)(p.ws + OFF_VC) + (size_t)bg * 256 * 64;
  const int head = 4 * g + (l31 & 3);
  bf16x8 qf[2][4];
  int tq[2];
  UNROLL for (int qt = 0; qt < 2; ++qt) {
    tq[qt] = 64 * cur + 16 * w + 8 * qt + (l31 >> 2);
    const u16* base = QN + (size_t)(b * T + tq[qt]) * 512 + head * 64;
    UNROLL for (int ks = 0; ks < 4; ++ks) qf[qt][ks] = *(const bf16x8*)(base + 16 * ks + 8 * hh);
  }
  const float sl2 = 0.125f * LOG2E;
  unsigned long long* selm = (unsigned long long*)(smem + 69632 + 8192);
  char* R1 = smem;
  char* R2 = smem + 36864;
  float* impw = (float*)(smem + 69632) + w * 512;
  {
    UNROLL for (int i = 0; i < 8; ++i) {
      const int c = tid + 256 * i, key = c >> 3, ch = c & 7;
      u32x4 kk = *(const u32x4*)(KC + (size_t)c * 8);
      u32x4 vv = *(const u32x4*)(VC + (size_t)c * 8);
      *(u32x4*)(R1 + (key >> 6) * 9216 + (key & 63) * 144 + ch * 16) = kk;
      *(u32x4*)(R2 + (key >> 6) * 8192 + (key & 63) * 128 + ((ch ^ (4 * ((key >> 1) & 1))) * 16)) = vv;
    }
    __syncthreads();
    const int blk = (lane >> 4) & 1, q4 = (lane & 15) >> 2, p4 = lane & 3, sw = (q4 >> 1) & 1;
    UNROLL for (int qt = 0; qt < 2; ++qt) {
      const int cmh = ((tq[qt] - 31) >> 4) - 4 * hh;
      float mx = NEGF, lsum = 0.f;
      UNROLL for (int a = 0; a < 8; ++a) {
        f32x16 sa;
        zero16(sa);
        const char* pk = R1 + (a >> 1) * 9216 + (32 * (a & 1) + l31) * 144 + hh * 16;
        {
          bf16x8 kf4[4];
          UNROLL for (int ks = 0; ks < 4; ++ks) kf4[ks] = *(const bf16x8*)(pk + ks * 32);
          __builtin_amdgcn_sched_barrier(0);
          UNROLL for (int ks = 0; ks < 4; ++ks) sa = MFMA(kf4[ks], qf[qt][ks], sa);
        }
        float tm = NEGF;
        UNROLL for (int i = 0; i < 16; ++i) {
          const int c = 32 * a + 8 * (i >> 2) + (i & 3);
          const float x = (c <= cmh) ? sa[i] * sl2 : NEGF;
          sa[i] = x;
          tm = fmaxf(tm, x);
        }
        const float mnew = fmaxf(mx, tm);
        float ts = 0.f;
        UNROLL for (int i = 0; i < 16; ++i) ts += ex2(sa[i] - mnew);
        lsum = lsum * ex2(mx - mnew) + ts;
        mx = mnew;
      }
      {
        const float mo = xh_get(mx, hh), lo = xh_get(lsum, hh);
        const float mt = fmaxf(mx, mo);
        lsum = lsum * ex2(mx - mt) + lo * ex2(mo - mt);
        mx = mt;
      }
      const float inv = (mx > -1e29f) ? 1.f / lsum : 0.f;
      float lastprev = 0.f;
      f32x16 oc[2];
      zero16(oc[0]);
      zero16(oc[1]);
      UNROLL for (int a = 0; a < 8; ++a) {
        f32x16 sa;
        zero16(sa);
        const char* pk = R1 + (a >> 1) * 9216 + (32 * (a & 1) + l31) * 144 + hh * 16;
        {
          bf16x8 kf4[4];
          UNROLL for (int ks = 0; ks < 4; ++ks) kf4[ks] = *(const bf16x8*)(pk + ks * 32);
          __builtin_amdgcn_sched_barrier(0);
          UNROLL for (int ks = 0; ks < 4; ++ks) sa = MFMA(kf4[ks], qf[qt][ks], sa);
        }
        UNROLL for (int i = 0; i < 16; ++i) {
          const int c = 32 * a + 8 * (i >> 2) + (i & 3);
          sa[i] = (c <= cmh) ? ex2(sa[i] * sl2 - mx) * inv : 0.f;
        }
        UNROLL for (int q = 0; q < 4; ++q) {
          const int gi = 4 * a + q;
          const float g4 = sa[4 * q] + sa[4 * q + 1] + sa[4 * q + 2] + sa[4 * q + 3];
          const float lastcur = sa[4 * q + 3];
          const float tosend = hh ? lastprev : lastcur;
          const float recv = xh_get(tosend, hh);
          const float im = quad_sum(g4 + recv);
          if ((l31 & 3) == (gi & 3)) impw[(l31 >> 2) * 64 + 2 * gi + hh] = im;
          lastprev = lastcur;
        }
        {
          s16x4 vlo[4], vhi[4];
          UNROLL for (int c = 0; c < 4; ++c) {
            const int st = c >> 1, dt = c & 1;
            const char* pv = R2 + (a >> 1) * 8192 + (32 * (a & 1) + 16 * st + 4 * hh + q4) * 128 + ((dt ^ sw) * 64) + (16 * blk + 4 * p4) * 2;
            vlo[c] = tr_read(pv);
            vhi[c] = tr_read(pv + 8 * 128);
          }
          const bf16x8 pfa = pack8(sa, 0), pfb = pack8(sa, 1);
          __builtin_amdgcn_sched_barrier(0);
          UNROLL for (int c = 0; c < 4; ++c) {
            const bf16x8 vf = __builtin_shufflevector(vlo[c], vhi[c], 0, 1, 2, 3, 4, 5, 6, 7);
            oc[c & 1] = MFMA(vf, (c >> 1) ? pfb : pfa, oc[c & 1]);
          }
        }
      }
      __syncthreads();
      if (cur >= 16) {
        unsigned* keyw = (unsigned*)impw;
        UNROLL for (int t8 = 0; t8 < 8; ++t8) {
          const float v = impw[t8 * 64 + lane];
          const int j = lane;
          unsigned key = (__float_as_uint(v) & ~63u) | (unsigned)(63 - j);
          if (j == 0 || j == cur || j == cur - 1) key = 0x7f800000u | (unsigned)(63 - j);
          else if (j > cur) key = (unsigned)(63 - j);
          keyw[t8 * 64 + lane] = key;
        }
        __syncthreads();
        _Pragma("unroll 1") for (int t8 = 0; t8 < 8; ++t8) {
          const unsigned key = keyw[t8 * 64 + lane];
          int rank = 0;
          UNROLL for (int c4 = 0; c4 < 16; ++c4) {
            const u32x4 kk = *(const u32x4*)(keyw + t8 * 64 + c4 * 4);
            rank += (kk[0] > key) ? 1 : 0;
            rank += (kk[1] > key) ? 1 : 0;
            rank += (kk[2] > key) ? 1 : 0;
            rank += (kk[3] > key) ? 1 : 0;
          }
          const unsigned long long mk = __ballot(rank < 16);
          if (lane == 0) selm[16 * w + 8 * qt + t8] = mk;
        }
      } else {
        if (lane < 8) selm[16 * w + 8 * qt + lane] = ~0ull;
      }
      __syncthreads();
      int zq = 0;
      asm volatile("" : "+v"(zq));
      const int rowq = b * T + tq[qt] + zq;
      const float g0 = GATES[(size_t)rowq * 24 + head * 3 + 0];
      u16* dst = (u16*)(p.ws + OFF_ON) + (size_t)rowq * 512 + head * 64;
      UNROLL for (int dt = 0; dt < 2; ++dt) UNROLL for (int g4 = 0; g4 < 4; ++g4) {
        u32x2 v;
        v[0] = pk2(oc[dt][4 * g4 + 0] * g0, oc[dt][4 * g4 + 1] * g0);
        v[1] = pk2(oc[dt][4 * g4 + 2] * g0, oc[dt][4 * g4 + 3] * g0);
        *(u32x2*)(dst + 32 * dt + 8 * g4 + 4 * hh) = v;
      }
    }
    __syncthreads();
  }
  {
    char* qdst = smem + 36864 + w * 8192 + lane * 16;
    UNROLL for (int qt = 0; qt < 2; ++qt) UNROLL for (int ks = 0; ks < 4; ++ks) *(bf16x8*)(qdst + (qt * 4 + ks) * 1024) = qf[qt][ks];
  }
  __syncthreads();
  UNROLL for (int br = 1; br <= 2; ++br) {
    f32x16 o[2][2];
    UNROLL for (int a = 0; a < 2; ++a) UNROLL for (int c = 0; c < 2; ++c) zero16(o[a][c]);
    float mrun[2] = {NEGF, NEGF}, lrun[2] = {0.f, 0.f};
    const u16* Kg = KV6 + ((size_t)((2 * br) * 16 + bg) * T) * 64;
    const u16* Vg = KV6 + ((size_t)((2 * br + 1) * 16 + bg) * T) * 64;
    if (br == 1) nsa_flash<1>(Kg, Vg, 0, cur, cur, o, mrun, lrun, sl2, tq, smem);
    else nsa_flash<2>(Kg, Vg, cur > 8 ? cur - 8 : 0, cur, cur, o, mrun, lrun, sl2, tq, smem);
    UNROLL for (int qt = 0; qt < 2; ++qt) {
      const float lt = xh_sum(lrun[qt]);
      int zq = 0;
      asm volatile("" : "+v"(zq));
      const int rowq = b * T + tq[qt] + zq;
      const float gt = GATES[(size_t)rowq * 24 + head * 3 + br];
      const float inv = gt * __builtin_amdgcn_rcpf(lt);
      u16* dst = (u16*)(p.ws + OFF_ON) + (size_t)rowq * 512 + head * 64;
      UNROLL for (int dt = 0; dt < 2; ++dt) UNROLL for (int g4 = 0; g4 < 4; ++g4) {
        u32x2* pd = (u32x2*)(dst + 32 * dt + 8 * g4 + 4 * hh);
        const u32x2 old = *pd;
        u32x2 v;
        v[0] = pk2(o[qt][dt][4 * g4 + 0] * inv + __uint_as_float(old[0] << 16),
                   o[qt][dt][4 * g4 + 1] * inv + __uint_as_float(old[0] & 0xffff0000u));
        v[1] = pk2(o[qt][dt][4 * g4 + 2] * inv + __uint_as_float(old[1] << 16),
                   o[qt][dt][4 * g4 + 3] * inv + __uint_as_float(old[1] & 0xffff0000u));
        *pd = v;
      }
    }
  }
}

DI void phase_attn(const Params& p, int layer, char* smem, char* smem_blk) {
  int* cnt = (int*)(p.ws + OFF_CNT) + layer;
  int* s_task = (int*)(smem_blk + 2 * VSMEM);
  const int half = vhalf();
  for (;;) {
    if (__builtin_amdgcn_workitem_id_x() == 0) *s_task = atomicAdd(cnt, 2);
    __syncthreads();
    const int task = *s_task + half;
    __syncthreads();
    if (task >= 2048) break;
    if (task < 1024) mla_task(p, task, smem);
    else nsa_task(p, task - 1024, smem);
  }
}

DI void phase_proj(const Params& p, int layer, char* smem) {
  EPI_VARS
  const u16* WL = (const u16*)(p.ws + OFF_W) + (size_t)layer * W_LAYER;
  const u16* OM = (const u16*)(p.ws + OFF_OM);
  const u16* ON = (const u16*)(p.ws + OFF_ON);
  const u16* GM = (const u16*)(p.ws + OFF_GM);
  const u16* GN = (const u16*)(p.ws + OFF_GN);
  u16* Yb = (u16*)(p.ws + OFF_XB);
  const int ntn = 8, ntiles = 256 * ntn;
  for (int tile = vbid(); tile < ntiles; tile += nvb()) {
    const int tm = tile / ntn, tn = tile % ntn;
    f32x16 acc[2][2];
    UNROLL for (int a = 0; a < 2; ++a) UNROLL for (int b = 0; b < 2; ++b) zero16(acc[a][b]);
    gemm_main(OM + (size_t)tm * 128 * 512, 512, WL + W_PM + (size_t)tn * 128 * 512, 512, 512, acc, smem);
    {
      int z1 = 0;
      asm volatile("" : "+v"(z1)::"memory");
      UNROLL for (int mi = 0; mi < 2; ++mi) UNROLL for (int ni = 0; ni < 2; ++ni) UNROLL for (int i = 0; i < 16; ++i) {
        if ((i & 3) == 0) asm volatile("" ::: "memory");
        const int row = tm * 128 + EROW(mi, i) + z1;
        const size_t idx = (size_t)row * 1024 + tn * 128 + wc * 64 + ni * 32 + l31;
        acc[mi][ni][i] *= bf2f(GM[idx]) * __builtin_amdgcn_rcpf(bf2f(GN[idx]));
      }
    }
    gemm_main(ON + (size_t)tm * 128 * 512, 512, WL + W_PN + (size_t)tn * 128 * 512, 512, 512, acc, smem);
    int z2 = 0;
    asm volatile("" : "+v"(z2)::"memory");
    UNROLL for (int mi = 0; mi < 2; ++mi) UNROLL for (int ni = 0; ni < 2; ++ni) UNROLL for (int i = 0; i < 16; ++i) {
      const int row = tm * 128 + EROW(mi, i) + z2;
      const size_t idx = (size_t)row * 1024 + tn * 128 + wc * 64 + ni * 32 + l31;
      if ((i & 3) == 0) asm volatile("" ::: "memory");
      const float y = bf2f(GN[idx]) * acc[mi][ni][i];
      Yb[idx] = f2bf(y);
    }
  }
}

#define XB_TMO      128
#define XB_XCNT(j)  (256  + 64 * (j))
#define XB_XSUB(j)  (1280 + 64 * (j))
#define XB_XGEN(j)  (2304 + 64 * (j))
#define XB_TOP      3328
#define XB_TOPGEN   3392
#define XCD_BAR_WORDS 3456
#define XB_SPIN_CAP (1u << 18)
#define LAS __attribute__((address_space(3)))

__device__ __forceinline__ unsigned xb_ld(unsigned* p)              { return __hip_atomic_load(p, __ATOMIC_RELAXED, __HIP_MEMORY_SCOPE_AGENT); }
__device__ __forceinline__ unsigned xb_add(unsigned* p, unsigned v) { return __hip_atomic_fetch_add(p, v, __ATOMIC_RELAXED, __HIP_MEMORY_SCOPE_AGENT); }
__device__ __forceinline__ unsigned xb_xcc_id() { return (unsigned)__builtin_amdgcn_s_getreg((3 << 11) | 20) & 0xFu; }
#define XB_SPIN(cond, bar) do { unsigned _sp = 0; while (cond) { __builtin_amdgcn_s_sleep(1); \
    if ((++_sp & 255u) == 0u) { if (xb_ld(&(bar)[XB_TMO])) break; if (_sp > XB_SPIN_CAP) { atomicAdd(&(bar)[XB_TMO], 1u); break; } } } } while (0)

struct XcdBarrier {
    unsigned* bar; unsigned x;
    volatile LAS unsigned* st;
};

__device__ __forceinline__ XcdBarrier xcd_barrier_post(unsigned* bar, volatile LAS unsigned* st) {
    XcdBarrier b; b.bar = bar; b.x = xb_xcc_id(); b.st = st;
    if (threadIdx.x == 0) (void)xb_add(&bar[XB_XCNT(b.x)], 1u);
    return b;
}
__device__ __forceinline__ void xcd_barrier_complete(unsigned* bar, unsigned x, unsigned& nloc, unsigned& nx) {
    const unsigned G = gridDim.x * gridDim.y * gridDim.z;
    unsigned sum, cnt, mine, sp = 0u;
    for (;;) {
        sum = 0u; cnt = 0u; mine = 0u;
#pragma unroll
        for (unsigned j = 0; j < 16; ++j) { const unsigned c = xb_ld(&bar[XB_XCNT(j)]); sum += c; cnt += (c > 0u) ? 1u : 0u; mine = (j == x) ? c : mine; }
        if (sum == G) break;
        __builtin_amdgcn_s_sleep(1);
        if ((++sp & 255u) == 0u) { if (xb_ld(&bar[XB_TMO])) break; if (sp > XB_SPIN_CAP) { atomicAdd(&bar[XB_TMO], 1u); break; } }
    }
    nloc = mine > 0u ? mine : 1u; nx = cnt > 0u ? cnt : 1u;
}

__device__ __forceinline__ void xcd_barrier(const XcdBarrier& b) {
    asm volatile("s_waitcnt vmcnt(0)" ::: "memory");
    __syncthreads();
    if (threadIdx.x == 0) {
        unsigned* bar = b.bar;
        __builtin_amdgcn_s_waitcnt(0);
        unsigned nloc = b.st[0], nx = b.st[1];
        if (nloc == 0u) { xcd_barrier_complete(bar, b.x, nloc, nx); b.st[0] = nloc; b.st[1] = nx; }
        const unsigned old = xb_add(&bar[XB_XSUB(b.x)], 1u);
        const unsigned gen = old / nloc;
        if (old + 1u == (gen + 1u) * nloc) {
            __builtin_amdgcn_fence(__ATOMIC_RELEASE, "agent");
            asm volatile("s_waitcnt vmcnt(0)" ::: "memory");
            const unsigned og = xb_add(&bar[XB_TOP], 1u);
            const unsigned tg = og / nx;
            if (og + 1u == (tg + 1u) * nx) xb_add(&bar[XB_TOPGEN], 1u);
            else XB_SPIN(xb_ld(&bar[XB_TOPGEN]) == tg, bar);
            __builtin_amdgcn_fence(__ATOMIC_ACQUIRE, "agent");
            xb_add(&bar[XB_XGEN(b.x)], 1u);
            asm volatile("s_waitcnt vmcnt(0)" ::: "memory");
        } else {
            XB_SPIN(xb_ld(&bar[XB_XGEN(b.x)]) == gen, bar);
            __builtin_amdgcn_fence(__ATOMIC_ACQUIRE, "agent");
            asm volatile("s_waitcnt vmcnt(0)" ::: "memory");
        }
    }
    __syncthreads();
}

#define GSYNC xcd_barrier(xb)
#define LAYER(layer)                                                                                              \
  {                                                                                                               \
    const u16* WL = (const u16*)(p.ws + OFF_W) + (size_t)(layer) * W_LAYER;                                       \
    const u16* XB = (const u16*)(p.ws + OFF_XB);                                                                  \
    const u16* HB = (const u16*)(p.ws + OFF_H);                                                                   \
    big_gemm(XB, WL + W_UP1, 5632, 1024, EpiSwiglu{(u16*)(p.ws + OFF_H)}, smem_blk); GSYNC;                       \
    big_gemm<true, true>(HB, WL + W_DN1, 1024, FF, EpiResid{(layer) == 0 ? p.in[0] : p.out, p.out, 0.5f}, smem_blk); GSYNC;                                   \
    bias_reduce(p); phase_ln(p, p.in[1] + (layer) * DM, p.in[2] + (layer) * DM); GSYNC;                                          \
    big_gemm(XB, WL + W_IN, 3840, 1024, EpiWin{p.ws}, smem_blk); GSYNC;                                           \
    phase_up_cmp(p, layer, smem); GSYNC;                                                                          \
    phase_attn(p, layer, smem, smem_blk); GSYNC;                                                                  \
    big_gemm((const u16*)(p.ws + OFF_OM), WL + W_PM, 1024, 512, EpiGate1{(u16*)(p.ws + OFF_GM)}, smem_blk); GSYNC; big_gemm((const u16*)(p.ws + OFF_ON), WL + W_PN, 1024, 512, EpiGate2{(const u16*)(p.ws + OFF_GM), (const u16*)(p.ws + OFF_GN), (u16*)(p.ws + OFF_XB)}, smem_blk); GSYNC;                                                                           \
    big_gemm(XB, WL + W_OUT, 1024, 1024, EpiResid{p.out, p.out, 1.0f}, smem_blk); GSYNC;        \
    phase_ln(p, p.in[22] + (layer) * DM, p.in[23] + (layer) * DM); GSYNC;                                         \
    big_gemm(XB, WL + W_UP2, 5632, 1024, EpiSwiglu{(u16*)(p.ws + OFF_H)}, smem_blk); GSYNC;                       \
    big_gemm<true, true>(HB, WL + W_DN2, 1024, FF, EpiResid{p.out, p.out, 0.5f}, smem_blk); GSYNC;                                   \
    if ((layer) == 1) phase_ln<false>(p, p.in[27] + (layer) * DM, p.in[28] + (layer) * DM);                       \
    else phase_ln(p, p.in[27] + (layer) * DM, p.in[28] + (layer) * DM);                                           \
  }

__global__ void __launch_bounds__(512, 2) mega(Params p) {
  __shared__ __attribute__((aligned(16))) char smem_blk[SMEM_BYTES];
  char* smem = smem_blk + vhalf() * VSMEM;
  cg::grid_group grid = cg::this_grid();
  volatile LAS unsigned* st = (volatile LAS unsigned*)(smem_blk + 2 * VSMEM + 16);
  if (threadIdx.x == 0) { st[0] = 0u; st[1] = 0u; }
  __syncthreads();
  const XcdBarrier xb = xcd_barrier_post((unsigned*)(p.ws + OFF_BAR), st);
  phase_init(p, smem);
  if (p.ws == nullptr) grid.sync();
  GSYNC;
  LAYER(0)
  GSYNC;
  LAYER(1)
}

extern "C" void kernel_launch(void* const* d_in, const int* in_sizes, int n_in, void* d_out, int out_size, void* d_ws,
                              size_t ws_size, hipStream_t stream) {
  Params p{};
  for (int i = 0; i < 29; ++i) p.in[i] = (const float*)d_in[i];
  p.out = (float*)d_out;
  p.ws = (char*)d_ws;
  if (ws_size < WS_NEED) fprintf(stderr, "workspace too small: %zu < %zu\n", ws_size, (size_t)WS_NEED);
  static int grid_blocks = 0;
  if (!grid_blocks) {
    int dev = 0, cus = 0, per_cu = 0;
    hipGetDevice(&dev);
    hipDeviceGetAttribute(&cus, hipDeviceAttributeMultiprocessorCount, dev);
    hipOccupancyMaxActiveBlocksPerMultiprocessor(&per_cu, mega, 512, 0);
    if (per_cu < 1) per_cu = 1;
    if (per_cu > 1) per_cu = 1;
    grid_blocks = cus * per_cu;
  }
  (void)hipMemsetAsync((char*)d_ws + OFF_BAR, 0, XCD_BAR_WORDS * 4, stream);
  void* args[] = {&p};
  hipError_t e = hipLaunchCooperativeKernel((void*)mega, dim3(grid_blocks), dim3(512), args, 0, stream);
  if (e != hipSuccess) fprintf(stderr, "cooperative launch failed: %s (grid %d)\n", hipGetErrorString(e), grid_blocks);
}
```

```cpp
#include <hip/hip_runtime.h>
#include <hip/hip_cooperative_groups.h>
#include <stdint.h>
#include <stdio.h>
namespace cg = cooperative_groups;

#ifndef MULTI
#define MULTI 0
#endif

typedef unsigned short u16;
typedef __attribute__((ext_vector_type(8))) short bf16x8;
typedef __attribute__((ext_vector_type(4))) short s16x4;
typedef __attribute__((ext_vector_type(16))) float f32x16;
typedef __attribute__((ext_vector_type(4))) unsigned u32x4;
typedef __attribute__((ext_vector_type(2))) unsigned u32x2;
typedef __attribute__((ext_vector_type(2))) __bf16 bf2_t;
#define DI __device__ __forceinline__
#define MFMA(a, b, c) __builtin_amdgcn_mfma_f32_32x32x16_bf16((a), (b), (c), 0, 0, 0)
#define UNROLL _Pragma("unroll")

constexpr int NB = 8, T = 4096, DM = 1024, M = NB * T, FF = 2816;
constexpr float ALPHA = 1.4142135623730951f;
constexpr float NEGF = -1e30f;
constexpr float NEGR = -30000.f;
constexpr float LOG2E = 1.4426950408889634f;

constexpr size_t W_UP1 = 0;
constexpr size_t W_DN1 = W_UP1 + (size_t)5632 * 1024;
constexpr size_t W_IN = W_DN1 + (size_t)1024 * 2816;
constexpr size_t W_UQ = W_IN + (size_t)3840 * 1024;
constexpr size_t W_UKV = W_UQ + (size_t)768 * 256;
constexpr size_t W_CK1 = W_UKV + (size_t)1024 * 128;
constexpr size_t W_CK2 = W_CK1 + (size_t)128 * 2048;
constexpr size_t W_CV1 = W_CK2 + (size_t)64 * 128;
constexpr size_t W_CV2 = W_CV1 + (size_t)128 * 2048;
constexpr size_t W_PM = W_CV2 + (size_t)64 * 128;
constexpr size_t W_PN = W_PM + (size_t)1024 * 512;
constexpr size_t W_OUT = W_PN + (size_t)1024 * 512;
constexpr size_t W_UP2 = W_OUT + (size_t)1024 * 1024;
constexpr size_t W_DN2 = W_UP2 + (size_t)5632 * 1024;
constexpr size_t W_LAYER = W_DN2 + (size_t)1024 * 2816;

constexpr size_t al256(size_t x) { return (x + 255) & ~(size_t)255; }
constexpr size_t OFF_W = 0;
constexpr size_t OFF_BIAS = al256(OFF_W + 2 * W_LAYER * 2);
constexpr size_t OFF_COSN = al256(OFF_BIAS + 2 * 2 * 128 * 4);
constexpr size_t OFF_SINN = OFF_COSN + (size_t)T * 8 * 4;
constexpr size_t OFF_COSM = OFF_SINN + (size_t)T * 8 * 4;
constexpr size_t OFF_SINM = OFF_COSM + (size_t)T * 16 * 4;
constexpr size_t OFF_CNT = OFF_SINM + (size_t)T * 16 * 4;
constexpr size_t OFF_BAR = al256(OFF_CNT + 256);
constexpr size_t OFF_PART = al256(OFF_BAR + 3456 * 4);
constexpr size_t OFF_XB = al256(OFF_PART + (size_t)4 * 128 * 128 * 4);
constexpr size_t OFF_KM = OFF_XB;
constexpr size_t OFF_VM = OFF_XB + (size_t)M * 512 * 2;
constexpr size_t OFF_BIG = al256(OFF_XB + (size_t)M * 1024 * 2);
constexpr size_t OFF_H = OFF_BIG;
constexpr size_t OFF_CQ = OFF_BIG;
constexpr size_t OFF_CKV = OFF_CQ + (size_t)M * 256 * 2;
constexpr size_t OFF_QN = OFF_CKV + (size_t)M * 128 * 2;
constexpr size_t OFF_KV6 = OFF_QN + (size_t)M * 512 * 2;
constexpr size_t OFF_KPE = OFF_KV6 + (size_t)6 * M * 128 * 2;
constexpr size_t OFF_GATES = OFF_KPE + (size_t)M * 32 * 2;
constexpr size_t OFF_QM = OFF_GATES + (size_t)M * 24 * 4;
constexpr size_t OFF_GM = OFF_QM + (size_t)M * 768 * 2;
constexpr size_t OFF_GN = OFF_GM + (size_t)M * 1024 * 2;
constexpr size_t OFF_KC = OFF_GN + (size_t)M * 1024 * 2;
constexpr size_t OFF_VC = OFF_KC + (size_t)16 * 256 * 64 * 2;
constexpr size_t OFF_OM = al256(OFF_VC + (size_t)16 * 256 * 64 * 2 + 65536);
constexpr size_t OFF_ON = OFF_OM + (size_t)M * 512 * 2;
constexpr size_t OFF_MIXEND = OFF_ON + (size_t)M * 512 * 2;
constexpr size_t OFF_HEND = OFF_H + (size_t)M * FF * 2;
constexpr size_t WS_NEED = OFF_MIXEND > OFF_HEND ? OFF_MIXEND : OFF_HEND;

constexpr int VSMEM = 69632 + 8192 + 512;
constexpr int SMEM_BYTES = 2 * VSMEM + 64;

struct Params {
  const float* in[29];
  float* out;
  char* ws;
};

DI int ltid() {
  int t = __builtin_amdgcn_workitem_id_x() & 255;
  asm volatile("" : "+v"(t));
  return t;
}
DI size_t lz() {
  size_t z = 0;
  asm volatile("" : "+s"(z));
  return z;
}
DI int vhalf() {
  int t = __builtin_amdgcn_workitem_id_x();
  asm volatile("" : "+v"(t));
  return __builtin_amdgcn_readfirstlane(t >> 8);
}
DI int vbid() { return (int)blockIdx.x * 2 + vhalf(); }
DI int nvb() { return (int)gridDim.x * 2; }
typedef __attribute__((ext_vector_type(4))) float f32x4_nt;
DI float bf2f(u16 h) { return __uint_as_float(((unsigned)h) << 16); }
DI unsigned pk2(float a, float b) {
  bf2_t v;
  v[0] = (__bf16)a;
  v[1] = (__bf16)b;
  return __builtin_bit_cast(unsigned, v);
}
DI u16 f2bf(float a) { return (u16)(pk2(a, 0.f) & 0xffffu); }
DI float ex2(float x) { return __builtin_amdgcn_exp2f(x); }
DI float sigmoidf_(float x) { return __builtin_amdgcn_rcpf(1.f + __expf(-x)); }
DI bf16x8 pack8(const f32x16& v, int st) {
  u32x4 p;
  p[0] = pk2(v[8 * st + 0], v[8 * st + 1]);
  p[1] = pk2(v[8 * st + 2], v[8 * st + 3]);
  p[2] = pk2(v[8 * st + 4], v[8 * st + 5]);
  p[3] = pk2(v[8 * st + 6], v[8 * st + 7]);
  return __builtin_bit_cast(bf16x8, p);
}
DI s16x4 tr_read(const char* p) {
  return __builtin_amdgcn_ds_read_tr16_b64_v4i16((__attribute__((address_space(3))) s16x4*)(p));
}
DI float xh_max(float x) {
  const auto r = __builtin_amdgcn_permlane32_swap(__float_as_uint(x), __float_as_uint(x), false, false);
  return fmaxf(__uint_as_float(r[0]), __uint_as_float(r[1]));
}
DI float xh_sum(float x) {
  const auto r = __builtin_amdgcn_permlane32_swap(__float_as_uint(x), __float_as_uint(x), false, false);
  return __uint_as_float(r[0]) + __uint_as_float(r[1]);
}
DI float xh_get(float x, int hh) {
  const auto r = __builtin_amdgcn_permlane32_swap(__float_as_uint(x), __float_as_uint(x), false, false);
  return hh ? __uint_as_float(r[0]) : __uint_as_float(r[1]);
}
DI float quad_sum(float x) {
  x += __int_as_float(__builtin_amdgcn_update_dpp(0, __float_as_int(x), 0xB1, 0xF, 0xF, true));
  x += __int_as_float(__builtin_amdgcn_update_dpp(0, __float_as_int(x), 0x4E, 0xF, 0xF, true));
  return x;
}
DI void zero16(f32x16& v) {
  float z = 0.f;
  asm volatile("" : "+v"(z));
  UNROLL for (int i = 0; i < 16; ++i) v[i] = z;
}

DI void gemm_main(const u16* __restrict__ A, int lda, const u16* __restrict__ Bt, int ldb, int K,
                  f32x16 (&acc)[2][2], char* smem) {
  const int tid = ltid(), lane = tid & 63, w = tid >> 6, wr = w >> 1, wc = w & 1;
  const int lrow = tid >> 3, lch = tid & 7;
  const u16* ga = A + (size_t)lrow * lda + lch * 8;
  const u16* gb = Bt + (size_t)lrow * ldb + lch * 8;
  u32x4 ra[4], rb[4];
  UNROLL for (int i = 0; i < 4; ++i) {
    ra[i] = *(const u32x4*)(ga + (size_t)(32 * i) * lda);
    rb[i] = *(const u32x4*)(gb + (size_t)(32 * i) * ldb);
  }
  {
    char* pa = smem + lrow * 144 + lch * 16;
    UNROLL for (int i = 0; i < 4; ++i) {
      *(u32x4*)(pa + i * 32 * 144) = ra[i];
      *(u32x4*)(pa + 18432 + i * 32 * 144) = rb[i];
    }
  }
  __syncthreads();
  const int nk = K >> 6;
  _Pragma("unroll 1") for (int kt = 0; kt < nk; ++kt) {
    const bool more = (kt + 1 < nk);
    if (more) {
      const int k0 = (kt + 1) << 6;
      UNROLL for (int i = 0; i < 4; ++i) {
        ra[i] = *(const u32x4*)(ga + (size_t)(32 * i) * lda + k0);
        rb[i] = *(const u32x4*)(gb + (size_t)(32 * i) * ldb + k0);
      }
    }
    const char* pa = smem + (kt & 1) * 36864 + (wr * 64 + (lane & 31)) * 144 + (lane >> 5) * 16;
    const char* pb = smem + (kt & 1) * 36864 + 18432 + (wc * 64 + (lane & 31)) * 144 + (lane >> 5) * 16;
    UNROLL for (int ks = 0; ks < 4; ++ks) {
      bf16x8 a0 = *(const bf16x8*)(pa + ks * 32);
      bf16x8 a1 = *(const bf16x8*)(pa + 32 * 144 + ks * 32);
      bf16x8 b0 = *(const bf16x8*)(pb + ks * 32);
      bf16x8 b1 = *(const bf16x8*)(pb + 32 * 144 + ks * 32);
      acc[0][0] = MFMA(a0, b0, acc[0][0]);
      acc[0][1] = MFMA(a0, b1, acc[0][1]);
      acc[1][0] = MFMA(a1, b0, acc[1][0]);
      acc[1][1] = MFMA(a1, b1, acc[1][1]);
    }
    if (more) {
      char* pw = smem + ((kt + 1) & 1) * 36864 + lrow * 144 + lch * 16;
      UNROLL for (int i = 0; i < 4; ++i) {
        *(u32x4*)(pw + i * 32 * 144) = ra[i];
        *(u32x4*)(pw + 18432 + i * 32 * 144) = rb[i];
      }
    }
    __syncthreads();
  }
}

#define EPI_VARS const int tid = ltid(), lane = tid & 63, w = tid >> 6, wr = w >> 1, wc = w & 1, l31 = lane & 31, hh = lane >> 5; (void)l31; (void)hh; (void)wr; (void)wc;
#define EROW(mi, i) (wr * 64 + (mi) * 32 + 8 * ((i) >> 2) + 4 * hh + ((i) & 3))

DI void convT(const float* __restrict__ src0, const float* __restrict__ src1, int ldsrc, int K, int Nout,
              int kind, const float* __restrict__ scale, u16* __restrict__ dst, char* smem, int slab) {
  float* t = (float*)smem;
  const int tid = ltid();
  const int tiles_n = (Nout + 255) >> 8, tiles_k = K >> 6;
  for (int tile = vbid(); tile < tiles_n * tiles_k; tile += nvb()) {
    const int tn = tile % tiles_n, tk = tile / tiles_n;
    {
      const int nn = tid, n = tn * 256 + nn;
      const float* src = src0;
      int col = n;
      if (kind == 1) {
        const int j = n >> 8, r = n & 255;
        col = 128 * j + (r & 127);
        src = (r >> 7) ? src1 : src0;
      } else if (kind == 2) {
        if (n < 384) col = n;
        else if (n < 896) col = 416 + (n - 384);
        else if (n < 1664) col = 928 + (n - 896);
        else if (n < 2688) col = 1720 + (n - 1664);
        else if (n < 3712) col = 2744 + (n - 2688);
        else if (n < 3744) col = 384 + (n - 3712);
        else if (n < 3768) col = 1696 + (n - 3744);
        else col = -1;
      } else if (kind == 3) {
        if (n < 512) col = (n >> 6) * 96 + (n & 63);
        else col = ((n - 512) >> 5) * 96 + 64 + ((n - 512) & 31);
      }
      if (n >= Nout) col = -1;
      _Pragma("unroll 1") for (int kb = 0; kb < 4; ++kb) {
        float v[16];
        UNROLL for (int i = 0; i < 16; ++i) {
          const int k = tk * 64 + kb * 16 + i;
          v[i] = (col >= 0) ? __builtin_nontemporal_load(src + (size_t)k * ldsrc + col) : 0.f;
          if (scale) v[i] *= scale[k];
        }
        UNROLL for (int i = 0; i < 16; ++i) t[(kb * 16 + i) * 257 + nn] = v[i];
      }
    }
    __syncthreads();
    {
      const int k8 = (tid & 7) * 8;
      UNROLL for (int i = 0; i < 8; ++i) {
        const int n2 = (tid >> 3) + 32 * i, n = tn * 256 + n2;
        if (n < Nout) {
          u32x4 o;
          o[0] = pk2(t[(k8 + 0) * 257 + n2], t[(k8 + 1) * 257 + n2]);
          o[1] = pk2(t[(k8 + 2) * 257 + n2], t[(k8 + 3) * 257 + n2]);
          o[2] = pk2(t[(k8 + 4) * 257 + n2], t[(k8 + 5) * 257 + n2]);
          o[3] = pk2(t[(k8 + 6) * 257 + n2], t[(k8 + 7) * 257 + n2]);
          const size_t di = slab ? ((size_t)(((n >> 8) * (K >> 6) + tk) * 256 + (n & 255)) * 64 + k8) : ((size_t)n * K + tk * 64 + k8);
          *(u32x4*)(dst + di) = o;
        }
      }
    }
    __syncthreads();
  }
}

DI void phase_init(const Params& p, char* smem) {
  const int tid = ltid();
  const size_t gtid = (size_t)vbid() * 256 + tid, gsz = (size_t)nvb() * 256;
  if (vbid() == 0 && tid < 64) ((int*)(p.ws + OFF_CNT))[tid] = 0;
  {
    const float4* xs = (const float4*)p.in[0];
    u32x2* xb = (u32x2*)(p.ws + OFF_XB);
    const size_t n4 = (size_t)M * DM / 4;
    for (size_t i = gtid; i < n4; i += 4 * gsz) {
      float4 v[4];
      UNROLL for (int u = 0; u < 4; ++u) if (i + u * gsz < n4) {
        const f32x4_nt t4 = __builtin_nontemporal_load((const f32x4_nt*)(xs + i + u * gsz));
        v[u] = make_float4(t4[0], t4[1], t4[2], t4[3]);
      }
      UNROLL for (int u = 0; u < 4; ++u) if (i + u * gsz < n4) {
        u32x2 o;
        o[0] = pk2(v[u].x, v[u].y);
        o[1] = pk2(v[u].z, v[u].w);
        xb[i + u * gsz] = o;
      }
    }
  }
  {
    float* cn = (float*)(p.ws + OFF_COSN);
    float* sn = (float*)(p.ws + OFF_SINN);
    float* cm = (float*)(p.ws + OFF_COSM);
    float* sm = (float*)(p.ws + OFF_SINM);
    for (size_t i = gtid; i < (size_t)T * 24; i += gsz) {
      const int t = (int)(i / 24), j = (int)(i % 24);
      if (j < 8) {
        const float inv = (float)(1.0 / pow(500000.0, (double)(2 * j) / 16.0));
        const float ang = (float)t * inv;
        cn[t * 8 + j] = (float)cos((double)ang);
        sn[t * 8 + j] = (float)sin((double)ang);
      } else {
        const int m = j - 8;
        const float inv = (float)(1.0 / pow(500000.0, (double)(2 * m) / 32.0));
        const float ang = (float)t * inv;
        cm[t * 16 + m] = (float)cos((double)ang);
        sm[t * 16 + m] = (float)sin((double)ang);
      }
    }
  }
  for (int u = vbid(); u < 512; u += nvb()) {
    const int job = u >> 7, chunk = u & 127, layer = job >> 1, kv = job & 1;
    const float* pe = p.in[kv ? 15 : 11] + (size_t)layer * 2048;
    const float* w1 = p.in[kv ? 16 : 12] + (size_t)layer * 2048 * 128;
    float* red = (float*)smem;
    const int n = tid & 127, sub = tid >> 7;
    float sacc = 0.f;
    UNROLL for (int i = 0; i < 8; ++i) {
      const int kk = chunk * 16 + sub * 8 + i;
      sacc += pe[kk] * w1[(size_t)kk * 128 + n];
    }
    red[tid] = sacc;
    __syncthreads();
    if (tid < 128) ((float*)(p.ws + OFF_PART))[(size_t)(job * 128 + chunk) * 128 + n] = red[tid] + red[tid + 128];
    __syncthreads();
  }
  for (int job = 0; job < 28; ++job) {
    const int layer = job / 14, jj = job % 14;
    u16* wl = (u16*)(p.ws + OFF_W) + (size_t)layer * W_LAYER;
    const float* s0 = nullptr; const float* s1 = nullptr; const float* sc = nullptr;
    int ldsrc = 0, K = 0, Nout = 0, kind = 0; size_t woff = 0;
    switch (jj) {
      case 0: s0 = p.in[3] + (size_t)layer * DM * FF; s1 = p.in[4] + (size_t)layer * DM * FF; ldsrc = FF; K = 1024; Nout = 5632; kind = 1; woff = W_UP1; break;
      case 1: s0 = p.in[5] + (size_t)layer * FF * DM; ldsrc = DM; K = FF; Nout = 1024; woff = W_DN1; break;
      case 2: s0 = p.in[6] + (size_t)layer * DM * 3768; ldsrc = 3768; K = 1024; Nout = 3840; kind = 2; woff = W_IN; break;
      case 3: s0 = p.in[8] + (size_t)layer * 256 * 768; ldsrc = 768; K = 256; Nout = 768; kind = 3; sc = p.in[7] + layer * 256; woff = W_UQ; break;
      case 4: s0 = p.in[10] + (size_t)layer * 128 * 1024; ldsrc = 1024; K = 128; Nout = 1024; sc = p.in[9] + layer * 128; woff = W_UKV; break;
      case 5: s0 = p.in[12] + (size_t)layer * 2048 * 128; ldsrc = 128; K = 2048; Nout = 128; woff = W_CK1; break;
      case 6: s0 = p.in[14] + (size_t)layer * 128 * 64; ldsrc = 64; K = 128; Nout = 64; woff = W_CK2; break;
      case 7: s0 = p.in[16] + (size_t)layer * 2048 * 128; ldsrc = 128; K = 2048; Nout = 128; woff = W_CV1; break;
      case 8: s0 = p.in[18] + (size_t)layer * 128 * 64; ldsrc = 64; K = 128; Nout = 64; woff = W_CV2; break;
      case 9: s0 = p.in[19] + (size_t)layer * 512 * 1024; ldsrc = 1024; K = 512; Nout = 1024; woff = W_PM; break;
      case 10: s0 = p.in[20] + (size_t)layer * 512 * 1024; ldsrc = 1024; K = 512; Nout = 1024; woff = W_PN; break;
      case 11: s0 = p.in[21] + (size_t)layer * 1024 * 1024; ldsrc = 1024; K = 1024; Nout = 1024; woff = W_OUT; break;
      case 12: s0 = p.in[24] + (size_t)layer * DM * FF; s1 = p.in[25] + (size_t)layer * DM * FF; ldsrc = FF; K = 1024; Nout = 5632; kind = 1; woff = W_UP2; break;
      default: s0 = p.in[26] + (size_t)layer * FF * DM; ldsrc = DM; K = FF; Nout = 1024; woff = W_DN2; break;
    }
    convT(s0, s1, ldsrc, K, Nout, kind, sc, wl + woff, smem, (jj == 1 || jj == 13) ? 1 : 0);
  }
}

namespace pg8 {
#define PG8_LAS __attribute__((address_space(3)))
typedef unsigned short bf16_t;
typedef short bf16x8 __attribute__((ext_vector_type(8)));
typedef float f32x4 __attribute__((ext_vector_type(4)));
typedef unsigned u32x4 __attribute__((ext_vector_type(4)));
constexpr int BM = 256, BK = 64, HALF = 128, HTB = HALF * BK * 2  , STAGE_BYTES = 8 * HTB, NXCD = 8, WGM = 8;

__host__ __device__ __forceinline__ int lds_byte(int r, int c) { const int st = (r >> 4) * 2 + (c >> 5), rr = r & 15, cc = c & 31, ob = rr * 64 + cc * 2; return st * 1024 + (ob ^ (((ob >> 9) & 1) << 5)); }
__host__ __device__ __forceinline__ void stage_rc(int b, int& R, int& C) { const int st = b / 1024, sb = b % 1024, swz = sb ^ (((sb >> 9) & 1) << 5); R = (st >> 1) * 16 + swz / 64; C = (st & 1) * 32 + (swz % 64) / 2; }
__host__ __device__ __forceinline__ int perm32(int rho) { const int n = rho >> 4, i = rho & 15; return 8 * (i >> 2) + 4 * n + (i & 3); }

struct Unit { int pm, pn; };
struct Gemm { const bf16_t* A; const bf16_t* Bt; int M, N, K; };

struct StaticOrder {
    int nM, nN, nwg, G, c;
    __host__ __device__ void init(int M, int N, int G_, int c_) { nM = M / BM; nN = N / BM; nwg = nM * nN; G = G_; c = c_; }
    __host__ __device__ bool next(int i, Unit& u) const {
        const long L = (long)i * G + c; if (L >= nwg) return false;
        int wgid = (int)L; { const int q = nwg / NXCD, r = nwg % NXCD, xcd = wgid % NXCD, off = wgid / NXCD; wgid = (xcd < r ? xcd * (q + 1) : r * (q + 1) + (xcd - r) * q) + off; }
        const int nig = WGM * nN, gid = wgid / nig, fm = gid * WGM, gsz = (nM - fm) < WGM ? (nM - fm) : WGM;
        u.pm = fm + ((wgid % nig) % gsz); u.pn = (wgid % nig) / gsz; return true;
    }
    __device__ __forceinline__ void a_ready(const Unit&) const {}
    __device__ __forceinline__ void done(const Unit&) const {}
};

template <class Epi, class Sched, bool STAMP = false, bool ATILED = false, bool BTILED = false>
__device__ __forceinline__ void gemm_phase(PG8_LAS unsigned char* lds, const Gemm g, const Sched& S, const Epi& E, unsigned long long* stamps) {
    int tid = threadIdx.x; asm volatile("" : "+v"(tid));
    const int wid = __builtin_amdgcn_readfirstlane(tid >> 6), lane = tid & 63, wr = wid >> 2, wc = wid & 3, fr = lane & 15, fq = lane >> 4;
    const int K = g.K, nt = K / BK;
    int ts_lo = 0, ts_hi = 0, nts = 0; const unsigned long long rt_entry = STAMP ? (unsigned long long)wall_clock64() : 0ull;
#define PG8_STAMP() do { if (STAMP && wid == 0 && nts < 64) { const unsigned long long _c = (unsigned long long)clock64(); \
        ts_lo = (lane == nts) ? (int)(unsigned)_c : ts_lo; ts_hi = (lane == nts) ? (int)(unsigned)(_c >> 32) : ts_hi; ++nts; } } while (0)
    PG8_STAMP();
    unsigned voffA[2], voffB[2];
#pragma unroll
    for (int i = 0; i < 2; ++i) { int R, C; stage_rc(tid * 16 + i * 8192, R, C); const int Rb = Epi::PERM ? ((R & ~31) + perm32(R & 31)) : R;
        voffA[i] = (unsigned)(R * (ATILED ? BK : K) + C) * 2u; voffB[i] = (unsigned)(Rb * (BTILED ? BK : K) + C) * 2u; }
    const size_t kstep = (size_t)(BK * 2);
    const size_t hstep = (size_t)HALF * K * 2;
    const size_t tstep = 2 * hstep;
    const size_t kstepA = ATILED ? (size_t)(BM * BK * 2) : kstep, hstepA = ATILED ? (size_t)(HALF * BK * 2) : hstep, tstepA = ATILED ? (size_t)(K / BK) * (size_t)(BM * BK * 2) : tstep;
    const size_t kstepB = BTILED ? (size_t)(BM * BK * 2) : kstep, hstepB = BTILED ? (size_t)(HALF * BK * 2) : hstep, tstepB = BTILED ? (size_t)(K / BK) * (size_t)(BM * BK * 2) : tstep;
    const unsigned ldsw = (unsigned)wid * 1024u;
    const int aoff = lds_byte(wr * 64 + fr, fq * 8), boff = lds_byte(wc * 32 + fr, fq * 8);
#define PG8_SA(b, h) (((b) * 2 + (h)) * HTB)
#define PG8_SB(b, h) ((4 + (b) * 2 + (h)) * HTB)
#define PG8_STAGE(bufoff, gbase, voff) do { _Pragma("unroll") for (int _i = 0; _i < 2; ++_i) \
        __builtin_amdgcn_global_load_lds((const unsigned*)((const char*)(gbase) + (voff)[_i]), (PG8_LAS unsigned*)(lds + (bufoff) + ldsw + _i * 8192), 16, 0, 0); } while (0)
#define PG8_LDA(dst, b, h) do { _Pragma("unroll") for (int m = 0; m < 4; ++m) _Pragma("unroll") for (int k = 0; k < 2; ++k) dst[m][k] = *(const PG8_LAS bf16x8*)(lds + PG8_SA(b, h) + aoff + m * 2048 + k * 1024); } while (0)
#define PG8_LDB(dst, b, h) do { _Pragma("unroll") for (int n = 0; n < 2; ++n) _Pragma("unroll") for (int k = 0; k < 2; ++k) dst[n][k] = *(const PG8_LAS bf16x8*)(lds + PG8_SB(b, h) + boff + n * 2048 + k * 1024); } while (0)
#define PG8_MMA(ai, bj, At, Bt) do { __builtin_amdgcn_s_setprio(1); _Pragma("unroll") for (int m = 0; m < 4; ++m) _Pragma("unroll") for (int n = 0; n < 2; ++n) _Pragma("unroll") for (int k = 0; k < 2; ++k) \
        acc[ai][bj][m][n] = __builtin_amdgcn_mfma_f32_16x16x32_bf16(Bt[n][k], At[m][k], acc[ai][bj][m][n], 0, 0, 0); __builtin_amdgcn_s_setprio(0); } while (0)
#define PG8_WAIT_V(n) asm volatile("s_waitcnt vmcnt(" #n ")" ::: "memory")
#define PG8_WAIT_L(n) asm volatile("s_waitcnt lgkmcnt(" #n ")" ::: "memory")
#define PG8_BAR __builtin_amdgcn_s_barrier()
#define PG8_SCHED __builtin_amdgcn_sched_barrier(0)
    Unit cur, nxt; int ui = 0;
    if (!S.next(0, cur)) return;
    f32x4 acc[2][2][4][2];
#pragma unroll
    for (int a = 0; a < 2; ++a)
#pragma unroll
        for (int b = 0; b < 2; ++b)
#pragma unroll
            for (int m = 0; m < 4; ++m)
#pragma unroll
                for (int n = 0; n < 2; ++n) acc[a][b][m][n] = (f32x4){0.f, 0.f, 0.f, 0.f};
    bf16x8 At[4][2], B0[2][2], B1[2][2];
    const char* cA = (const char*)g.A + (size_t)cur.pm * tstepA; const char* cB = (const char*)g.Bt + (size_t)cur.pn * tstepB;
    S.a_ready(cur);
    PG8_STAGE(PG8_SB(0, 0), cB, voffB); PG8_STAGE(PG8_SA(0, 0), cA, voffA); PG8_STAGE(PG8_SB(0, 1), cB + hstepB, voffB); PG8_STAGE(PG8_SA(0, 1), cA + hstepA, voffA);
    if (wr == 1) PG8_BAR;
    PG8_WAIT_V(4); PG8_BAR;
    PG8_STAGE(PG8_SB(1, 0), cB + kstepB, voffB); PG8_STAGE(PG8_SA(1, 0), cA + kstepA, voffA); PG8_STAGE(PG8_SB(1, 1), cB + hstepB + kstepB, voffB);
    PG8_WAIT_V(6); PG8_BAR;
    PG8_STAMP();
    for (;;) {
        const bool has_next = S.next(ui + 1, nxt);
        const char* nA = has_next ? (const char*)g.A + (size_t)nxt.pm * tstepA : cA; const char* nB = has_next ? (const char*)g.Bt + (size_t)nxt.pn * tstepB : cB;
        for (int t = 0; t < nt; t += 2) {
            const bool last = (t == nt - 2);
            const char* a1 = cA + (size_t)(t + 1) * kstepA;
            const char* a2 = last ? nA : cA + (size_t)(t + 2) * kstepA; const char* b2 = last ? nB : cB + (size_t)(t + 2) * kstepB;
            const char* a3 = a2 + kstepA; const char* b3 = b2 + kstepB;
            if (last && has_next) S.a_ready(nxt);
            PG8_LDB(B0, 0, 0); PG8_SCHED; PG8_LDA(At, 0, 0); PG8_STAGE(PG8_SA(1, 1), a1 + hstepA, voffA);
            PG8_WAIT_L(8); PG8_BAR; PG8_WAIT_L(0); PG8_MMA(0, 0, At, B0); PG8_BAR; PG8_SCHED;
            PG8_LDB(B1, 0, 1); PG8_STAGE(PG8_SB(0, 0), b2, voffB);
            PG8_BAR; PG8_WAIT_L(0); PG8_MMA(0, 1, At, B1); PG8_BAR;
            PG8_LDA(At, 0, 1); PG8_STAGE(PG8_SA(0, 0), a2, voffA);
            PG8_BAR; PG8_WAIT_L(0); PG8_MMA(1, 0, At, B0); PG8_BAR; PG8_SCHED;
            PG8_STAGE(PG8_SB(0, 1), b2 + hstepB, voffB);
            PG8_WAIT_V(6); PG8_BAR; PG8_MMA(1, 1, At, B1); PG8_BAR;
            PG8_LDB(B0, 1, 0); PG8_SCHED; PG8_LDA(At, 1, 0); PG8_STAGE(PG8_SA(0, 1), a2 + hstepA, voffA);
            PG8_WAIT_L(8); PG8_BAR; PG8_WAIT_L(0); PG8_MMA(0, 0, At, B0); PG8_BAR; PG8_SCHED;
            PG8_LDB(B1, 1, 1); PG8_STAGE(PG8_SB(1, 0), b3, voffB);
            PG8_BAR; PG8_WAIT_L(0); PG8_MMA(0, 1, At, B1); PG8_BAR;
            PG8_LDA(At, 1, 1); PG8_STAGE(PG8_SA(1, 0), a3, voffA);
            PG8_BAR; PG8_WAIT_L(0); PG8_MMA(1, 0, At, B0); PG8_BAR; PG8_SCHED;
            PG8_STAGE(PG8_SB(1, 1), b3 + hstepB, voffB);
            PG8_WAIT_V(6); PG8_BAR; PG8_MMA(1, 1, At, B1); PG8_BAR;
        }
        PG8_STAMP();
        if constexpr (!Epi::AFTER_DRAIN) { E(acc, cur, wr, wc, fr, fq); S.done(cur); }
        PG8_STAMP();
        if (!has_next) break;
#pragma unroll
        for (int a = 0; a < 2; ++a)
#pragma unroll
            for (int b = 0; b < 2; ++b)
#pragma unroll
                for (int m = 0; m < 4; ++m)
#pragma unroll
                    for (int n = 0; n < 2; ++n) acc[a][b][m][n] = (f32x4){0.f, 0.f, 0.f, 0.f};
        cur = nxt; cA = nA; cB = nB; ++ui;
    }
    PG8_WAIT_V(0);
    if (wr == 0) PG8_BAR;
    PG8_BAR;
    if constexpr (Epi::AFTER_DRAIN) { E.fused(acc, cur, wr, wc, fr, fq, lds, wid, lane); S.done(cur); }
    PG8_STAMP();
    if (STAMP && wid == 0) { stamps[lane] = lane < nts ? (((unsigned long long)(unsigned)ts_hi << 32) | (unsigned)ts_lo) : 0ull;
        if (lane == 62) stamps[62] = rt_entry; if (lane == 63) stamps[63] = (unsigned long long)wall_clock64(); }
#undef PG8_STAMP
#undef PG8_SA
#undef PG8_SB
#undef PG8_STAGE
#undef PG8_LDA
#undef PG8_LDB
#undef PG8_MMA
#undef PG8_WAIT_V
#undef PG8_WAIT_L
#undef PG8_BAR
#undef PG8_SCHED
}
}

typedef pg8::f32x4 f32x4_t;
DI f32x4_t ld4(const float* p) { return *(const f32x4_t*)p; }

struct EpiSwiglu {
  static constexpr bool PERM = true, AFTER_DRAIN = false;
  u16* H;
  __device__ __forceinline__ void operator()(const f32x4_t (&acc)[2][2][4][2], const pg8::Unit& u, int wr, int wc, int fr, int fq) const {
    u16* base = H + ((size_t)(u.pm * (FF / 64) + 2 * u.pn + (wc >> 1)) * 256) * 64 + (size_t)((wr * 64 + fr) * 64 + (wc & 1) * 32 + fq * 8);
    UNROLL for (int ai = 0; ai < 2; ++ai) UNROLL for (int m = 0; m < 4; ++m) {
      float h[8];
      UNROLL for (int n = 0; n < 2; ++n) UNROLL for (int j = 0; j < 4; ++j) {
        const float g = acc[ai][0][m][n][j], up = acc[ai][1][m][n][j];
        h[4 * n + j] = g * __builtin_amdgcn_rcpf(1.f + __expf(-g)) * up;
      }
      u32x4 o;
      o[0] = pk2(h[0], h[1]); o[1] = pk2(h[2], h[3]); o[2] = pk2(h[4], h[5]); o[3] = pk2(h[6], h[7]);
      *(u32x4*)(base + (ai * 128 + m * 16) * 64) = o;
    }
  }
};

struct EpiResid {
  static constexpr bool PERM = true, AFTER_DRAIN = false;
  const float* Xin; float* X; float coef;
  __device__ __forceinline__ void operator()(const f32x4_t (&acc)[2][2][4][2], const pg8::Unit& u, int wr, int wc, int fr, int fq) const {
    UNROLL for (int ai = 0; ai < 2; ++ai) UNROLL for (int m = 0; m < 4; ++m) {
      const int row = u.pm * 256 + ai * 128 + wr * 64 + m * 16 + fr;
      UNROLL for (int bj = 0; bj < 2; ++bj) {
        const size_t off = (size_t)row * DM + u.pn * 256 + bj * 128 + wc * 32 + fq * 8;
        UNROLL for (int n = 0; n < 2; ++n) {
          f32x4_t x = *(const f32x4_t*)(Xin + off + 4 * n);
          x = x * ALPHA + acc[ai][bj][m][n] * coef;
          *(f32x4_t*)(X + off + 4 * n) = x;
        }
      }
    }
  }
};

struct EpiGate1 {
  static constexpr bool PERM = true, AFTER_DRAIN = false;
  u16* GM;
  __device__ __forceinline__ void operator()(const f32x4_t (&acc)[2][2][4][2], const pg8::Unit& u, int wr, int wc, int fr, int fq) const {
    UNROLL for (int ai = 0; ai < 2; ++ai) UNROLL for (int m = 0; m < 4; ++m) {
      const int row = u.pm * 256 + ai * 128 + wr * 64 + m * 16 + fr;
      UNROLL for (int bj = 0; bj < 2; ++bj) {
        u16* pg = GM + (size_t)row * 1024 + u.pn * 256 + bj * 128 + wc * 32 + fq * 8;
        const u32x4 g = *(const u32x4*)pg;
        u32x4 o;
        UNROLL for (int e = 0; e < 4; ++e) {
          const float lo = __uint_as_float(g[e] << 16) * acc[ai][bj][m][e >> 1][(e & 1) * 2];
          const float hi = __uint_as_float(g[e] & 0xffff0000u) * acc[ai][bj][m][e >> 1][(e & 1) * 2 + 1];
          o[e] = pk2(lo, hi);
        }
        *(u32x4*)pg = o;
      }
    }
  }
};
struct EpiGate2 {
  static constexpr bool PERM = true, AFTER_DRAIN = false;
  const u16* GM; const u16* GN; u16* Y;
  __device__ __forceinline__ void operator()(const f32x4_t (&acc)[2][2][4][2], const pg8::Unit& u, int wr, int wc, int fr, int fq) const {
    UNROLL for (int ai = 0; ai < 2; ++ai) UNROLL for (int m = 0; m < 4; ++m) {
      const int row = u.pm * 256 + ai * 128 + wr * 64 + m * 16 + fr;
      UNROLL for (int bj = 0; bj < 2; ++bj) {
        const size_t off = (size_t)row * 1024 + u.pn * 256 + bj * 128 + wc * 32 + fq * 8;
        const u32x4 t1 = *(const u32x4*)(GM + off);
        const u32x4 g = *(const u32x4*)(GN + off);
        u32x4 o;
        UNROLL for (int e = 0; e < 4; ++e) {
          const float lo = __uint_as_float(t1[e] << 16) + __uint_as_float(g[e] << 16) * acc[ai][bj][m][e >> 1][(e & 1) * 2];
          const float hi = __uint_as_float(t1[e] & 0xffff0000u) + __uint_as_float(g[e] & 0xffff0000u) * acc[ai][bj][m][e >> 1][(e & 1) * 2 + 1];
          o[e] = pk2(lo, hi);
        }
        *(u32x4*)(Y + off) = o;
      }
    }
  }
};

struct EpiWin {
  static constexpr bool PERM = true, AFTER_DRAIN = false;
  char* ws_;
  __device__ __forceinline__ void operator()(const f32x4_t (&acc)[2][2][4][2], const pg8::Unit& u, int wr, int wc, int fr, int fq) const {
    char* ws = ws_ + lz();
    u16* CQ = (u16*)(ws + OFF_CQ);
    u16* CKV = (u16*)(ws + OFF_CKV);
    u16* QN = (u16*)(ws + OFF_QN);
    u16* KV6 = (u16*)(ws + OFF_KV6);
    u16* KPE = (u16*)(ws + OFF_KPE);
    float* GATES = (float*)(ws + OFF_GATES);
    u16* GM = (u16*)(ws + OFF_GM);
    u16* GN = (u16*)(ws + OFF_GN);
    const float* COSN = (const float*)(ws + OFF_COSN);
    const float* SINN = (const float*)(ws + OFF_SINN);
    const float* COSM = (const float*)(ws + OFF_COSM);
    const float* SINM = (const float*)(ws + OFF_SINM);
    UNROLL for (int bj = 0; bj < 2; ++bj) {
      const int hc = 2 * u.pn + bj;
      const int cin = wc * 32 + fq * 8;
      UNROLL for (int ai = 0; ai < 2; ++ai) UNROLL for (int m = 0; m < 4; ++m) {
        const int row = u.pm * 256 + ai * 128 + wr * 64 + m * 16 + fr;
        const int t = row & (T - 1), b = row >> 12;
        float v[8];
        UNROLL for (int n = 0; n < 2; ++n) UNROLL for (int j = 0; j < 4; ++j) v[4 * n + j] = acc[ai][bj][m][n][j];
        if (hc < 3) {
          u16* dst = hc < 2 ? (CQ + (size_t)row * 256 + hc * 128 + cin) : (CKV + (size_t)row * 128 + cin);
          u32x4 o;
          o[0] = pk2(v[0], v[1]); o[1] = pk2(v[2], v[3]); o[2] = pk2(v[4], v[5]); o[3] = pk2(v[6], v[7]);
          *(u32x4*)dst = o;
        } else if (hc < 13) {
          const bool isq = hc < 7;
          const int j6 = hc - 7;
          const bool rope_on = isq || ((j6 & 1) == 0);
          if ((wc & 1) == 0) {
            float pr[8];
            UNROLL for (int e = 0; e < 8; ++e) pr[e] = __shfl_xor(v[e], 16);
            if (rope_on && fq < 2) {
              const f32x4_t c0 = ld4(COSN + t * 8), c1 = ld4(COSN + t * 8 + 4), s0 = ld4(SINN + t * 8), s1 = ld4(SINN + t * 8 + 4);
              UNROLL for (int e = 0; e < 8; ++e) {
                const float cs = e < 4 ? c0[e & 3] : c1[e & 3], sn = e < 4 ? s0[e & 3] : s1[e & 3];
                v[e] = (fq == 0) ? (v[e] * cs - pr[e] * sn) : (v[e] * cs + pr[e] * sn);
              }
            }
          }
          const int d = (wc & 1) * 32 + fq * 8;
          u16* dst = isq ? (QN + (size_t)row * 512 + (2 * (hc - 3) + (wc >> 1)) * 64 + d)
                         : (KV6 + ((size_t)((j6 * NB + b) * 2 + (wc >> 1)) * T + t) * 64 + d);
          u32x4 o;
          o[0] = pk2(v[0], v[1]); o[1] = pk2(v[2], v[3]); o[2] = pk2(v[4], v[5]); o[3] = pk2(v[6], v[7]);
          *(u32x4*)dst = o;
        } else if (hc < 29) {
          u16* dst = (hc < 21 ? GM : GN) + (size_t)row * 1024 + (hc < 21 ? hc - 13 : hc - 21) * 128 + cin;
          u32x4 o;
          o[0] = pk2(sigmoidf_(v[0]), sigmoidf_(v[1])); o[1] = pk2(sigmoidf_(v[2]), sigmoidf_(v[3]));
          o[2] = pk2(sigmoidf_(v[4]), sigmoidf_(v[5])); o[3] = pk2(sigmoidf_(v[6]), sigmoidf_(v[7]));
          *(u32x4*)dst = o;
        } else {
          if (wc == 0) {
            float pr[8];
            UNROLL for (int e = 0; e < 8; ++e) pr[e] = __shfl_xor(v[e], 32);
            const int mb = (fq & 1) * 8;
            const f32x4_t c0 = ld4(COSM + t * 16 + mb), c1 = ld4(COSM + t * 16 + mb + 4), s0 = ld4(SINM + t * 16 + mb), s1 = ld4(SINM + t * 16 + mb + 4);
            UNROLL for (int e = 0; e < 8; ++e) {
              const float cs = e < 4 ? c0[e & 3] : c1[e & 3], sn = e < 4 ? s0[e & 3] : s1[e & 3];
              v[e] = (fq < 2) ? (v[e] * cs - pr[e] * sn) : (v[e] * cs + pr[e] * sn);
            }
            u32x4 o;
            o[0] = pk2(v[0], v[1]); o[1] = pk2(v[2], v[3]); o[2] = pk2(v[4], v[5]); o[3] = pk2(v[6], v[7]);
            *(u32x4*)(KPE + (size_t)row * 32 + fq * 8) = o;
          } else if (wc == 1 && fq < 3) {
            float* dst = GATES + (size_t)row * 24 + fq * 8;
            f32x4_t g0, g1;
            UNROLL for (int e = 0; e < 4; ++e) { g0[e] = sigmoidf_(v[e]); g1[e] = sigmoidf_(v[4 + e]); }
            *(f32x4_t*)dst = g0;
            *(f32x4_t*)(dst + 4) = g1;
          }
        }
      }
    }
  }
};

template <bool ATILED = false, bool BTILED = false, class Epi>
DI void big_gemm(const u16* A, const u16* Bt, int N, int K, const Epi& E, char* smem_blk) {
  pg8::Gemm g{A, Bt, M, N, K};
  pg8::StaticOrder S;
  S.init(M, N, (int)gridDim.x, (int)blockIdx.x);
  pg8::gemm_phase<Epi, pg8::StaticOrder, false, ATILED, BTILED>((PG8_LAS unsigned char*)smem_blk, g, S, E, nullptr);
  __syncthreads();
}

DI void bias_reduce(const Params& p) {
  const int vb = vbid(), tid = ltid();
  if (vb < 4 && tid < 128) {
    const int job = vb, layer = job >> 1, kv = job & 1;
    const float* part = (const float*)(p.ws + OFF_PART) + (size_t)job * 128 * 128;
    float sacc = (p.in[kv ? 17 : 13] + (size_t)layer * 128)[tid];
    for (int ch = 0; ch < 128; ++ch) sacc += part[ch * 128 + tid];
    ((float*)(p.ws + OFF_BIAS))[job * 128 + tid] = sacc;
  }
}

template <bool WXB = true>
DI void phase_ln(const Params& p, const float* g, const float* b) {
  const int tid = ltid(), lane = tid & 63, w = tid >> 6;
  float* X = p.out;
  u16* Xb = (u16*)(p.ws + OFF_XB);
  float4 gv[4], bv[4];
  UNROLL for (int i = 0; i < 4; ++i) {
    gv[i] = *(const float4*)(g + i * 256 + lane * 4);
    bv[i] = *(const float4*)(b + i * 256 + lane * 4);
  }
  for (int row0 = vbid() * 4 + w; row0 < M; row0 += nvb() * 8) {
    int row1 = row0 + nvb() * 4;
    const bool has1 = row1 < M;
    if (!has1) row1 = row0;
    float4 va[4], vc[4];
    UNROLL for (int i = 0; i < 4; ++i) {
      va[i] = *(const float4*)(X + (size_t)row0 * DM + i * 256 + lane * 4);
      vc[i] = *(const float4*)(X + (size_t)row1 * DM + i * 256 + lane * 4);
    }
    float s0 = 0.f, s1 = 0.f;
    UNROLL for (int i = 0; i < 4; ++i) {
      s0 += va[i].x + va[i].y + va[i].z + va[i].w;
      s1 += vc[i].x + vc[i].y + vc[i].z + vc[i].w;
    }
    UNROLL for (int o = 32; o >= 1; o >>= 1) { s0 += __shfl_xor(s0, o); s1 += __shfl_xor(s1, o); }
    const float mu0 = s0 * (1.f / 1024.f), mu1 = s1 * (1.f / 1024.f);
    float q0 = 0.f, q1 = 0.f;
    UNROLL for (int i = 0; i < 4; ++i) {
      va[i].x -= mu0; va[i].y -= mu0; va[i].z -= mu0; va[i].w -= mu0;
      vc[i].x -= mu1; vc[i].y -= mu1; vc[i].z -= mu1; vc[i].w -= mu1;
      q0 += va[i].x * va[i].x + va[i].y * va[i].y + va[i].z * va[i].z + va[i].w * va[i].w;
      q1 += vc[i].x * vc[i].x + vc[i].y * vc[i].y + vc[i].z * vc[i].z + vc[i].w * vc[i].w;
    }
    UNROLL for (int o = 32; o >= 1; o >>= 1) { q0 += __shfl_xor(q0, o); q1 += __shfl_xor(q1, o); }
    const float rstd0 = rsqrtf(q0 * (1.f / 1024.f) + 1e-5f), rstd1 = rsqrtf(q1 * (1.f / 1024.f) + 1e-5f);
#define LN_STORE(V, ROW, RSTD)                                                                   \
  UNROLL for (int i = 0; i < 4; ++i) {                                                            \
    float4 y;                                                                                      \
    y.x = V[i].x * (RSTD) * gv[i].x + bv[i].x;                                                    \
    y.y = V[i].y * (RSTD) * gv[i].y + bv[i].y;                                                    \
    y.z = V[i].z * (RSTD) * gv[i].z + bv[i].z;                                                    \
    y.w = V[i].w * (RSTD) * gv[i].w + bv[i].w;                                                    \
    *(float4*)(X + (size_t)(ROW) * DM + i * 256 + lane * 4) = y;                                  \
    u32x2 o;                                                                                       \
    o[0] = pk2(y.x, y.y);                                                                          \
    o[1] = pk2(y.z, y.w);                                                                          \
    if (WXB) *(u32x2*)(Xb + (size_t)(ROW) * DM + i * 256 + lane * 4) = o;                         \
  }
    LN_STORE(va, row0, rstd0)
    if (has1) { LN_STORE(vc, row1, rstd1) }
#undef LN_STORE
  }
}

DI float gelu_tanh(float x) {
  const float u = 0.7978845608028654f * (x + 0.044715f * x * x * x);
  return x * __builtin_amdgcn_rcpf(1.f + __expf(-2.f * u));
}

DI void phase_up_cmp(const Params& p, int layer, char* smem) {
  EPI_VARS
  const u16* WL = (const u16*)(p.ws + OFF_W) + (size_t)layer * W_LAYER;
  float* rstd = (float*)(smem + 73728);
  const float* COSM = (const float*)(p.ws + OFF_COSM);
  const float* SINM = (const float*)(p.ws + OFF_SINM);
  for (int task = vbid(); task < 64; task += nvb()) {
    char* wsz = p.ws + lz();
    f32x16 acc[2][2];
    UNROLL for (int a = 0; a < 2; ++a) UNROLL for (int b = 0; b < 2; ++b) zero16(acc[a][b]);
      const int kv = task >> 5, bg = (task >> 1) & 15, mt = task & 1;
      const u16* A = (const u16*)(wsz + OFF_KV6) + ((size_t)(kv * 16 + bg) * T) * 64 + (size_t)mt * 128 * 1024;
      const u16* W1 = WL + (kv ? W_CV1 : W_CK1);
      const u16* W2 = WL + (kv ? W_CV2 : W_CK2);
      const float* bias = (const float*)(wsz + OFF_BIAS) + (layer * 2 + kv) * 128;
      u16* dst = (u16*)(wsz + (kv ? OFF_VC : OFF_KC)) + (size_t)bg * 256 * 64;
      gemm_main(A, 1024, W1, 2048, 2048, acc, smem);
      UNROLL for (int mi = 0; mi < 2; ++mi) UNROLL for (int ni = 0; ni < 2; ++ni) UNROLL for (int i = 0; i < 16; ++i) {
        const int r = EROW(mi, i), c = wc * 64 + ni * 32 + l31;
        *(u16*)(smem + r * 272 + c * 2) = f2bf(gelu_tanh(acc[mi][ni][i] + bias[c]));
      }
      __syncthreads();
      f32x16 a2[2];
      zero16(a2[0]);
      zero16(a2[1]);
      UNROLL for (int ks = 0; ks < 8; ++ks) {
        bf16x8 af = *(const bf16x8*)(smem + (32 * w + l31) * 272 + ks * 32 + hh * 16);
        bf16x8 b0 = *(const bf16x8*)(W2 + (size_t)(l31) * 128 + ks * 16 + hh * 8);
        bf16x8 b1 = *(const bf16x8*)(W2 + (size_t)(32 + l31) * 128 + ks * 16 + hh * 8);
        a2[0] = MFMA(af, b0, a2[0]);
        a2[1] = MFMA(af, b1, a2[1]);
      }
      UNROLL for (int ni = 0; ni < 2; ++ni) UNROLL for (int i = 0; i < 16; ++i) {
        const int c = mt * 128 + 32 * w + 8 * (i >> 2) + 4 * hh + (i & 3);
        dst[(size_t)c * 64 + ni * 32 + l31] = (c == 255) ? (u16)0 : f2bf(a2[ni][i]);
      }
      __syncthreads();
  }
  const int nw_small = nvb() > 128 ? nvb() - 64 : nvb();
  const int vb_small = nvb() > 128 ? vbid() - 64 : vbid();
  for (int task = vb_small; task >= 0 && task < 1536; task += nw_small) {
    char* wsz = p.ws + lz();
    f32x16 acc[2][2];
    UNROLL for (int a = 0; a < 2; ++a) UNROLL for (int b = 0; b < 2; ++b) zero16(acc[a][b]);
      const int tt = task, tm = tt / 6, tn = tt % 6;
      const u16* A = (const u16*)(wsz + OFF_CQ) + (size_t)tm * 128 * 256;
      {
        const int r = tid >> 1, hf = tid & 1;
        const u16* ar = A + (size_t)r * 256 + hf * 128;
        float ss = 0.f;
        UNROLL for (int c = 0; c < 16; ++c) {
          u32x4 v = *(const u32x4*)(ar + c * 8);
          UNROLL for (int e = 0; e < 4; ++e) {
            const float lo = __uint_as_float(v[e] << 16), hi = __uint_as_float(v[e] & 0xffff0000u);
            ss += lo * lo + hi * hi;
          }
        }
        ss += __shfl_xor(ss, 1);
        if (hf == 0) rstd[r] = rsqrtf(ss * (1.f / 256.f) + 1e-6f);
      }
      gemm_main(A, 256, WL + W_UQ + (size_t)tn * 128 * 256, 256, 256, acc, smem);
      u16* QM = (u16*)(wsz + OFF_QM);
      UNROLL for (int mi = 0; mi < 2; ++mi) UNROLL for (int ni = 0; ni < 2; ++ni) UNROLL for (int i = 0; i < 16; ++i) {
        const int r = EROW(mi, i), row = tm * 128 + r;
        float v = acc[mi][ni][i] * rstd[r];
        const float pr = __shfl_xor(v, 16);
        if (tn >= 4) {
          const int t = row & (T - 1);
          const float cs = COSM[t * 16 + (l31 & 15)], sn = SINM[t * 16 + (l31 & 15)];
          v = (l31 < 16) ? (v * cs - pr * sn) : (v * cs + pr * sn);
        }
        QM[(size_t)row * 768 + tn * 128 + wc * 64 + ni * 32 + l31] = f2bf(v);
      }
      __syncthreads();
  }
  for (int task = vb_small; task >= 0 && task < 2048; task += nw_small) {
    char* wsz = p.ws + lz();
    f32x16 acc[2][2];
    UNROLL for (int a = 0; a < 2; ++a) UNROLL for (int b = 0; b < 2; ++b) zero16(acc[a][b]);
      const int tt = task, tm = tt >> 3, tn = tt & 7;
      const u16* A = (const u16*)(wsz + OFF_CKV) + (size_t)tm * 128 * 128;
      {
        const int r = tid >> 1, hf = tid & 1;
        const u16* ar = A + (size_t)r * 128 + hf * 64;
        float ss = 0.f;
        UNROLL for (int c = 0; c < 8; ++c) {
          u32x4 v = *(const u32x4*)(ar + c * 8);
          UNROLL for (int e = 0; e < 4; ++e) {
            const float lo = __uint_as_float(v[e] << 16), hi = __uint_as_float(v[e] & 0xffff0000u);
            ss += lo * lo + hi * hi;
          }
        }
        ss += __shfl_xor(ss, 1);
        if (hf == 0) rstd[r] = rsqrtf(ss * (1.f / 128.f) + 1e-6f);
      }
      gemm_main(A, 128, WL + W_UKV + (size_t)tn * 128 * 128, 128, 128, acc, smem);
      u16* dst = (u16*)(wsz + (wc == 0 ? OFF_KM : OFF_VM));
      UNROLL for (int mi = 0; mi < 2; ++mi) UNROLL for (int ni = 0; ni < 2; ++ni) UNROLL for (int i = 0; i < 16; ++i) {
        const int r = EROW(mi, i), row = tm * 128 + r;
        const int t = row & (T - 1), b = row >> 12;
        dst[((size_t)(b * 8 + tn) * T + t) * 64 + ni * 32 + l31] = f2bf(acc[mi][ni][i] * rstd[r]);
      }
      __syncthreads();
  }
}

template <int NKS, int KSTR, int MODE, int NREG>
DI void attn_tile(const char* sK, const char* sV, const bf16x8 (&qf)[2][4], const char* qlds, f32x16 (&o)[2][2],
                  float (&mrun)[2], float (&lrun)[2], float sl2, int lane, int kbase, const int (&tq)[2],
                  bool need_mask, const bool (&selb)[2]) {
  const int hh = lane >> 5, r = lane & 31;
  const int blk = (lane >> 4) & 1, q4 = (lane & 15) >> 2, p4 = lane & 3;
  const int sw = (q4 >> 1) & 1;
  UNROLL for (int kt2 = 0; kt2 < 2; ++kt2) {
    f32x16 s[2];
    UNROLL for (int i = 0; i < 16; ++i) { s[0][i] = 0.f; s[1][i] = 0.f; }
    {
      const char* pk = sK + (32 * kt2 + r) * KSTR + hh * 16;
      bf16x8 kf[2], qa[2], qb[2];
      kf[0] = *(const bf16x8*)(pk);
      if (0 >= NREG) {
        qa[0] = *(const bf16x8*)(qlds + (0 - NREG) * 1024);
        qb[0] = *(const bf16x8*)(qlds + (NKS - NREG + 0 - NREG) * 1024);
      }
      UNROLL for (int ks = 0; ks < NKS; ++ks) {
        const int cb = ks & 1, nb = cb ^ 1;
        if (ks + 1 < NKS) {
          kf[nb] = *(const bf16x8*)(pk + (ks + 1) * 32);
          if (ks + 1 >= NREG) {
            qa[nb] = *(const bf16x8*)(qlds + (ks + 1 - NREG) * 1024);
            qb[nb] = *(const bf16x8*)(qlds + (NKS - NREG + ks + 1 - NREG) * 1024);
          }
        }
        __builtin_amdgcn_sched_barrier(0);
        if (ks >= NREG) {
          s[0] = MFMA(kf[cb], qa[cb], s[0]);
          s[1] = MFMA(kf[cb], qb[cb], s[1]);
        } else {
          s[0] = MFMA(kf[cb], qf[0][ks < 4 ? ks : 0], s[0]);
          s[1] = MFMA(kf[cb], qf[1][ks < 4 ? ks : 0], s[1]);
        }
        __builtin_amdgcn_sched_barrier(0);
      }
    }
    UNROLL for (int qt = 0; qt < 2; ++qt) {
      float mx = NEGR;
      if (need_mask) {
        const int lim = tq[qt] - kbase - 4 * hh;
        UNROLL for (int i = 0; i < 16; ++i) {
          const int kc = 32 * kt2 + 8 * (i >> 2) + (i & 3);
          bool ok = kc <= lim;
          if (MODE == 2) ok = ok && (kc > lim - 512);
          if (MODE == 1) ok = ok && selb[qt];
          const float x = ok ? s[qt][i] : NEGR;
          s[qt][i] = x;
          mx = fmaxf(mx, x);
        }
      } else {
        UNROLL for (int i = 0; i < 16; ++i) mx = fmaxf(mx, s[qt][i]);
      }
      mx = xh_max(mx);
      const float mnew = fmaxf(mrun[qt], mx * sl2);
      if (__builtin_amdgcn_ballot_w64(mnew != mrun[qt]) != 0ull) {
        const float alpha = ex2(mrun[qt] - mnew);
        mrun[qt] = mnew;
        lrun[qt] *= alpha;
        UNROLL for (int dt = 0; dt < 2; ++dt) UNROLL for (int i = 0; i < 16; ++i) o[qt][dt][i] *= alpha;
      }
      float ls = 0.f;
      const float nbias = (MODE == 1 && !selb[qt]) ? (-mnew - 20000.f) : -mnew;
      UNROLL for (int i = 0; i < 16; ++i) {
        const float pv = ex2(__builtin_fmaf(s[qt][i], sl2, nbias));
        s[qt][i] = pv;
        ls += pv;
      }
      lrun[qt] += ls;
    }
    {
      bf16x8 pf0[2], pf1[2];
      pf0[0] = pack8(s[0], 0); pf1[0] = pack8(s[1], 0);
      pf0[1] = pack8(s[0], 1); pf1[1] = pack8(s[1], 1);
      s16x4 lo[2], hi[2];
      const char* pvb = sV + (32 * kt2 + 4 * hh + q4) * 128 + (16 * blk + 4 * p4) * 2;
      lo[0] = tr_read(pvb + ((0 ^ sw) * 64));
      hi[0] = tr_read(pvb + ((0 ^ sw) * 64) + 8 * 128);
      UNROLL for (int c = 0; c < 4; ++c) {
        const int st = c >> 1, dt = c & 1, cb = c & 1, nb = cb ^ 1;
        if (c + 1 < 4) {
          const int st1 = (c + 1) >> 1, dt1 = (c + 1) & 1;
          lo[nb] = tr_read(pvb + st1 * 16 * 128 + ((dt1 ^ sw) * 64));
          hi[nb] = tr_read(pvb + st1 * 16 * 128 + ((dt1 ^ sw) * 64) + 8 * 128);
        }
        __builtin_amdgcn_sched_barrier(0);
        const bf16x8 vf = __builtin_shufflevector(lo[cb], hi[cb], 0, 1, 2, 3, 4, 5, 6, 7);
        o[0][dt] = MFMA(vf, pf0[st], o[0][dt]);
        o[1][dt] = MFMA(vf, pf1[st], o[1][dt]);
        __builtin_amdgcn_sched_barrier(0);
      }
    }
  }
}

DI void mla_task(const Params& p, int task, char* smem) {
  const int tid = ltid(), lane = tid & 63, w = tid >> 6, l31 = lane & 31, hh = lane >> 5;
  const int qb = 15 - (task >> 6), bh = task & 63, b = bh >> 3, h = bh & 7;
  const int q0 = qb * 256;
  u16* QM = (u16*)(p.ws + OFF_QM);
  const u16* KM = (const u16*)(p.ws + OFF_KM) + (size_t)bh * T * 64;
  const u16* VM = (const u16*)(p.ws + OFF_VM) + (size_t)bh * T * 64;
  const u16* KPE = (const u16*)(p.ws + OFF_KPE) + (size_t)b * T * 32;
  bf16x8 qf[2][4];
  int tq[2];
  const char* qlds = smem + 43008 + w * 4096 + lane * 16;
  UNROLL for (int qt = 0; qt < 2; ++qt) {
    tq[qt] = q0 + 64 * w + 32 * qt + l31;
    const u16* base = QM + (size_t)(b * T + tq[qt]) * 768;
    UNROLL for (int ks = 0; ks < 4; ++ks) qf[qt][ks] = *(const bf16x8*)(base + h * 64 + 16 * ks + 8 * hh);
    UNROLL for (int ks = 0; ks < 2; ++ks)
      *(bf16x8*)(smem + 43008 + w * 4096 + lane * 16 + (qt * 2 + ks) * 1024) = *(const bf16x8*)(base + 512 + h * 32 + 16 * ks + 8 * hh);
  }
  f32x16 o[2][2];
  UNROLL for (int a = 0; a < 2; ++a) UNROLL for (int c = 0; c < 2; ++c) zero16(o[a][c]);
  float mrun[2] = {NEGF, NEGF}, lrun[2] = {0.f, 0.f};
  const bool selb[2] = {true, true};
  const float sl2 = 0.10206207261596575f * LOG2E;
  const int nkt = (q0 >> 6) + 4, my_last = (q0 >> 6) + w;
  u32x4 rk[3], rv[2];
  const unsigned offa = (unsigned)tid * 16u;
  const unsigned offp = (unsigned)tid * 16u;
  auto gload = [&](int kt) {
    const char* kb = (const char*)(KM + (size_t)kt * 4096);
    const char* vb = (const char*)(VM + (size_t)kt * 4096);
    const char* pb = (const char*)(KPE + (size_t)kt * 2048);
    rk[0] = *(const u32x4*)(kb + offa);
    rk[1] = *(const u32x4*)(kb + offa + 4096u);
    rk[2] = *(const u32x4*)(pb + offp);
    rv[0] = *(const u32x4*)(vb + offa);
    rv[1] = *(const u32x4*)(vb + offa + 4096u);
  };
  auto sstore = [&](int s) {
    UNROLL for (int i = 0; i < 2; ++i) {
      const int c = tid + 256 * i, key = c >> 3, ch = c & 7;
      *(u32x4*)(smem + s * 13312 + key * 208 + ch * 16) = rk[i];
      *(u32x4*)(smem + 26624 + s * 8192 + key * 128 + ((ch ^ (4 * ((key >> 1) & 1))) * 16)) = rv[i];
    }
    *(u32x4*)(smem + s * 13312 + (tid >> 2) * 208 + 128 + (tid & 3) * 16) = rk[2];
  };
  gload(0);
  sstore(0);
  __syncthreads();
  _Pragma("unroll 1") for (int kt = 0; kt < nkt; ++kt) {
    const bool more = kt + 1 < nkt;
    if (more) gload(kt + 1);
    if (kt <= my_last) {
      const bool need_mask = (64 * kt + 63 > q0 + 64 * w);
      attn_tile<6, 208, 0, 4>(smem + (kt & 1) * 13312, smem + 26624 + (kt & 1) * 8192, qf, qlds, o, mrun, lrun, sl2, lane,
                           64 * kt, tq, need_mask, selb);
    }
    if (more) sstore((kt + 1) & 1);
    __syncthreads();
  }
  UNROLL for (int qt = 0; qt < 2; ++qt) {
    const float lt = xh_sum(lrun[qt]);
    const float inv = __builtin_amdgcn_rcpf(lt);
    u16* dst = (u16*)(p.ws + OFF_OM) + (size_t)(b * T + tq[qt]) * 512 + h * 64;
    UNROLL for (int dt = 0; dt < 2; ++dt) UNROLL for (int g4 = 0; g4 < 4; ++g4) {
      u32x2 v;
      v[0] = pk2(o[qt][dt][4 * g4 + 0] * inv, o[qt][dt][4 * g4 + 1] * inv);
      v[1] = pk2(o[qt][dt][4 * g4 + 2] * inv, o[qt][dt][4 * g4 + 3] * inv);
      *(u32x2*)(dst + 32 * dt + 8 * g4 + 4 * hh) = v;
    }
  }
}

template <int MODE>
DI void nsa_flash(const u16* __restrict__ Kg, const u16* __restrict__ Vg, int kt_lo, int kt_hi, int cur,
                  f32x16 (&o)[2][2], float (&mrun)[2], float (&lrun)[2], float sl2,
                  const int (&tq)[2], char* smem) {
  const bf16x8 qdummy[2][4] = {};
  const char* qlds = smem + 36864 + (ltid() >> 6) * 8192 + (ltid() & 63) * 16;
  const int tid = ltid(), lane = tid & 63;
  const unsigned* selw = (const unsigned*)(smem + 69632 + 8192);
  u32x4 rk[2], rv[2];
  const unsigned offa = (unsigned)tid * 16u;
  auto gload = [&](int kt) {
    const char* kb = (const char*)(Kg + (size_t)kt * 4096);
    const char* vb = (const char*)(Vg + (size_t)kt * 4096);
    rk[0] = *(const u32x4*)(kb + offa);
    rk[1] = *(const u32x4*)(kb + offa + 4096u);
    rv[0] = *(const u32x4*)(vb + offa);
    rv[1] = *(const u32x4*)(vb + offa + 4096u);
  };
  auto sstore = [&](int s) {
    UNROLL for (int i = 0; i < 2; ++i) {
      const int c = tid + 256 * i, key = c >> 3, ch = c & 7;
      *(u32x4*)(smem + s * 9216 + key * 144 + ch * 16) = rk[i];
      *(u32x4*)(smem + 18432 + s * 8192 + key * 128 + ((ch ^ (4 * ((key >> 1) & 1))) * 16)) = rv[i];
    }
  };
  gload(kt_lo);
  sstore(0);
  __syncthreads();
  _Pragma("unroll 1") for (int kt = kt_lo; kt <= kt_hi; ++kt) {
    const int s = (kt - kt_lo) & 1;
    const bool more = kt < kt_hi;
    if (more) gload(kt + 1);
    bool selb[2] = {true, true};
    if (MODE == 1) {
      selb[0] = (selw[(tq[0] & 63) * 2 + (kt >> 5)] >> (kt & 31)) & 1u;
      selb[1] = (selw[(tq[1] & 63) * 2 + (kt >> 5)] >> (kt & 31)) & 1u;
    }
    const bool need_mask = (kt == cur) || (MODE == 2 && kt == cur - 8);
    attn_tile<4, 144, MODE, 0>(smem + s * 9216, smem + 18432 + s * 8192, qdummy, qlds, o, mrun, lrun, sl2, lane,
                                  64 * kt, tq, need_mask, selb);
    if (more) sstore(s ^ 1);
    __syncthreads();
  }
}

DI void nsa_task(const Params& p, int task, char* smem) {
  const int tid = ltid(), lane = tid & 63, w = tid >> 6, l31 = lane & 31, hh = lane >> 5;
  const int cur = 63 - (task >> 4), bg = task & 15, b = bg >> 1, g = bg & 1;
  u16* QN = (u16*)(p.ws + OFF_QN);
  const u16* KV6 = (const u16*)(p.ws + OFF_KV6);
  const float* GATES = (const float*)(p.ws + OFF_GATES);
  const u16* KC = (const u16*)(p.ws + OFF_KC) + (size_t)bg * 256 * 64;
  const u16* VC = (const u16*)(p.ws + OFF_VC) + (size_t)bg * 256 * 64;
  const int head = 4 * g + (l31 & 3);
  bf16x8 qf[2][4];
  int tq[2];
  UNROLL for (int qt = 0; qt < 2; ++qt) {
    tq[qt] = 64 * cur + 16 * w + 8 * qt + (l31 >> 2);
    const u16* base = QN + (size_t)(b * T + tq[qt]) * 512 + head * 64;
    UNROLL for (int ks = 0; ks < 4; ++ks) qf[qt][ks] = *(const bf16x8*)(base + 16 * ks + 8 * hh);
  }
  const float sl2 = 0.125f * LOG2E;
  unsigned long long* selm = (unsigned long long*)(smem + 69632 + 8192);
  char* R1 = smem;
  char* R2 = smem + 36864;
  float* impw = (float*)(smem + 69632) + w * 512;
  {
    UNROLL for (int i = 0; i < 8; ++i) {
      const int c = tid + 256 * i, key = c >> 3, ch = c & 7;
      u32x4 kk = *(const u32x4*)(KC + (size_t)c * 8);
      u32x4 vv = *(const u32x4*)(VC + (size_t)c * 8);
      *(u32x4*)(R1 + (key >> 6) * 9216 + (key & 63) * 144 + ch * 16) = kk;
      *(u32x4*)(R2 + (key >> 6) * 8192 + (key & 63) * 128 + ((ch ^ (4 * ((key >> 1) & 1))) * 16)) = vv;
    }
    __syncthreads();
    const int blk = (lane >> 4) & 1, q4 = (lane & 15) >> 2, p4 = lane & 3, sw = (q4 >> 1) & 1;
    UNROLL for (int qt = 0; qt < 2; ++qt) {
      const int cmh = ((tq[qt] - 31) >> 4) - 4 * hh;
      float mx = NEGF, lsum = 0.f;
      UNROLL for (int a = 0; a < 8; ++a) {
        f32x16 sa;
        zero16(sa);
        const char* pk = R1 + (a >> 1) * 9216 + (32 * (a & 1) + l31) * 144 + hh * 16;
        {
          bf16x8 kf4[4];
          UNROLL for (int ks = 0; ks < 4; ++ks) kf4[ks] = *(const bf16x8*)(pk + ks * 32);
          __builtin_amdgcn_sched_barrier(0);
          UNROLL for (int ks = 0; ks < 4; ++ks) sa = MFMA(kf4[ks], qf[qt][ks], sa);
        }
        float tm = NEGF;
        UNROLL for (int i = 0; i < 16; ++i) {
          const int c = 32 * a + 8 * (i >> 2) + (i & 3);
          const float x = (c <= cmh) ? sa[i] * sl2 : NEGF;
          sa[i] = x;
          tm = fmaxf(tm, x);
        }
        const float mnew = fmaxf(mx, tm);
        float ts = 0.f;
        UNROLL for (int i = 0; i < 16; ++i) ts += ex2(sa[i] - mnew);
        lsum = lsum * ex2(mx - mnew) + ts;
        mx = mnew;
        __builtin_amdgcn_sched_barrier(0);
      }
      {
        const float mo = xh_get(mx, hh), lo = xh_get(lsum, hh);
        const float mt = fmaxf(mx, mo);
        lsum = lsum * ex2(mx - mt) + lo * ex2(mo - mt);
        mx = mt;
      }
      const float inv = (mx > -1e29f) ? 1.f / lsum : 0.f;
      float lastprev = 0.f;
      f32x16 oc[2];
      zero16(oc[0]);
      zero16(oc[1]);
      UNROLL for (int a = 0; a < 8; ++a) {
        f32x16 sa;
        zero16(sa);
        const char* pk = R1 + (a >> 1) * 9216 + (32 * (a & 1) + l31) * 144 + hh * 16;
        {
          bf16x8 kf4[4];
          UNROLL for (int ks = 0; ks < 4; ++ks) kf4[ks] = *(const bf16x8*)(pk + ks * 32);
          __builtin_amdgcn_sched_barrier(0);
          UNROLL for (int ks = 0; ks < 4; ++ks) sa = MFMA(kf4[ks], qf[qt][ks], sa);
        }
        UNROLL for (int i = 0; i < 16; ++i) {
          const int c = 32 * a + 8 * (i >> 2) + (i & 3);
          sa[i] = (c <= cmh) ? ex2(sa[i] * sl2 - mx) * inv : 0.f;
        }
        UNROLL for (int q = 0; q < 4; ++q) {
          const int gi = 4 * a + q;
          const float g4 = sa[4 * q] + sa[4 * q + 1] + sa[4 * q + 2] + sa[4 * q + 3];
          const float lastcur = sa[4 * q + 3];
          const float tosend = hh ? lastprev : lastcur;
          const float recv = xh_get(tosend, hh);
          const float im = quad_sum(g4 + recv);
          if ((l31 & 3) == (gi & 3)) impw[(l31 >> 2) * 64 + 2 * gi + hh] = im;
          lastprev = lastcur;
        }
        {
          s16x4 vlo[4], vhi[4];
          UNROLL for (int c = 0; c < 4; ++c) {
            const int st = c >> 1, dt = c & 1;
            const char* pv = R2 + (a >> 1) * 8192 + (32 * (a & 1) + 16 * st + 4 * hh + q4) * 128 + ((dt ^ sw) * 64) + (16 * blk + 4 * p4) * 2;
            vlo[c] = tr_read(pv);
            vhi[c] = tr_read(pv + 8 * 128);
          }
          const bf16x8 pfa = pack8(sa, 0), pfb = pack8(sa, 1);
          __builtin_amdgcn_sched_barrier(0);
          UNROLL for (int c = 0; c < 4; ++c) {
            const bf16x8 vf = __builtin_shufflevector(vlo[c], vhi[c], 0, 1, 2, 3, 4, 5, 6, 7);
            oc[c & 1] = MFMA(vf, (c >> 1) ? pfb : pfa, oc[c & 1]);
          }
        }
        __builtin_amdgcn_sched_barrier(0);
      }
      __syncthreads();
      if (cur >= 16) {
        unsigned* keyw = (unsigned*)impw;
        UNROLL for (int t8 = 0; t8 < 8; ++t8) {
          const float v = impw[t8 * 64 + lane];
          const int j = lane;
          unsigned key = (__float_as_uint(v) & ~63u) | (unsigned)(63 - j);
          if (j == 0 || j == cur || j == cur - 1) key = 0x7f800000u | (unsigned)(63 - j);
          else if (j > cur) key = (unsigned)(63 - j);
          keyw[t8 * 64 + lane] = key;
        }
        __syncthreads();
        _Pragma("unroll 1") for (int t8 = 0; t8 < 8; ++t8) {
          const unsigned key = keyw[t8 * 64 + lane];
          int rank = 0;
          UNROLL for (int c4 = 0; c4 < 16; ++c4) {
            const u32x4 kk = *(const u32x4*)(keyw + t8 * 64 + c4 * 4);
            rank += (kk[0] > key) ? 1 : 0;
            rank += (kk[1] > key) ? 1 : 0;
            rank += (kk[2] > key) ? 1 : 0;
            rank += (kk[3] > key) ? 1 : 0;
          }
          const unsigned long long mk = __ballot(rank < 16);
          if (lane == 0) selm[16 * w + 8 * qt + t8] = mk;
        }
      } else {
        if (lane < 8) selm[16 * w + 8 * qt + lane] = ~0ull;
      }
      __syncthreads();
      int zq = 0;
      asm volatile("" : "+v"(zq));
      const int rowq = b * T + tq[qt] + zq;
      const float g0 = GATES[(size_t)rowq * 24 + head * 3 + 0];
      u16* dst = (u16*)(p.ws + OFF_ON) + (size_t)rowq * 512 + head * 64;
      UNROLL for (int dt = 0; dt < 2; ++dt) UNROLL for (int g4 = 0; g4 < 4; ++g4) {
        u32x2 v;
        v[0] = pk2(oc[dt][4 * g4 + 0] * g0, oc[dt][4 * g4 + 1] * g0);
        v[1] = pk2(oc[dt][4 * g4 + 2] * g0, oc[dt][4 * g4 + 3] * g0);
        *(u32x2*)(dst + 32 * dt + 8 * g4 + 4 * hh) = v;
      }
    }
    __syncthreads();
  }
  {
    char* qdst = smem + 36864 + w * 8192 + lane * 16;
    UNROLL for (int qt = 0; qt < 2; ++qt) UNROLL for (int ks = 0; ks < 4; ++ks) *(bf16x8*)(qdst + (qt * 4 + ks) * 1024) = qf[qt][ks];
  }
  __syncthreads();
  UNROLL for (int br = 1; br <= 2; ++br) {
    f32x16 o[2][2];
    UNROLL for (int a = 0; a < 2; ++a) UNROLL for (int c = 0; c < 2; ++c) zero16(o[a][c]);
    float mrun[2] = {NEGF, NEGF}, lrun[2] = {0.f, 0.f};
    const u16* Kg = KV6 + ((size_t)((2 * br) * 16 + bg) * T) * 64;
    const u16* Vg = KV6 + ((size_t)((2 * br + 1) * 16 + bg) * T) * 64;
    if (br == 1) nsa_flash<1>(Kg, Vg, 0, cur, cur, o, mrun, lrun, sl2, tq, smem);
    else nsa_flash<2>(Kg, Vg, cur > 8 ? cur - 8 : 0, cur, cur, o, mrun, lrun, sl2, tq, smem);
    UNROLL for (int qt = 0; qt < 2; ++qt) {
      const float lt = xh_sum(lrun[qt]);
      int zq = 0;
      asm volatile("" : "+v"(zq));
      const int rowq = b * T + tq[qt] + zq;
      const float gt = GATES[(size_t)rowq * 24 + head * 3 + br];
      const float inv = gt * __builtin_amdgcn_rcpf(lt);
      u16* dst = (u16*)(p.ws + OFF_ON) + (size_t)rowq * 512 + head * 64;
      UNROLL for (int dt = 0; dt < 2; ++dt) UNROLL for (int g4 = 0; g4 < 4; ++g4) {
        u32x2* pd = (u32x2*)(dst + 32 * dt + 8 * g4 + 4 * hh);
        const u32x2 old = *pd;
        u32x2 v;
        v[0] = pk2(o[qt][dt][4 * g4 + 0] * inv + __uint_as_float(old[0] << 16),
                   o[qt][dt][4 * g4 + 1] * inv + __uint_as_float(old[0] & 0xffff0000u));
        v[1] = pk2(o[qt][dt][4 * g4 + 2] * inv + __uint_as_float(old[1] << 16),
                   o[qt][dt][4 * g4 + 3] * inv + __uint_as_float(old[1] & 0xffff0000u));
        *pd = v;
      }
    }
  }
}

DI void phase_attn(const Params& p, int layer, char* smem, char* smem_blk) {
  int* cnt = (int*)(p.ws + OFF_CNT) + layer;
  int* s_task = (int*)(smem_blk + 2 * VSMEM);
  const int half = vhalf();
  for (;;) {
    if (__builtin_amdgcn_workitem_id_x() == 0) *s_task = atomicAdd(cnt, 2);
    __syncthreads();
    const int task = *s_task + half;
    __syncthreads();
    if (task >= 2048) break;
    if (task < 1024) mla_task(p, task, smem);
    else nsa_task(p, task - 1024, smem);
  }
}

DI void phase_proj(const Params& p, int layer, char* smem) {
  EPI_VARS
  const u16* WL = (const u16*)(p.ws + OFF_W) + (size_t)layer * W_LAYER;
  const u16* OM = (const u16*)(p.ws + OFF_OM);
  const u16* ON = (const u16*)(p.ws + OFF_ON);
  const u16* GM = (const u16*)(p.ws + OFF_GM);
  const u16* GN = (const u16*)(p.ws + OFF_GN);
  u16* Yb = (u16*)(p.ws + OFF_XB);
  const int ntn = 8, ntiles = 256 * ntn;
  for (int tile = vbid(); tile < ntiles; tile += nvb()) {
    const int tm = tile / ntn, tn = tile % ntn;
    f32x16 acc[2][2];
    UNROLL for (int a = 0; a < 2; ++a) UNROLL for (int b = 0; b < 2; ++b) zero16(acc[a][b]);
    gemm_main(OM + (size_t)tm * 128 * 512, 512, WL + W_PM + (size_t)tn * 128 * 512, 512, 512, acc, smem);
    {
      int z1 = 0;
      asm volatile("" : "+v"(z1)::"memory");
      UNROLL for (int mi = 0; mi < 2; ++mi) UNROLL for (int ni = 0; ni < 2; ++ni) UNROLL for (int i = 0; i < 16; ++i) {
        if ((i & 3) == 0) asm volatile("" ::: "memory");
        const int row = tm * 128 + EROW(mi, i) + z1;
        const size_t idx = (size_t)row * 1024 + tn * 128 + wc * 64 + ni * 32 + l31;
        acc[mi][ni][i] *= bf2f(GM[idx]) * __builtin_amdgcn_rcpf(bf2f(GN[idx]));
      }
    }
    gemm_main(ON + (size_t)tm * 128 * 512, 512, WL + W_PN + (size_t)tn * 128 * 512, 512, 512, acc, smem);
    int z2 = 0;
    asm volatile("" : "+v"(z2)::"memory");
    UNROLL for (int mi = 0; mi < 2; ++mi) UNROLL for (int ni = 0; ni < 2; ++ni) UNROLL for (int i = 0; i < 16; ++i) {
      const int row = tm * 128 + EROW(mi, i) + z2;
      const size_t idx = (size_t)row * 1024 + tn * 128 + wc * 64 + ni * 32 + l31;
      if ((i & 3) == 0) asm volatile("" ::: "memory");
      const float y = bf2f(GN[idx]) * acc[mi][ni][i];
      Yb[idx] = f2bf(y);
    }
  }
}

#define XB_TMO      128
#define XB_XCNT(j)  (256  + 64 * (j))
#define XB_XSUB(j)  (1280 + 64 * (j))
#define XB_XGEN(j)  (2304 + 64 * (j))
#define XB_TOP      3328
#define XB_TOPGEN   3392
#define XCD_BAR_WORDS 3456
#define XB_SPIN_CAP (1u << 18)
#define LAS __attribute__((address_space(3)))

__device__ __forceinline__ unsigned xb_ld(unsigned* p)              { return __hip_atomic_load(p, __ATOMIC_RELAXED, __HIP_MEMORY_SCOPE_AGENT); }
__device__ __forceinline__ unsigned xb_add(unsigned* p, unsigned v) { return __hip_atomic_fetch_add(p, v, __ATOMIC_RELAXED, __HIP_MEMORY_SCOPE_AGENT); }
__device__ __forceinline__ unsigned xb_xcc_id() { return (unsigned)__builtin_amdgcn_s_getreg((3 << 11) | 20) & 0xFu; }
#define XB_SPIN(cond, bar) do { unsigned _sp = 0; while (cond) { __builtin_amdgcn_s_sleep(1); \
    if ((++_sp & 255u) == 0u) { if (xb_ld(&(bar)[XB_TMO])) break; if (_sp > XB_SPIN_CAP) { atomicAdd(&(bar)[XB_TMO], 1u); break; } } } } while (0)

struct XcdBarrier {
    unsigned* bar; unsigned x;
    volatile LAS unsigned* st;
};

__device__ __forceinline__ XcdBarrier xcd_barrier_post(unsigned* bar, volatile LAS unsigned* st) {
    XcdBarrier b; b.bar = bar; b.x = xb_xcc_id(); b.st = st;
    if (threadIdx.x == 0) (void)xb_add(&bar[XB_XCNT(b.x)], 1u);
    return b;
}
__device__ __forceinline__ void xcd_barrier_complete(unsigned* bar, unsigned x, unsigned& nloc, unsigned& nx) {
    const unsigned G = gridDim.x * gridDim.y * gridDim.z;
    unsigned sum, cnt, mine, sp = 0u;
    for (;;) {
        sum = 0u; cnt = 0u; mine = 0u;
#pragma unroll
        for (unsigned j = 0; j < 16; ++j) { const unsigned c = xb_ld(&bar[XB_XCNT(j)]); sum += c; cnt += (c > 0u) ? 1u : 0u; mine = (j == x) ? c : mine; }
        if (sum == G) break;
        __builtin_amdgcn_s_sleep(1);
        if ((++sp & 255u) == 0u) { if (xb_ld(&bar[XB_TMO])) break; if (sp > XB_SPIN_CAP) { atomicAdd(&bar[XB_TMO], 1u); break; } }
    }
    nloc = mine > 0u ? mine : 1u; nx = cnt > 0u ? cnt : 1u;
}

__device__ __forceinline__ void xcd_barrier(const XcdBarrier& b) {
    asm volatile("s_waitcnt vmcnt(0)" ::: "memory");
    __syncthreads();
    if (threadIdx.x == 0) {
        unsigned* bar = b.bar;
        __builtin_amdgcn_s_waitcnt(0);
        unsigned nloc = b.st[0], nx = b.st[1];
        if (nloc == 0u) { xcd_barrier_complete(bar, b.x, nloc, nx); b.st[0] = nloc; b.st[1] = nx; }
        const unsigned old = xb_add(&bar[XB_XSUB(b.x)], 1u);
        const unsigned gen = old / nloc;
        if (old + 1u == (gen + 1u) * nloc) {
            __builtin_amdgcn_fence(__ATOMIC_RELEASE, "agent");
            asm volatile("s_waitcnt vmcnt(0)" ::: "memory");
            const unsigned og = xb_add(&bar[XB_TOP], 1u);
            const unsigned tg = og / nx;
            if (og + 1u == (tg + 1u) * nx) xb_add(&bar[XB_TOPGEN], 1u);
            else XB_SPIN(xb_ld(&bar[XB_TOPGEN]) == tg, bar);
            __builtin_amdgcn_fence(__ATOMIC_ACQUIRE, "agent");
            xb_add(&bar[XB_XGEN(b.x)], 1u);
            asm volatile("s_waitcnt vmcnt(0)" ::: "memory");
        } else {
            XB_SPIN(xb_ld(&bar[XB_XGEN(b.x)]) == gen, bar);
            __builtin_amdgcn_fence(__ATOMIC_ACQUIRE, "agent");
            asm volatile("s_waitcnt vmcnt(0)" ::: "memory");
        }
    }
    __syncthreads();
}

#define GSYNC xcd_barrier(xb)
#define LAYER(layer)                                                                                              \
  {                                                                                                               \
    const u16* WL = (const u16*)(p.ws + OFF_W) + (size_t)(layer) * W_LAYER;                                       \
    const u16* XB = (const u16*)(p.ws + OFF_XB);                                                                  \
    const u16* HB = (const u16*)(p.ws + OFF_H);                                                                   \
    big_gemm(XB, WL + W_UP1, 5632, 1024, EpiSwiglu{(u16*)(p.ws + OFF_H)}, smem_blk); GSYNC;                       \
    big_gemm<true, true>(HB, WL + W_DN1, 1024, FF, EpiResid{(layer) == 0 ? p.in[0] : p.out, p.out, 0.5f}, smem_blk); GSYNC;                                   \
    bias_reduce(p); phase_ln(p, p.in[1] + (layer) * DM, p.in[2] + (layer) * DM); GSYNC;                                          \
    big_gemm(XB, WL + W_IN, 3840, 1024, EpiWin{p.ws}, smem_blk); GSYNC;                                           \
    phase_up_cmp(p, layer, smem); GSYNC;                                                                          \
    phase_attn(p, layer, smem, smem_blk); GSYNC;                                                                  \
    big_gemm((const u16*)(p.ws + OFF_OM), WL + W_PM, 1024, 512, EpiGate1{(u16*)(p.ws + OFF_GM)}, smem_blk); GSYNC; big_gemm((const u16*)(p.ws + OFF_ON), WL + W_PN, 1024, 512, EpiGate2{(const u16*)(p.ws + OFF_GM), (const u16*)(p.ws + OFF_GN), (u16*)(p.ws + OFF_XB)}, smem_blk); GSYNC;                                                                           \
    big_gemm(XB, WL + W_OUT, 1024, 1024, EpiResid{p.out, p.out, 1.0f}, smem_blk); GSYNC;        \
    phase_ln(p, p.in[22] + (layer) * DM, p.in[23] + (layer) * DM); GSYNC;                                         \
    big_gemm(XB, WL + W_UP2, 5632, 1024, EpiSwiglu{(u16*)(p.ws + OFF_H)}, smem_blk); GSYNC;                       \
    big_gemm<true, true>(HB, WL + W_DN2, 1024, FF, EpiResid{p.out, p.out, 0.5f}, smem_blk); GSYNC;                                   \
    if ((layer) == 1) phase_ln<false>(p, p.in[27] + (layer) * DM, p.in[28] + (layer) * DM);                       \
    else phase_ln(p, p.in[27] + (layer) * DM, p.in[28] + (layer) * DM);                                           \
  }

__global__ void __launch_bounds__(512, 2) mega(Params p) {
  __shared__ __attribute__((aligned(16))) char smem_blk[SMEM_BYTES];
  char* smem = smem_blk + vhalf() * VSMEM;
  cg::grid_group grid = cg::this_grid();
  volatile LAS unsigned* st = (volatile LAS unsigned*)(smem_blk + 2 * VSMEM + 16);
  if (threadIdx.x == 0) { st[0] = 0u; st[1] = 0u; }
  __syncthreads();
  const XcdBarrier xb = xcd_barrier_post((unsigned*)(p.ws + OFF_BAR), st);
  phase_init(p, smem);
  if (p.ws == nullptr) grid.sync();
  GSYNC;
  LAYER(0)
  GSYNC;
  LAYER(1)
}

extern "C" void kernel_launch(void* const* d_in, const int* in_sizes, int n_in, void* d_out, int out_size, void* d_ws,
                              size_t ws_size, hipStream_t stream) {
  Params p{};
  for (int i = 0; i < 29; ++i) p.in[i] = (const float*)d_in[i];
  p.out = (float*)d_out;
  p.ws = (char*)d_ws;
  if (ws_size < WS_NEED) fprintf(stderr, "workspace too small: %zu < %zu\n", ws_size, (size_t)WS_NEED);
  static int grid_blocks = 0;
  if (!grid_blocks) {
    int dev = 0, cus = 0, per_cu = 0;
    hipGetDevice(&dev);
    hipDeviceGetAttribute(&cus, hipDeviceAttributeMultiprocessorCount, dev);
    hipOccupancyMaxActiveBlocksPerMultiprocessor(&per_cu, mega, 512, 0);
    if (per_cu < 1) per_cu = 1;
    if (per_cu > 1) per_cu = 1;
    grid_blocks = cus * per_cu;
  }
  (void)hipMemsetAsync((char*)d_ws + OFF_BAR, 0, XCD_BAR_WORDS * 4, stream);
  void* args[] = {&p};
  hipError_t e = hipLaunchCooperativeKernel((void*)mega, dim3(grid_blocks), dim3(512), args, 0, stream);
  if (e != hipSuccess) fprintf(stderr, "cooperative launch failed: %s (grid %d)\n", hipGetErrorString(e), grid_blocks);
}
```

```cpp
#include <hip/hip_runtime.h>
#include <hip/hip_cooperative_groups.h>
#include <stdint.h>
#include <stdio.h>
namespace cg = cooperative_groups;

#ifndef MULTI
#define MULTI 0
#endif

typedef unsigned short u16;
typedef __attribute__((ext_vector_type(8))) short bf16x8;
typedef __attribute__((ext_vector_type(4))) short s16x4;
typedef __attribute__((ext_vector_type(16))) float f32x16;
typedef __attribute__((ext_vector_type(4))) unsigned u32x4;
typedef __attribute__((ext_vector_type(2))) unsigned u32x2;
typedef __attribute__((ext_vector_type(2))) __bf16 bf2_t;
#define DI __device__ __forceinline__
#define MFMA(a, b, c) __builtin_amdgcn_mfma_f32_32x32x16_bf16((a), (b), (c), 0, 0, 0)
#define UNROLL _Pragma("unroll")

constexpr int NB = 8, T = 4096, DM = 1024, M = NB * T, FF = 2816;
constexpr float ALPHA = 1.4142135623730951f;
constexpr float NEGF = -1e30f;
constexpr float NEGR = -30000.f;
constexpr float LOG2E = 1.4426950408889634f;

constexpr size_t W_UP1 = 0;
constexpr size_t W_DN1 = W_UP1 + (size_t)5632 * 1024;
constexpr size_t W_IN = W_DN1 + (size_t)1024 * 2816;
constexpr size_t W_UQ = W_IN + (size_t)3840 * 1024;
constexpr size_t W_UKV = W_UQ + (size_t)768 * 256;
constexpr size_t W_CK1 = W_UKV + (size_t)1024 * 128;
constexpr size_t W_CK2 = W_CK1 + (size_t)128 * 2048;
constexpr size_t W_CV1 = W_CK2 + (size_t)64 * 128;
constexpr size_t W_CV2 = W_CV1 + (size_t)128 * 2048;
constexpr size_t W_PM = W_CV2 + (size_t)64 * 128;
constexpr size_t W_PN = W_PM + (size_t)1024 * 512;
constexpr size_t W_OUT = W_PN + (size_t)1024 * 512;
constexpr size_t W_UP2 = W_OUT + (size_t)1024 * 1024;
constexpr size_t W_DN2 = W_UP2 + (size_t)5632 * 1024;
constexpr size_t W_LAYER = W_DN2 + (size_t)1024 * 2816;

constexpr size_t al256(size_t x) { return (x + 255) & ~(size_t)255; }
constexpr size_t OFF_W = 0;
constexpr size_t OFF_BIAS = al256(OFF_W + 2 * W_LAYER * 2);
constexpr size_t OFF_COSN = al256(OFF_BIAS + 2 * 2 * 128 * 4);
constexpr size_t OFF_SINN = OFF_COSN + (size_t)T * 8 * 4;
constexpr size_t OFF_COSM = OFF_SINN + (size_t)T * 8 * 4;
constexpr size_t OFF_SINM = OFF_COSM + (size_t)T * 16 * 4;
constexpr size_t OFF_CNT = OFF_SINM + (size_t)T * 16 * 4;
constexpr size_t OFF_BAR = al256(OFF_CNT + 256);
constexpr size_t OFF_PART = al256(OFF_BAR + 3456 * 4);
constexpr size_t OFF_XB = al256(OFF_PART + (size_t)4 * 128 * 128 * 4);
constexpr size_t OFF_KM = OFF_XB;
constexpr size_t OFF_VM = OFF_XB + (size_t)M * 512 * 2;
constexpr size_t OFF_BIG = al256(OFF_XB + (size_t)M * 1024 * 2);
constexpr size_t OFF_H = OFF_BIG;
constexpr size_t OFF_CQ = OFF_BIG;
constexpr size_t OFF_CKV = OFF_CQ + (size_t)M * 256 * 2;
constexpr size_t OFF_QN = OFF_CKV + (size_t)M * 128 * 2;
constexpr size_t OFF_KV6 = OFF_QN + (size_t)M * 512 * 2;
constexpr size_t OFF_KPE = OFF_KV6 + (size_t)6 * M * 128 * 2;
constexpr size_t OFF_GATES = OFF_KPE + (size_t)M * 32 * 2;
constexpr size_t OFF_QM = OFF_GATES + (size_t)M * 24 * 4;
constexpr size_t OFF_GM = OFF_QM + (size_t)M * 768 * 2;
constexpr size_t OFF_GN = OFF_GM + (size_t)M * 1024 * 2;
constexpr size_t OFF_KC = OFF_GN + (size_t)M * 1024 * 2;
constexpr size_t OFF_VC = OFF_KC + (size_t)16 * 256 * 64 * 2;
constexpr size_t OFF_OM = al256(OFF_VC + (size_t)16 * 256 * 64 * 2 + 65536);
constexpr size_t OFF_ON = OFF_OM + (size_t)M * 512 * 2;
constexpr size_t OFF_MIXEND = OFF_ON + (size_t)M * 512 * 2;
constexpr size_t OFF_HEND = OFF_H + (size_t)M * FF * 2;
constexpr size_t WS_NEED = OFF_MIXEND > OFF_HEND ? OFF_MIXEND : OFF_HEND;

constexpr int VSMEM = 69632 + 8192 + 512;
constexpr int SMEM_BYTES = 2 * VSMEM + 64;

struct Params {
  const float* in[29];
  float* out;
  char* ws;
};

DI int ltid() {
  int t = __builtin_amdgcn_workitem_id_x() & 255;
  asm volatile("" : "+v"(t));
  return t;
}
DI size_t lz() {
  size_t z = 0;
  asm volatile("" : "+s"(z));
  return z;
}
DI int vhalf() {
  int t = __builtin_amdgcn_workitem_id_x();
  asm volatile("" : "+v"(t));
  return __builtin_amdgcn_readfirstlane(t >> 8);
}
DI int vbid() { return (int)blockIdx.x * 2 + vhalf(); }
DI int nvb() { return (int)gridDim.x * 2; }
typedef __attribute__((ext_vector_type(4))) float f32x4_nt;
DI float bf2f(u16 h) { return __uint_as_float(((unsigned)h) << 16); }
DI unsigned pk2(float a, float b) {
  bf2_t v;
  v[0] = (__bf16)a;
  v[1] = (__bf16)b;
  return __builtin_bit_cast(unsigned, v);
}
DI u16 f2bf(float a) { return (u16)(pk2(a, 0.f) & 0xffffu); }
DI float ex2(float x) { return __builtin_amdgcn_exp2f(x); }
DI float sigmoidf_(float x) { return __builtin_amdgcn_rcpf(1.f + __expf(-x)); }
DI bf16x8 pack8(const f32x16& v, int st) {
  u32x4 p;
  p[0] = pk2(v[8 * st + 0], v[8 * st + 1]);
  p[1] = pk2(v[8 * st + 2], v[8 * st + 3]);
  p[2] = pk2(v[8 * st + 4], v[8 * st + 5]);
  p[3] = pk2(v[8 * st + 6], v[8 * st + 7]);
  return __builtin_bit_cast(bf16x8, p);
}
DI s16x4 tr_read(const char* p) {
  return __builtin_amdgcn_ds_read_tr16_b64_v4i16((__attribute__((address_space(3))) s16x4*)(p));
}
DI float xh_max(float x) {
  const auto r = __builtin_amdgcn_permlane32_swap(__float_as_uint(x), __float_as_uint(x), false, false);
  return fmaxf(__uint_as_float(r[0]), __uint_as_float(r[1]));
}
DI float xh_sum(float x) {
  const auto r = __builtin_amdgcn_permlane32_swap(__float_as_uint(x), __float_as_uint(x), false, false);
  return __uint_as_float(r[0]) + __uint_as_float(r[1]);
}
DI float xh_get(float x, int hh) {
  const auto r = __builtin_amdgcn_permlane32_swap(__float_as_uint(x), __float_as_uint(x), false, false);
  return hh ? __uint_as_float(r[0]) : __uint_as_float(r[1]);
}
DI float quad_sum(float x) {
  x += __int_as_float(__builtin_amdgcn_update_dpp(0, __float_as_int(x), 0xB1, 0xF, 0xF, true));
  x += __int_as_float(__builtin_amdgcn_update_dpp(0, __float_as_int(x), 0x4E, 0xF, 0xF, true));
  return x;
}
DI void zero16(f32x16& v) {
  float z = 0.f;
  asm volatile("" : "+v"(z));
  UNROLL for (int i = 0; i < 16; ++i) v[i] = z;
}

DI void gemm_main(const u16* __restrict__ A, int lda, const u16* __restrict__ Bt, int ldb, int K,
                  f32x16 (&acc)[2][2], char* smem) {
  const int tid = ltid(), lane = tid & 63, w = tid >> 6, wr = w >> 1, wc = w & 1;
  const int lrow = tid >> 3, lch = tid & 7;
  const u16* ga = A + (size_t)lrow * lda + lch * 8;
  const u16* gb = Bt + (size_t)lrow * ldb + lch * 8;
  u32x4 ra[4], rb[4];
  UNROLL for (int i = 0; i < 4; ++i) {
    ra[i] = *(const u32x4*)(ga + (size_t)(32 * i) * lda);
    rb[i] = *(const u32x4*)(gb + (size_t)(32 * i) * ldb);
  }
  {
    char* pa = smem + lrow * 144 + lch * 16;
    UNROLL for (int i = 0; i < 4; ++i) {
      *(u32x4*)(pa + i * 32 * 144) = ra[i];
      *(u32x4*)(pa + 18432 + i * 32 * 144) = rb[i];
    }
  }
  __syncthreads();
  const int nk = K >> 6;
  _Pragma("unroll 1") for (int kt = 0; kt < nk; ++kt) {
    const bool more = (kt + 1 < nk);
    if (more) {
      const int k0 = (kt + 1) << 6;
      UNROLL for (int i = 0; i < 4; ++i) {
        ra[i] = *(const u32x4*)(ga + (size_t)(32 * i) * lda + k0);
        rb[i] = *(const u32x4*)(gb + (size_t)(32 * i) * ldb + k0);
      }
    }
    const char* pa = smem + (kt & 1) * 36864 + (wr * 64 + (lane & 31)) * 144 + (lane >> 5) * 16;
    const char* pb = smem + (kt & 1) * 36864 + 18432 + (wc * 64 + (lane & 31)) * 144 + (lane >> 5) * 16;
    UNROLL for (int ks = 0; ks < 4; ++ks) {
      bf16x8 a0 = *(const bf16x8*)(pa + ks * 32);
      bf16x8 a1 = *(const bf16x8*)(pa + 32 * 144 + ks * 32);
      bf16x8 b0 = *(const bf16x8*)(pb + ks * 32);
      bf16x8 b1 = *(const bf16x8*)(pb + 32 * 144 + ks * 32);
      acc[0][0] = MFMA(a0, b0, acc[0][0]);
      acc[0][1] = MFMA(a0, b1, acc[0][1]);
      acc[1][0] = MFMA(a1, b0, acc[1][0]);
      acc[1][1] = MFMA(a1, b1, acc[1][1]);
    }
    if (more) {
      char* pw = smem + ((kt + 1) & 1) * 36864 + lrow * 144 + lch * 16;
      UNROLL for (int i = 0; i < 4; ++i) {
        *(u32x4*)(pw + i * 32 * 144) = ra[i];
        *(u32x4*)(pw + 18432 + i * 32 * 144) = rb[i];
      }
    }
    __syncthreads();
  }
}

#define EPI_VARS const int tid = ltid(), lane = tid & 63, w = tid >> 6, wr = w >> 1, wc = w & 1, l31 = lane & 31, hh = lane >> 5; (void)l31; (void)hh; (void)wr; (void)wc;
#define EROW(mi, i) (wr * 64 + (mi) * 32 + 8 * ((i) >> 2) + 4 * hh + ((i) & 3))

DI void convT(const float* __restrict__ src0, const float* __restrict__ src1, int ldsrc, int K, int Nout,
              int kind, const float* __restrict__ scale, u16* __restrict__ dst, char* smem, int slab) {
  float* t = (float*)smem;
  const int tid = ltid();
  const int tiles_n = (Nout + 255) >> 8, tiles_k = K >> 6;
  for (int tile = vbid(); tile < tiles_n * tiles_k; tile += nvb()) {
    const int tn = tile % tiles_n, tk = tile / tiles_n;
    {
      const int nn = tid, n = tn * 256 + nn;
      const float* src = src0;
      int col = n;
      if (kind == 1) {
        const int j = n >> 8, r = n & 255;
        col = 128 * j + (r & 127);
        src = (r >> 7) ? src1 : src0;
      } else if (kind == 2) {
        if (n < 384) col = n;
        else if (n < 896) col = 416 + (n - 384);
        else if (n < 1664) col = 928 + (n - 896);
        else if (n < 2688) col = 1720 + (n - 1664);
        else if (n < 3712) col = 2744 + (n - 2688);
        else if (n < 3744) col = 384 + (n - 3712);
        else if (n < 3768) col = 1696 + (n - 3744);
        else col = -1;
      } else if (kind == 3) {
        if (n < 512) col = (n >> 6) * 96 + (n & 63);
        else col = ((n - 512) >> 5) * 96 + 64 + ((n - 512) & 31);
      }
      if (n >= Nout) col = -1;
      _Pragma("unroll 1") for (int kb = 0; kb < 4; ++kb) {
        float v[16];
        UNROLL for (int i = 0; i < 16; ++i) {
          const int k = tk * 64 + kb * 16 + i;
          v[i] = (col >= 0) ? __builtin_nontemporal_load(src + (size_t)k * ldsrc + col) : 0.f;
          if (scale) v[i] *= scale[k];
        }
        UNROLL for (int i = 0; i < 16; ++i) t[(kb * 16 + i) * 257 + nn] = v[i];
      }
    }
    __syncthreads();
    {
      const int k8 = (tid & 7) * 8;
      UNROLL for (int i = 0; i < 8; ++i) {
        const int n2 = (tid >> 3) + 32 * i, n = tn * 256 + n2;
        if (n < Nout) {
          u32x4 o;
          o[0] = pk2(t[(k8 + 0) * 257 + n2], t[(k8 + 1) * 257 + n2]);
          o[1] = pk2(t[(k8 + 2) * 257 + n2], t[(k8 + 3) * 257 + n2]);
          o[2] = pk2(t[(k8 + 4) * 257 + n2], t[(k8 + 5) * 257 + n2]);
          o[3] = pk2(t[(k8 + 6) * 257 + n2], t[(k8 + 7) * 257 + n2]);
          const size_t di = slab ? ((size_t)(((n >> 8) * (K >> 6) + tk) * 256 + (n & 255)) * 64 + k8) : ((size_t)n * K + tk * 64 + k8);
          *(u32x4*)(dst + di) = o;
        }
      }
    }
    __syncthreads();
  }
}

DI void phase_init(const Params& p, char* smem) {
  const int tid = ltid();
  const size_t gtid = (size_t)vbid() * 256 + tid, gsz = (size_t)nvb() * 256;
  if (vbid() == 0 && tid < 64) ((int*)(p.ws + OFF_CNT))[tid] = 0;
  {
    const float4* xs = (const float4*)p.in[0];
    u32x2* xb = (u32x2*)(p.ws + OFF_XB);
    const size_t n4 = (size_t)M * DM / 4;
    for (size_t i = gtid; i < n4; i += 4 * gsz) {
      float4 v[4];
      UNROLL for (int u = 0; u < 4; ++u) if (i + u * gsz < n4) {
        const f32x4_nt t4 = __builtin_nontemporal_load((const f32x4_nt*)(xs + i + u * gsz));
        v[u] = make_float4(t4[0], t4[1], t4[2], t4[3]);
      }
      UNROLL for (int u = 0; u < 4; ++u) if (i + u * gsz < n4) {
        u32x2 o;
        o[0] = pk2(v[u].x, v[u].y);
        o[1] = pk2(v[u].z, v[u].w);
        xb[i + u * gsz] = o;
      }
    }
  }
  {
    float* cn = (float*)(p.ws + OFF_COSN);
    float* sn = (float*)(p.ws + OFF_SINN);
    float* cm = (float*)(p.ws + OFF_COSM);
    float* sm = (float*)(p.ws + OFF_SINM);
    for (size_t i = gtid; i < (size_t)T * 24; i += gsz) {
      const int t = (int)(i / 24), j = (int)(i % 24);
      if (j < 8) {
        const float inv = (float)(1.0 / pow(500000.0, (double)(2 * j) / 16.0));
        const float ang = (float)t * inv;
        cn[t * 8 + j] = (float)cos((double)ang);
        sn[t * 8 + j] = (float)sin((double)ang);
      } else {
        const int m = j - 8;
        const float inv = (float)(1.0 / pow(500000.0, (double)(2 * m) / 32.0));
        const float ang = (float)t * inv;
        cm[t * 16 + m] = (float)cos((double)ang);
        sm[t * 16 + m] = (float)sin((double)ang);
      }
    }
  }
  for (int u = vbid(); u < 512; u += nvb()) {
    const int job = u >> 7, chunk = u & 127, layer = job >> 1, kv = job & 1;
    const float* pe = p.in[kv ? 15 : 11] + (size_t)layer * 2048;
    const float* w1 = p.in[kv ? 16 : 12] + (size_t)layer * 2048 * 128;
    float* red = (float*)smem;
    const int n = tid & 127, sub = tid >> 7;
    float sacc = 0.f;
    UNROLL for (int i = 0; i < 8; ++i) {
      const int kk = chunk * 16 + sub * 8 + i;
      sacc += pe[kk] * w1[(size_t)kk * 128 + n];
    }
    red[tid] = sacc;
    __syncthreads();
    if (tid < 128) ((float*)(p.ws + OFF_PART))[(size_t)(job * 128 + chunk) * 128 + n] = red[tid] + red[tid + 128];
    __syncthreads();
  }
  for (int job = 0; job < 28; ++job) {
    const int layer = job / 14, jj = job % 14;
    u16* wl = (u16*)(p.ws + OFF_W) + (size_t)layer * W_LAYER;
    const float* s0 = nullptr; const float* s1 = nullptr; const float* sc = nullptr;
    int ldsrc = 0, K = 0, Nout = 0, kind = 0; size_t woff = 0;
    switch (jj) {
      case 0: s0 = p.in[3] + (size_t)layer * DM * FF; s1 = p.in[4] + (size_t)layer * DM * FF; ldsrc = FF; K = 1024; Nout = 5632; kind = 1; woff = W_UP1; break;
      case 1: s0 = p.in[5] + (size_t)layer * FF * DM; ldsrc = DM; K = FF; Nout = 1024; woff = W_DN1; break;
      case 2: s0 = p.in[6] + (size_t)layer * DM * 3768; ldsrc = 3768; K = 1024; Nout = 3840; kind = 2; woff = W_IN; break;
      case 3: s0 = p.in[8] + (size_t)layer * 256 * 768; ldsrc = 768; K = 256; Nout = 768; kind = 3; sc = p.in[7] + layer * 256; woff = W_UQ; break;
      case 4: s0 = p.in[10] + (size_t)layer * 128 * 1024; ldsrc = 1024; K = 128; Nout = 1024; sc = p.in[9] + layer * 128; woff = W_UKV; break;
      case 5: s0 = p.in[12] + (size_t)layer * 2048 * 128; ldsrc = 128; K = 2048; Nout = 128; woff = W_CK1; break;
      case 6: s0 = p.in[14] + (size_t)layer * 128 * 64; ldsrc = 64; K = 128; Nout = 64; woff = W_CK2; break;
      case 7: s0 = p.in[16] + (size_t)layer * 2048 * 128; ldsrc = 128; K = 2048; Nout = 128; woff = W_CV1; break;
      case 8: s0 = p.in[18] + (size_t)layer * 128 * 64; ldsrc = 64; K = 128; Nout = 64; woff = W_CV2; break;
      case 9: s0 = p.in[19] + (size_t)layer * 512 * 1024; ldsrc = 1024; K = 512; Nout = 1024; woff = W_PM; break;
      case 10: s0 = p.in[20] + (size_t)layer * 512 * 1024; ldsrc = 1024; K = 512; Nout = 1024; woff = W_PN; break;
      case 11: s0 = p.in[21] + (size_t)layer * 1024 * 1024; ldsrc = 1024; K = 1024; Nout = 1024; woff = W_OUT; break;
      case 12: s0 = p.in[24] + (size_t)layer * DM * FF; s1 = p.in[25] + (size_t)layer * DM * FF; ldsrc = FF; K = 1024; Nout = 5632; kind = 1; woff = W_UP2; break;
      default: s0 = p.in[26] + (size_t)layer * FF * DM; ldsrc = DM; K = FF; Nout = 1024; woff = W_DN2; break;
    }
    convT(s0, s1, ldsrc, K, Nout, kind, sc, wl + woff, smem, (jj == 1 || jj == 13) ? 1 : 0);
  }
}

namespace pg8 {
#define PG8_LAS __attribute__((address_space(3)))
typedef unsigned short bf16_t;
typedef short bf16x8 __attribute__((ext_vector_type(8)));
typedef float f32x4 __attribute__((ext_vector_type(4)));
typedef unsigned u32x4 __attribute__((ext_vector_type(4)));
constexpr int BM = 256, BK = 64, HALF = 128, HTB = HALF * BK * 2  , STAGE_BYTES = 8 * HTB, NXCD = 8, WGM = 8;

__host__ __device__ __forceinline__ int lds_byte(int r, int c) { const int st = (r >> 4) * 2 + (c >> 5), rr = r & 15, cc = c & 31, ob = rr * 64 + cc * 2; return st * 1024 + (ob ^ (((ob >> 9) & 1) << 5)); }
__host__ __device__ __forceinline__ void stage_rc(int b, int& R, int& C) { const int st = b / 1024, sb = b % 1024, swz = sb ^ (((sb >> 9) & 1) << 5); R = (st >> 1) * 16 + swz / 64; C = (st & 1) * 32 + (swz % 64) / 2; }
__host__ __device__ __forceinline__ int perm32(int rho) { const int n = rho >> 4, i = rho & 15; return 8 * (i >> 2) + 4 * n + (i & 3); }

struct Unit { int pm, pn; };
struct Gemm { const bf16_t* A; const bf16_t* Bt; int M, N, K; };

struct StaticOrder {
    int nM, nN, nwg, G, c;
    __host__ __device__ void init(int M, int N, int G_, int c_) { nM = M / BM; nN = N / BM; nwg = nM * nN; G = G_; c = c_; }
    __host__ __device__ bool next(int i, Unit& u) const {
        const long L = (long)i * G + c; if (L >= nwg) return false;
        int wgid = (int)L; { const int q = nwg / NXCD, r = nwg % NXCD, xcd = wgid % NXCD, off = wgid / NXCD; wgid = (xcd < r ? xcd * (q + 1) : r * (q + 1) + (xcd - r) * q) + off; }
        const int nig = WGM * nN, gid = wgid / nig, fm = gid * WGM, gsz = (nM - fm) < WGM ? (nM - fm) : WGM;
        u.pm = fm + ((wgid % nig) % gsz); u.pn = (wgid % nig) / gsz; return true;
    }
    __device__ __forceinline__ void a_ready(const Unit&) const {}
    __device__ __forceinline__ void done(const Unit&) const {}
};

template <class Epi, class Sched, bool STAMP = false, bool ATILED = false, bool BTILED = false>
__device__ __forceinline__ void gemm_phase(PG8_LAS unsigned char* lds, const Gemm g, const Sched& S, const Epi& E, unsigned long long* stamps) {
    int tid = threadIdx.x; asm volatile("" : "+v"(tid));
    const int wid = __builtin_amdgcn_readfirstlane(tid >> 6), lane = tid & 63, wr = wid >> 2, wc = wid & 3, fr = lane & 15, fq = lane >> 4;
    const int K = g.K, nt = K / BK;
    int ts_lo = 0, ts_hi = 0, nts = 0; const unsigned long long rt_entry = STAMP ? (unsigned long long)wall_clock64() : 0ull;
#define PG8_STAMP() do { if (STAMP && wid == 0 && nts < 64) { const unsigned long long _c = (unsigned long long)clock64(); \
        ts_lo = (lane == nts) ? (int)(unsigned)_c : ts_lo; ts_hi = (lane == nts) ? (int)(unsigned)(_c >> 32) : ts_hi; ++nts; } } while (0)
    PG8_STAMP();
    unsigned voffA[2], voffB[2];
#pragma unroll
    for (int i = 0; i < 2; ++i) { int R, C; stage_rc(tid * 16 + i * 8192, R, C); const int Rb = Epi::PERM ? ((R & ~31) + perm32(R & 31)) : R;
        voffA[i] = (unsigned)(R * (ATILED ? BK : K) + C) * 2u; voffB[i] = (unsigned)(Rb * (BTILED ? BK : K) + C) * 2u; }
    const size_t kstep = (size_t)(BK * 2);
    const size_t hstep = (size_t)HALF * K * 2;
    const size_t tstep = 2 * hstep;
    const size_t kstepA = ATILED ? (size_t)(BM * BK * 2) : kstep, hstepA = ATILED ? (size_t)(HALF * BK * 2) : hstep, tstepA = ATILED ? (size_t)(K / BK) * (size_t)(BM * BK * 2) : tstep;
    const size_t kstepB = BTILED ? (size_t)(BM * BK * 2) : kstep, hstepB = BTILED ? (size_t)(HALF * BK * 2) : hstep, tstepB = BTILED ? (size_t)(K / BK) * (size_t)(BM * BK * 2) : tstep;
    const unsigned ldsw = (unsigned)wid * 1024u;
    const int aoff = lds_byte(wr * 64 + fr, fq * 8), boff = lds_byte(wc * 32 + fr, fq * 8);
#define PG8_SA(b, h) (((b) * 2 + (h)) * HTB)
#define PG8_SB(b, h) ((4 + (b) * 2 + (h)) * HTB)
#define PG8_STAGE(bufoff, gbase, voff) do { _Pragma("unroll") for (int _i = 0; _i < 2; ++_i) \
        __builtin_amdgcn_global_load_lds((const unsigned*)((const char*)(gbase) + (voff)[_i]), (PG8_LAS unsigned*)(lds + (bufoff) + ldsw + _i * 8192), 16, 0, 0); } while (0)
#define PG8_LDA(dst, b, h) do { _Pragma("unroll") for (int m = 0; m < 4; ++m) _Pragma("unroll") for (int k = 0; k < 2; ++k) dst[m][k] = *(const PG8_LAS bf16x8*)(lds + PG8_SA(b, h) + aoff + m * 2048 + k * 1024); } while (0)
#define PG8_LDB(dst, b, h) do { _Pragma("unroll") for (int n = 0; n < 2; ++n) _Pragma("unroll") for (int k = 0; k < 2; ++k) dst[n][k] = *(const PG8_LAS bf16x8*)(lds + PG8_SB(b, h) + boff + n * 2048 + k * 1024); } while (0)
#define PG8_MMA(ai, bj, At, Bt) do { __builtin_amdgcn_s_setprio(1); _Pragma("unroll") for (int m = 0; m < 4; ++m) _Pragma("unroll") for (int n = 0; n < 2; ++n) _Pragma("unroll") for (int k = 0; k < 2; ++k) \
        acc[ai][bj][m][n] = __builtin_amdgcn_mfma_f32_16x16x32_bf16(Bt[n][k], At[m][k], acc[ai][bj][m][n], 0, 0, 0); __builtin_amdgcn_s_setprio(0); } while (0)
#define PG8_WAIT_V(n) asm volatile("s_waitcnt vmcnt(" #n ")" ::: "memory")
#define PG8_WAIT_L(n) asm volatile("s_waitcnt lgkmcnt(" #n ")" ::: "memory")
#define PG8_BAR __builtin_amdgcn_s_barrier()
#define PG8_SCHED __builtin_amdgcn_sched_barrier(0)
    Unit cur, nxt; int ui = 0;
    if (!S.next(0, cur)) return;
    f32x4 acc[2][2][4][2];
#pragma unroll
    for (int a = 0; a < 2; ++a)
#pragma unroll
        for (int b = 0; b < 2; ++b)
#pragma unroll
            for (int m = 0; m < 4; ++m)
#pragma unroll
                for (int n = 0; n < 2; ++n) acc[a][b][m][n] = (f32x4){0.f, 0.f, 0.f, 0.f};
    bf16x8 At[4][2], B0[2][2], B1[2][2];
    const char* cA = (const char*)g.A + (size_t)cur.pm * tstepA; const char* cB = (const char*)g.Bt + (size_t)cur.pn * tstepB;
    S.a_ready(cur);
    PG8_STAGE(PG8_SB(0, 0), cB, voffB); PG8_STAGE(PG8_SA(0, 0), cA, voffA); PG8_STAGE(PG8_SB(0, 1), cB + hstepB, voffB); PG8_STAGE(PG8_SA(0, 1), cA + hstepA, voffA);
    if (wr == 1) PG8_BAR;
    PG8_WAIT_V(4); PG8_BAR;
    PG8_STAGE(PG8_SB(1, 0), cB + kstepB, voffB); PG8_STAGE(PG8_SA(1, 0), cA + kstepA, voffA); PG8_STAGE(PG8_SB(1, 1), cB + hstepB + kstepB, voffB);
    PG8_WAIT_V(6); PG8_BAR;
    PG8_STAMP();
    for (;;) {
        const bool has_next = S.next(ui + 1, nxt);
        const char* nA = has_next ? (const char*)g.A + (size_t)nxt.pm * tstepA : cA; const char* nB = has_next ? (const char*)g.Bt + (size_t)nxt.pn * tstepB : cB;
        for (int t = 0; t < nt; t += 2) {
            const bool last = (t == nt - 2);
            const char* a1 = cA + (size_t)(t + 1) * kstepA;
            const char* a2 = last ? nA : cA + (size_t)(t + 2) * kstepA; const char* b2 = last ? nB : cB + (size_t)(t + 2) * kstepB;
            const char* a3 = a2 + kstepA; const char* b3 = b2 + kstepB;
            if (last && has_next) S.a_ready(nxt);
            PG8_LDB(B0, 0, 0); PG8_SCHED; PG8_LDA(At, 0, 0); PG8_STAGE(PG8_SA(1, 1), a1 + hstepA, voffA);
            PG8_WAIT_L(8); PG8_BAR; PG8_WAIT_L(0); PG8_MMA(0, 0, At, B0); PG8_BAR; PG8_SCHED;
            PG8_LDB(B1, 0, 1); PG8_STAGE(PG8_SB(0, 0), b2, voffB);
            PG8_BAR; PG8_WAIT_L(0); PG8_MMA(0, 1, At, B1); PG8_BAR;
            PG8_LDA(At, 0, 1); PG8_STAGE(PG8_SA(0, 0), a2, voffA);
            PG8_BAR; PG8_WAIT_L(0); PG8_MMA(1, 0, At, B0); PG8_BAR; PG8_SCHED;
            PG8_STAGE(PG8_SB(0, 1), b2 + hstepB, voffB);
            PG8_WAIT_V(6); PG8_BAR; PG8_MMA(1, 1, At, B1); PG8_BAR;
            PG8_LDB(B0, 1, 0); PG8_SCHED; PG8_LDA(At, 1, 0); PG8_STAGE(PG8_SA(0, 1), a2 + hstepA, voffA);
            PG8_WAIT_L(8); PG8_BAR; PG8_WAIT_L(0); PG8_MMA(0, 0, At, B0); PG8_BAR; PG8_SCHED;
            PG8_LDB(B1, 1, 1); PG8_STAGE(PG8_SB(1, 0), b3, voffB);
            PG8_BAR; PG8_WAIT_L(0); PG8_MMA(0, 1, At, B1); PG8_BAR;
            PG8_LDA(At, 1, 1); PG8_STAGE(PG8_SA(1, 0), a3, voffA);
            PG8_BAR; PG8_WAIT_L(0); PG8_MMA(1, 0, At, B0); PG8_BAR; PG8_SCHED;
            PG8_STAGE(PG8_SB(1, 1), b3 + hstepB, voffB);
            PG8_WAIT_V(6); PG8_BAR; PG8_MMA(1, 1, At, B1); PG8_BAR;
        }
        PG8_STAMP();
        if constexpr (!Epi::AFTER_DRAIN) { E(acc, cur, wr, wc, fr, fq); S.done(cur); }
        PG8_STAMP();
        if (!has_next) break;
#pragma unroll
        for (int a = 0; a < 2; ++a)
#pragma unroll
            for (int b = 0; b < 2; ++b)
#pragma unroll
                for (int m = 0; m < 4; ++m)
#pragma unroll
                    for (int n = 0; n < 2; ++n) acc[a][b][m][n] = (f32x4){0.f, 0.f, 0.f, 0.f};
        cur = nxt; cA = nA; cB = nB; ++ui;
    }
    PG8_WAIT_V(0);
    if (wr == 0) PG8_BAR;
    PG8_BAR;
    if constexpr (Epi::AFTER_DRAIN) { E.fused(acc, cur, wr, wc, fr, fq, lds, wid, lane); S.done(cur); }
    PG8_STAMP();
    if (STAMP && wid == 0) { stamps[lane] = lane < nts ? (((unsigned long long)(unsigned)ts_hi << 32) | (unsigned)ts_lo) : 0ull;
        if (lane == 62) stamps[62] = rt_entry; if (lane == 63) stamps[63] = (unsigned long long)wall_clock64(); }
#undef PG8_STAMP
#undef PG8_SA
#undef PG8_SB
#undef PG8_STAGE
#undef PG8_LDA
#undef PG8_LDB
#undef PG8_MMA
#undef PG8_WAIT_V
#undef PG8_WAIT_L
#undef PG8_BAR
#undef PG8_SCHED
}
}

typedef pg8::f32x4 f32x4_t;
DI f32x4_t ld4(const float* p) { return *(const f32x4_t*)p; }

struct EpiSwiglu {
  static constexpr bool PERM = true, AFTER_DRAIN = false;
  u16* H;
  __device__ __forceinline__ void operator()(const f32x4_t (&acc)[2][2][4][2], const pg8::Unit& u, int wr, int wc, int fr, int fq) const {
    u16* base = H + ((size_t)(u.pm * (FF / 64) + 2 * u.pn + (wc >> 1)) * 256) * 64 + (size_t)((wr * 64 + fr) * 64 + (wc & 1) * 32 + fq * 8);
    UNROLL for (int ai = 0; ai < 2; ++ai) UNROLL for (int m = 0; m < 4; ++m) {
      float h[8];
      UNROLL for (int n = 0; n < 2; ++n) UNROLL for (int j = 0; j < 4; ++j) {
        const float g = acc[ai][0][m][n][j], up = acc[ai][1][m][n][j];
        h[4 * n + j] = g * __builtin_amdgcn_rcpf(1.f + __expf(-g)) * up;
      }
      u32x4 o;
      o[0] = pk2(h[0], h[1]); o[1] = pk2(h[2], h[3]); o[2] = pk2(h[4], h[5]); o[3] = pk2(h[6], h[7]);
      *(u32x4*)(base + (ai * 128 + m * 16) * 64) = o;
    }
  }
};

struct EpiResid {
  static constexpr bool PERM = true, AFTER_DRAIN = false;
  const float* Xin; float* X; float coef;
  __device__ __forceinline__ void operator()(const f32x4_t (&acc)[2][2][4][2], const pg8::Unit& u, int wr, int wc, int fr, int fq) const {
    UNROLL for (int ai = 0; ai < 2; ++ai) UNROLL for (int m = 0; m < 4; ++m) {
      const int row = u.pm * 256 + ai * 128 + wr * 64 + m * 16 + fr;
      UNROLL for (int bj = 0; bj < 2; ++bj) {
        const size_t off = (size_t)row * DM + u.pn * 256 + bj * 128 + wc * 32 + fq * 8;
        UNROLL for (int n = 0; n < 2; ++n) {
          f32x4_t x = *(const f32x4_t*)(Xin + off + 4 * n);
          x = x * ALPHA + acc[ai][bj][m][n] * coef;
          *(f32x4_t*)(X + off + 4 * n) = x;
        }
      }
    }
  }
};

struct EpiGate1 {
  static constexpr bool PERM = true, AFTER_DRAIN = false;
  u16* GM;
  __device__ __forceinline__ void operator()(const f32x4_t (&acc)[2][2][4][2], const pg8::Unit& u, int wr, int wc, int fr, int fq) const {
    UNROLL for (int ai = 0; ai < 2; ++ai) UNROLL for (int m = 0; m < 4; ++m) {
      const int row = u.pm * 256 + ai * 128 + wr * 64 + m * 16 + fr;
      UNROLL for (int bj = 0; bj < 2; ++bj) {
        u16* pg = GM + (size_t)row * 1024 + u.pn * 256 + bj * 128 + wc * 32 + fq * 8;
        const u32x4 g = *(const u32x4*)pg;
        u32x4 o;
        UNROLL for (int e = 0; e < 4; ++e) {
          const float lo = __uint_as_float(g[e] << 16) * acc[ai][bj][m][e >> 1][(e & 1) * 2];
          const float hi = __uint_as_float(g[e] & 0xffff0000u) * acc[ai][bj][m][e >> 1][(e & 1) * 2 + 1];
          o[e] = pk2(lo, hi);
        }
        *(u32x4*)pg = o;
      }
    }
  }
};
struct EpiGate2 {
  static constexpr bool PERM = true, AFTER_DRAIN = false;
  const u16* GM; const u16* GN; u16* Y;
  __device__ __forceinline__ void operator()(const f32x4_t (&acc)[2][2][4][2], const pg8::Unit& u, int wr, int wc, int fr, int fq) const {
    UNROLL for (int ai = 0; ai < 2; ++ai) UNROLL for (int m = 0; m < 4; ++m) {
      const int row = u.pm * 256 + ai * 128 + wr * 64 + m * 16 + fr;
      UNROLL for (int bj = 0; bj < 2; ++bj) {
        const size_t off = (size_t)row * 1024 + u.pn * 256 + bj * 128 + wc * 32 + fq * 8;
        const u32x4 t1 = *(const u32x4*)(GM + off);
        const u32x4 g = *(const u32x4*)(GN + off);
        u32x4 o;
        UNROLL for (int e = 0; e < 4; ++e) {
          const float lo = __uint_as_float(t1[e] << 16) + __uint_as_float(g[e] << 16) * acc[ai][bj][m][e >> 1][(e & 1) * 2];
          const float hi = __uint_as_float(t1[e] & 0xffff0000u) + __uint_as_float(g[e] & 0xffff0000u) * acc[ai][bj][m][e >> 1][(e & 1) * 2 + 1];
          o[e] = pk2(lo, hi);
        }
        *(u32x4*)(Y + off) = o;
      }
    }
  }
};

struct EpiWin {
  static constexpr bool PERM = true, AFTER_DRAIN = false;
  char* ws_;
  __device__ __forceinline__ void operator()(const f32x4_t (&acc)[2][2][4][2], const pg8::Unit& u, int wr, int wc, int fr, int fq) const {
    char* ws = ws_ + lz();
    u16* CQ = (u16*)(ws + OFF_CQ);
    u16* CKV = (u16*)(ws + OFF_CKV);
    u16* QN = (u16*)(ws + OFF_QN);
    u16* KV6 = (u16*)(ws + OFF_KV6);
    u16* KPE = (u16*)(ws + OFF_KPE);
    float* GATES = (float*)(ws + OFF_GATES);
    u16* GM = (u16*)(ws + OFF_GM);
    u16* GN = (u16*)(ws + OFF_GN);
    const float* COSN = (const float*)(ws + OFF_COSN);
    const float* SINN = (const float*)(ws + OFF_SINN);
    const float* COSM = (const float*)(ws + OFF_COSM);
    const float* SINM = (const float*)(ws + OFF_SINM);
    UNROLL for (int bj = 0; bj < 2; ++bj) {
      const int hc = 2 * u.pn + bj;
      const int cin = wc * 32 + fq * 8;
      UNROLL for (int ai = 0; ai < 2; ++ai) UNROLL for (int m = 0; m < 4; ++m) {
        const int row = u.pm * 256 + ai * 128 + wr * 64 + m * 16 + fr;
        const int t = row & (T - 1), b = row >> 12;
        float v[8];
        UNROLL for (int n = 0; n < 2; ++n) UNROLL for (int j = 0; j < 4; ++j) v[4 * n + j] = acc[ai][bj][m][n][j];
        if (hc < 3) {
          u16* dst = hc < 2 ? (CQ + (size_t)row * 256 + hc * 128 + cin) : (CKV + (size_t)row * 128 + cin);
          u32x4 o;
          o[0] = pk2(v[0], v[1]); o[1] = pk2(v[2], v[3]); o[2] = pk2(v[4], v[5]); o[3] = pk2(v[6], v[7]);
          *(u32x4*)dst = o;
        } else if (hc < 13) {
          const bool isq = hc < 7;
          const int j6 = hc - 7;
          const bool rope_on = isq || ((j6 & 1) == 0);
          if ((wc & 1) == 0) {
            float pr[8];
            UNROLL for (int e = 0; e < 8; ++e) pr[e] = __shfl_xor(v[e], 16);
            if (rope_on && fq < 2) {
              const f32x4_t c0 = ld4(COSN + t * 8), c1 = ld4(COSN + t * 8 + 4), s0 = ld4(SINN + t * 8), s1 = ld4(SINN + t * 8 + 4);
              UNROLL for (int e = 0; e < 8; ++e) {
                const float cs = e < 4 ? c0[e & 3] : c1[e & 3], sn = e < 4 ? s0[e & 3] : s1[e & 3];
                v[e] = (fq == 0) ? (v[e] * cs - pr[e] * sn) : (v[e] * cs + pr[e] * sn);
              }
            }
          }
          const int d = (wc & 1) * 32 + fq * 8;
          u16* dst = isq ? (QN + (size_t)row * 512 + (2 * (hc - 3) + (wc >> 1)) * 64 + d)
                         : (KV6 + ((size_t)((j6 * NB + b) * 2 + (wc >> 1)) * T + t) * 64 + d);
          u32x4 o;
          o[0] = pk2(v[0], v[1]); o[1] = pk2(v[2], v[3]); o[2] = pk2(v[4], v[5]); o[3] = pk2(v[6], v[7]);
          *(u32x4*)dst = o;
        } else if (hc < 29) {
          u16* dst = (hc < 21 ? GM : GN) + (size_t)row * 1024 + (hc < 21 ? hc - 13 : hc - 21) * 128 + cin;
          u32x4 o;
          o[0] = pk2(sigmoidf_(v[0]), sigmoidf_(v[1])); o[1] = pk2(sigmoidf_(v[2]), sigmoidf_(v[3]));
          o[2] = pk2(sigmoidf_(v[4]), sigmoidf_(v[5])); o[3] = pk2(sigmoidf_(v[6]), sigmoidf_(v[7]));
          *(u32x4*)dst = o;
        } else {
          if (wc == 0) {
            float pr[8];
            UNROLL for (int e = 0; e < 8; ++e) pr[e] = __shfl_xor(v[e], 32);
            const int mb = (fq & 1) * 8;
            const f32x4_t c0 = ld4(COSM + t * 16 + mb), c1 = ld4(COSM + t * 16 + mb + 4), s0 = ld4(SINM + t * 16 + mb), s1 = ld4(SINM + t * 16 + mb + 4);
            UNROLL for (int e = 0; e < 8; ++e) {
              const float cs = e < 4 ? c0[e & 3] : c1[e & 3], sn = e < 4 ? s0[e & 3] : s1[e & 3];
              v[e] = (fq < 2) ? (v[e] * cs - pr[e] * sn) : (v[e] * cs + pr[e] * sn);
            }
            u32x4 o;
            o[0] = pk2(v[0], v[1]); o[1] = pk2(v[2], v[3]); o[2] = pk2(v[4], v[5]); o[3] = pk2(v[6], v[7]);
            *(u32x4*)(KPE + (size_t)row * 32 + fq * 8) = o;
          } else if (wc == 1 && fq < 3) {
            float* dst = GATES + (size_t)row * 24 + fq * 8;
            f32x4_t g0, g1;
            UNROLL for (int e = 0; e < 4; ++e) { g0[e] = sigmoidf_(v[e]); g1[e] = sigmoidf_(v[4 + e]); }
            *(f32x4_t*)dst = g0;
            *(f32x4_t*)(dst + 4) = g1;
          }
        }
      }
    }
  }
};

template <bool ATILED = false, bool BTILED = false, class Epi>
DI void big_gemm(const u16* A, const u16* Bt, int N, int K, const Epi& E, char* smem_blk) {
  pg8::Gemm g{A, Bt, M, N, K};
  pg8::StaticOrder S;
  S.init(M, N, (int)gridDim.x, (int)blockIdx.x);
  pg8::gemm_phase<Epi, pg8::StaticOrder, false, ATILED, BTILED>((PG8_LAS unsigned char*)smem_blk, g, S, E, nullptr);
  __syncthreads();
}

DI void bias_reduce(const Params& p) {
  const int vb = vbid(), tid = ltid();
  if (vb < 4 && tid < 128) {
    const int job = vb, layer = job >> 1, kv = job & 1;
    const float* part = (const float*)(p.ws + OFF_PART) + (size_t)job * 128 * 128;
    float sacc = (p.in[kv ? 17 : 13] + (size_t)layer * 128)[tid];
    for (int ch = 0; ch < 128; ++ch) sacc += part[ch * 128 + tid];
    ((float*)(p.ws + OFF_BIAS))[job * 128 + tid] = sacc;
  }
}

template <bool WXB = true>
DI void phase_ln(const Params& p, const float* g, const float* b) {
  const int tid = ltid(), lane = tid & 63, w = tid >> 6;
  float* X = p.out;
  u16* Xb = (u16*)(p.ws + OFF_XB);
  float4 gv[4], bv[4];
  UNROLL for (int i = 0; i < 4; ++i) {
    gv[i] = *(const float4*)(g + i * 256 + lane * 4);
    bv[i] = *(const float4*)(b + i * 256 + lane * 4);
  }
  for (int row0 = vbid() * 4 + w; row0 < M; row0 += nvb() * 8) {
    int row1 = row0 + nvb() * 4;
    const bool has1 = row1 < M;
    if (!has1) row1 = row0;
    float4 va[4], vc[4];
    UNROLL for (int i = 0; i < 4; ++i) {
      va[i] = *(const float4*)(X + (size_t)row0 * DM + i * 256 + lane * 4);
      vc[i] = *(const float4*)(X + (size_t)row1 * DM + i * 256 + lane * 4);
    }
    float s0 = 0.f, s1 = 0.f;
    UNROLL for (int i = 0; i < 4; ++i) {
      s0 += va[i].x + va[i].y + va[i].z + va[i].w;
      s1 += vc[i].x + vc[i].y + vc[i].z + vc[i].w;
    }
    UNROLL for (int o = 32; o >= 1; o >>= 1) { s0 += __shfl_xor(s0, o); s1 += __shfl_xor(s1, o); }
    const float mu0 = s0 * (1.f / 1024.f), mu1 = s1 * (1.f / 1024.f);
    float q0 = 0.f, q1 = 0.f;
    UNROLL for (int i = 0; i < 4; ++i) {
      va[i].x -= mu0; va[i].y -= mu0; va[i].z -= mu0; va[i].w -= mu0;
      vc[i].x -= mu1; vc[i].y -= mu1; vc[i].z -= mu1; vc[i].w -= mu1;
      q0 += va[i].x * va[i].x + va[i].y * va[i].y + va[i].z * va[i].z + va[i].w * va[i].w;
      q1 += vc[i].x * vc[i].x + vc[i].y * vc[i].y + vc[i].z * vc[i].z + vc[i].w * vc[i].w;
    }
    UNROLL for (int o = 32; o >= 1; o >>= 1) { q0 += __shfl_xor(q0, o); q1 += __shfl_xor(q1, o); }
    const float rstd0 = rsqrtf(q0 * (1.f / 1024.f) + 1e-5f), rstd1 = rsqrtf(q1 * (1.f / 1024.f) + 1e-5f);
#define LN_STORE(V, ROW, RSTD)                                                                   \
  UNROLL for (int i = 0; i < 4; ++i) {                                                            \
    float4 y;                                                                                      \
    y.x = V[i].x * (RSTD) * gv[i].x + bv[i].x;                                                    \
    y.y = V[i].y * (RSTD) * gv[i].y + bv[i].y;                                                    \
    y.z = V[i].z * (RSTD) * gv[i].z + bv[i].z;                                                    \
    y.w = V[i].w * (RSTD) * gv[i].w + bv[i].w;                                                    \
    *(float4*)(X + (size_t)(ROW) * DM + i * 256 + lane * 4) = y;                                  \
    u32x2 o;                                                                                       \
    o[0] = pk2(y.x, y.y);                                                                          \
    o[1] = pk2(y.z, y.w);                                                                          \
    if (WXB) *(u32x2*)(Xb + (size_t)(ROW) * DM + i * 256 + lane * 4) = o;                         \
  }
    LN_STORE(va, row0, rstd0)
    if (has1) { LN_STORE(vc, row1, rstd1) }
#undef LN_STORE
  }
}

DI float gelu_tanh(float x) {
  const float u = 0.7978845608028654f * (x + 0.044715f * x * x * x);
  return x * __builtin_amdgcn_rcpf(1.f + __expf(-2.f * u));
}

DI void phase_up_cmp(const Params& p, int layer, char* smem) {
  EPI_VARS
  const u16* WL = (const u16*)(p.ws + OFF_W) + (size_t)layer * W_LAYER;
  float* rstd = (float*)(smem + 73728);
  const float* COSM = (const float*)(p.ws + OFF_COSM);
  const float* SINM = (const float*)(p.ws + OFF_SINM);
  for (int task = vbid(); task < 64; task += nvb()) {
    char* wsz = p.ws + lz();
    f32x16 acc[2][2];
    UNROLL for (int a = 0; a < 2; ++a) UNROLL for (int b = 0; b < 2; ++b) zero16(acc[a][b]);
      const int kv = task >> 5, bg = (task >> 1) & 15, mt = task & 1;
      const u16* A = (const u16*)(wsz + OFF_KV6) + ((size_t)(kv * 16 + bg) * T) * 64 + (size_t)mt * 128 * 1024;
      const u16* W1 = WL + (kv ? W_CV1 : W_CK1);
      const u16* W2 = WL + (kv ? W_CV2 : W_CK2);
      const float* bias = (const float*)(wsz + OFF_BIAS) + (layer * 2 + kv) * 128;
      u16* dst = (u16*)(wsz + (kv ? OFF_VC : OFF_KC)) + (size_t)bg * 256 * 64;
      gemm_main(A, 1024, W1, 2048, 2048, acc, smem);
      UNROLL for (int mi = 0; mi < 2; ++mi) UNROLL for (int ni = 0; ni < 2; ++ni) UNROLL for (int i = 0; i < 16; ++i) {
        const int r = EROW(mi, i), c = wc * 64 + ni * 32 + l31;
        *(u16*)(smem + r * 272 + c * 2) = f2bf(gelu_tanh(acc[mi][ni][i] + bias[c]));
      }
      __syncthreads();
      f32x16 a2[2];
      zero16(a2[0]);
      zero16(a2[1]);
      UNROLL for (int ks = 0; ks < 8; ++ks) {
        bf16x8 af = *(const bf16x8*)(smem + (32 * w + l31) * 272 + ks * 32 + hh * 16);
        bf16x8 b0 = *(const bf16x8*)(W2 + (size_t)(l31) * 128 + ks * 16 + hh * 8);
        bf16x8 b1 = *(const bf16x8*)(W2 + (size_t)(32 + l31) * 128 + ks * 16 + hh * 8);
        a2[0] = MFMA(af, b0, a2[0]);
        a2[1] = MFMA(af, b1, a2[1]);
      }
      UNROLL for (int ni = 0; ni < 2; ++ni) UNROLL for (int i = 0; i < 16; ++i) {
        const int c = mt * 128 + 32 * w + 8 * (i >> 2) + 4 * hh + (i & 3);
        dst[(size_t)c * 64 + ni * 32 + l31] = (c == 255) ? (u16)0 : f2bf(a2[ni][i]);
      }
      __syncthreads();
  }
  const int nw_small = nvb() > 128 ? nvb() - 64 : nvb();
  const int vb_small = nvb() > 128 ? vbid() - 64 : vbid();
  for (int task = vb_small; task >= 0 && task < 1536; task += nw_small) {
    char* wsz = p.ws + lz();
    f32x16 acc[2][2];
    UNROLL for (int a = 0; a < 2; ++a) UNROLL for (int b = 0; b < 2; ++b) zero16(acc[a][b]);
      const int tt = task, tm = tt / 6, tn = tt % 6;
      const u16* A = (const u16*)(wsz + OFF_CQ) + (size_t)tm * 128 * 256;
      {
        const int r = tid >> 1, hf = tid & 1;
        const u16* ar = A + (size_t)r * 256 + hf * 128;
        float ss = 0.f;
        UNROLL for (int c = 0; c < 16; ++c) {
          u32x4 v = *(const u32x4*)(ar + c * 8);
          UNROLL for (int e = 0; e < 4; ++e) {
            const float lo = __uint_as_float(v[e] << 16), hi = __uint_as_float(v[e] & 0xffff0000u);
            ss += lo * lo + hi * hi;
          }
        }
        ss += __shfl_xor(ss, 1);
        if (hf == 0) rstd[r] = rsqrtf(ss * (1.f / 256.f) + 1e-6f);
      }
      gemm_main(A, 256, WL + W_UQ + (size_t)tn * 128 * 256, 256, 256, acc, smem);
      u16* QM = (u16*)(wsz + OFF_QM);
      UNROLL for (int mi = 0; mi < 2; ++mi) UNROLL for (int ni = 0; ni < 2; ++ni) UNROLL for (int i = 0; i < 16; ++i) {
        const int r = EROW(mi, i), row = tm * 128 + r;
        float v = acc[mi][ni][i] * rstd[r];
        const float pr = __shfl_xor(v, 16);
        if (tn >= 4) {
          const int t = row & (T - 1);
          const float cs = COSM[t * 16 + (l31 & 15)], sn = SINM[t * 16 + (l31 & 15)];
          v = (l31 < 16) ? (v * cs - pr * sn) : (v * cs + pr * sn);
        }
        QM[(size_t)row * 768 + tn * 128 + wc * 64 + ni * 32 + l31] = f2bf(v);
      }
      __syncthreads();
  }
  for (int task = vb_small; task >= 0 && task < 2048; task += nw_small) {
    char* wsz = p.ws + lz();
    f32x16 acc[2][2];
    UNROLL for (int a = 0; a < 2; ++a) UNROLL for (int b = 0; b < 2; ++b) zero16(acc[a][b]);
      const int tt = task, tm = tt >> 3, tn = tt & 7;
      const u16* A = (const u16*)(wsz + OFF_CKV) + (size_t)tm * 128 * 128;
      {
        const int r = tid >> 1, hf = tid & 1;
        const u16* ar = A + (size_t)r * 128 + hf * 64;
        float ss = 0.f;
        UNROLL for (int c = 0; c < 8; ++c) {
          u32x4 v = *(const u32x4*)(ar + c * 8);
          UNROLL for (int e = 0; e < 4; ++e) {
            const float lo = __uint_as_float(v[e] << 16), hi = __uint_as_float(v[e] & 0xffff0000u);
            ss += lo * lo + hi * hi;
          }
        }
        ss += __shfl_xor(ss, 1);
        if (hf == 0) rstd[r] = rsqrtf(ss * (1.f / 128.f) + 1e-6f);
      }
      gemm_main(A, 128, WL + W_UKV + (size_t)tn * 128 * 128, 128, 128, acc, smem);
      u16* dst = (u16*)(wsz + (wc == 0 ? OFF_KM : OFF_VM));
      UNROLL for (int mi = 0; mi < 2; ++mi) UNROLL for (int ni = 0; ni < 2; ++ni) UNROLL for (int i = 0; i < 16; ++i) {
        const int r = EROW(mi, i), row = tm * 128 + r;
        const int t = row & (T - 1), b = row >> 12;
        dst[((size_t)(b * 8 + tn) * T + t) * 64 + ni * 32 + l31] = f2bf(acc[mi][ni][i] * rstd[r]);
      }
      __syncthreads();
  }
}

template <int NKS, int KSTR, int MODE, int NREG>
DI void attn_tile(const char* sK, const char* sV, const bf16x8 (&qf)[2][4], const char* qlds, f32x16 (&o)[2][2],
                  float (&mrun)[2], float (&lrun)[2], float sl2, int lane, int kbase, const int (&tq)[2],
                  bool need_mask, const bool (&selb)[2]) {
  const int hh = lane >> 5, r = lane & 31;
  const int blk = (lane >> 4) & 1, q4 = (lane & 15) >> 2, p4 = lane & 3;
  const int sw = (q4 >> 1) & 1;
  UNROLL for (int kt2 = 0; kt2 < 2; ++kt2) {
    f32x16 s[2];
    UNROLL for (int i = 0; i < 16; ++i) { s[0][i] = 0.f; s[1][i] = 0.f; }
    {
      const char* pk = sK + (32 * kt2 + r) * KSTR + hh * 16;
      bf16x8 kf[2], qa[2], qb[2];
      kf[0] = *(const bf16x8*)(pk);
      if (0 >= NREG) {
        qa[0] = *(const bf16x8*)(qlds + (0 - NREG) * 1024);
        qb[0] = *(const bf16x8*)(qlds + (NKS - NREG + 0 - NREG) * 1024);
      }
      UNROLL for (int ks = 0; ks < NKS; ++ks) {
        const int cb = ks & 1, nb = cb ^ 1;
        if (ks + 1 < NKS) {
          kf[nb] = *(const bf16x8*)(pk + (ks + 1) * 32);
          if (ks + 1 >= NREG) {
            qa[nb] = *(const bf16x8*)(qlds + (ks + 1 - NREG) * 1024);
            qb[nb] = *(const bf16x8*)(qlds + (NKS - NREG + ks + 1 - NREG) * 1024);
          }
        }
        __builtin_amdgcn_sched_barrier(0);
        if (ks >= NREG) {
          s[0] = MFMA(kf[cb], qa[cb], s[0]);
          s[1] = MFMA(kf[cb], qb[cb], s[1]);
        } else {
          s[0] = MFMA(kf[cb], qf[0][ks < 4 ? ks : 0], s[0]);
          s[1] = MFMA(kf[cb], qf[1][ks < 4 ? ks : 0], s[1]);
        }
        __builtin_amdgcn_sched_barrier(0);
      }
    }
    UNROLL for (int qt = 0; qt < 2; ++qt) {
      float mx = NEGR;
      if (need_mask) {
        const int lim = tq[qt] - kbase - 4 * hh;
        UNROLL for (int i = 0; i < 16; ++i) {
          const int kc = 32 * kt2 + 8 * (i >> 2) + (i & 3);
          bool ok = kc <= lim;
          if (MODE == 2) ok = ok && (kc > lim - 512);
          if (MODE == 1) ok = ok && selb[qt];
          const float x = ok ? s[qt][i] : NEGR;
          s[qt][i] = x;
          mx = fmaxf(mx, x);
        }
      } else {
        UNROLL for (int i = 0; i < 16; ++i) mx = fmaxf(mx, s[qt][i]);
      }
      mx = xh_max(mx);
      const float mnew = fmaxf(mrun[qt], mx * sl2);
      if (__builtin_amdgcn_ballot_w64(mnew != mrun[qt]) != 0ull) {
        const float alpha = ex2(mrun[qt] - mnew);
        mrun[qt] = mnew;
        lrun[qt] *= alpha;
        UNROLL for (int dt = 0; dt < 2; ++dt) UNROLL for (int i = 0; i < 16; ++i) o[qt][dt][i] *= alpha;
      }
      float ls = 0.f;
      const float nbias = (MODE == 1 && !selb[qt]) ? (-mnew - 20000.f) : -mnew;
      UNROLL for (int i = 0; i < 16; ++i) {
        const float pv = ex2(__builtin_fmaf(s[qt][i], sl2, nbias));
        s[qt][i] = pv;
        ls += pv;
      }
      lrun[qt] += ls;
    }
    {
      bf16x8 pf0[2], pf1[2];
      pf0[0] = pack8(s[0], 0); pf1[0] = pack8(s[1], 0);
      pf0[1] = pack8(s[0], 1); pf1[1] = pack8(s[1], 1);
      s16x4 lo[2], hi[2];
      const char* pvb = sV + (32 * kt2 + 4 * hh + q4) * 128 + (16 * blk + 4 * p4) * 2;
      lo[0] = tr_read(pvb + ((0 ^ sw) * 64));
      hi[0] = tr_read(pvb + ((0 ^ sw) * 64) + 8 * 128);
      UNROLL for (int c = 0; c < 4; ++c) {
        const int st = c >> 1, dt = c & 1, cb = c & 1, nb = cb ^ 1;
        if (c + 1 < 4) {
          const int st1 = (c + 1) >> 1, dt1 = (c + 1) & 1;
          lo[nb] = tr_read(pvb + st1 * 16 * 128 + ((dt1 ^ sw) * 64));
          hi[nb] = tr_read(pvb + st1 * 16 * 128 + ((dt1 ^ sw) * 64) + 8 * 128);
        }
        __builtin_amdgcn_sched_barrier(0);
        const bf16x8 vf = __builtin_shufflevector(lo[cb], hi[cb], 0, 1, 2, 3, 4, 5, 6, 7);
        o[0][dt] = MFMA(vf, pf0[st], o[0][dt]);
        o[1][dt] = MFMA(vf, pf1[st], o[1][dt]);
        __builtin_amdgcn_sched_barrier(0);
      }
    }
  }
}

DI void mla_task(const Params& p, int task, char* smem) {
  const int tid = ltid(), lane = tid & 63, w = tid >> 6, l31 = lane & 31, hh = lane >> 5;
  const int qb = 15 - (task >> 6), bh = task & 63, b = bh >> 3, h = bh & 7;
  const int q0 = qb * 256;
  u16* QM = (u16*)(p.ws + OFF_QM);
  const u16* KM = (const u16*)(p.ws + OFF_KM) + (size_t)bh * T * 64;
  const u16* VM = (const u16*)(p.ws + OFF_VM) + (size_t)bh * T * 64;
  const u16* KPE = (const u16*)(p.ws + OFF_KPE) + (size_t)b * T * 32;
  bf16x8 qf[2][4];
  int tq[2];
  const char* qlds = smem + 43008 + w * 4096 + lane * 16;
  UNROLL for (int qt = 0; qt < 2; ++qt) {
    tq[qt] = q0 + 64 * w + 32 * qt + l31;
    const u16* base = QM + (size_t)(b * T + tq[qt]) * 768;
    UNROLL for (int ks = 0; ks < 4; ++ks) qf[qt][ks] = *(const bf16x8*)(base + h * 64 + 16 * ks + 8 * hh);
    UNROLL for (int ks = 0; ks < 2; ++ks)
      *(bf16x8*)(smem + 43008 + w * 4096 + lane * 16 + (qt * 2 + ks) * 1024) = *(const bf16x8*)(base + 512 + h * 32 + 16 * ks + 8 * hh);
  }
  f32x16 o[2][2];
  UNROLL for (int a = 0; a < 2; ++a) UNROLL for (int c = 0; c < 2; ++c) zero16(o[a][c]);
  float mrun[2] = {NEGF, NEGF}, lrun[2] = {0.f, 0.f};
  const bool selb[2] = {true, true};
  const float sl2 = 0.10206207261596575f * LOG2E;
  const int nkt = (q0 >> 6) + 4, my_last = (q0 >> 6) + w;
  u32x4 rk[3], rv[2];
  const unsigned offa = (unsigned)tid * 16u;
  const unsigned offp = (unsigned)tid * 16u;
  auto gload = [&](int kt) {
    const char* kb = (const char*)(KM + (size_t)kt * 4096);
    const char* vb = (const char*)(VM + (size_t)kt * 4096);
    const char* pb = (const char*)(KPE + (size_t)kt * 2048);
    rk[0] = *(const u32x4*)(kb + offa);
    rk[1] = *(const u32x4*)(kb + offa + 4096u);
    rk[2] = *(const u32x4*)(pb + offp);
    rv[0] = *(const u32x4*)(vb + offa);
    rv[1] = *(const u32x4*)(vb + offa + 4096u);
  };
  auto sstore = [&](int s) {
    UNROLL for (int i = 0; i < 2; ++i) {
      const int c = tid + 256 * i, key = c >> 3, ch = c & 7;
      *(u32x4*)(smem + s * 13312 + key * 208 + ch * 16) = rk[i];
      *(u32x4*)(smem + 26624 + s * 8192 + key * 128 + ((ch ^ (4 * ((key >> 1) & 1))) * 16)) = rv[i];
    }
    *(u32x4*)(smem + s * 13312 + (tid >> 2) * 208 + 128 + (tid & 3) * 16) = rk[2];
  };
  gload(0);
  sstore(0);
  __syncthreads();
  _Pragma("unroll 1") for (int kt = 0; kt < nkt; ++kt) {
    const bool more = kt + 1 < nkt;
    if (more) gload(kt + 1);
    if (kt <= my_last) {
      const bool need_mask = (64 * kt + 63 > q0 + 64 * w);
      attn_tile<6, 208, 0, 4>(smem + (kt & 1) * 13312, smem + 26624 + (kt & 1) * 8192, qf, qlds, o, mrun, lrun, sl2, lane,
                           64 * kt, tq, need_mask, selb);
    }
    if (more) sstore((kt + 1) & 1);
    __syncthreads();
  }
  UNROLL for (int qt = 0; qt < 2; ++qt) {
    const float lt = xh_sum(lrun[qt]);
    const float inv = __builtin_amdgcn_rcpf(lt);
    u16* dst = (u16*)(p.ws + OFF_OM) + (size_t)(b * T + tq[qt]) * 512 + h * 64;
    UNROLL for (int dt = 0; dt < 2; ++dt) UNROLL for (int g4 = 0; g4 < 4; ++g4) {
      u32x2 v;
      v[0] = pk2(o[qt][dt][4 * g4 + 0] * inv, o[qt][dt][4 * g4 + 1] * inv);
      v[1] = pk2(o[qt][dt][4 * g4 + 2] * inv, o[qt][dt][4 * g4 + 3] * inv);
      *(u32x2*)(dst + 32 * dt + 8 * g4 + 4 * hh) = v;
    }
  }
}

template <int MODE>
DI void nsa_flash(const u16* __restrict__ Kg, const u16* __restrict__ Vg, int kt_lo, int kt_hi, int cur,
                  f32x16 (&o)[2][2], float (&mrun)[2], float (&lrun)[2], float sl2,
                  const int (&tq)[2], char* smem) {
  const bf16x8 qdummy[2][4] = {};
  const char* qlds = smem + 36864 + (ltid() >> 6) * 8192 + (ltid() & 63) * 16;
  const int tid = ltid(), lane = tid & 63;
  const unsigned* selw = (const unsigned*)(smem + 69632 + 8192);
  u32x4 rk[2], rv[2];
  const unsigned offa = (unsigned)tid * 16u;
  auto gload = [&](int kt) {
    const char* kb = (const char*)(Kg + (size_t)kt * 4096);
    const char* vb = (const char*)(Vg + (size_t)kt * 4096);
    rk[0] = *(const u32x4*)(kb + offa);
    rk[1] = *(const u32x4*)(kb + offa + 4096u);
    rv[0] = *(const u32x4*)(vb + offa);
    rv[1] = *(const u32x4*)(vb + offa + 4096u);
  };
  auto sstore = [&](int s) {
    UNROLL for (int i = 0; i < 2; ++i) {
      const int c = tid + 256 * i, key = c >> 3, ch = c & 7;
      *(u32x4*)(smem + s * 9216 + key * 144 + ch * 16) = rk[i];
      *(u32x4*)(smem + 18432 + s * 8192 + key * 128 + ((ch ^ (4 * ((key >> 1) & 1))) * 16)) = rv[i];
    }
  };
  gload(kt_lo);
  sstore(0);
  __syncthreads();
  _Pragma("unroll 1") for (int kt = kt_lo; kt <= kt_hi; ++kt) {
    const int s = (kt - kt_lo) & 1;
    const bool more = kt < kt_hi;
    if (more) gload(kt + 1);
    bool selb[2] = {true, true};
    if (MODE == 1) {
      selb[0] = (selw[(tq[0] & 63) * 2 + (kt >> 5)] >> (kt & 31)) & 1u;
      selb[1] = (selw[(tq[1] & 63) * 2 + (kt >> 5)] >> (kt & 31)) & 1u;
    }
    const bool need_mask = (kt == cur) || (MODE == 2 && kt == cur - 8);
    attn_tile<4, 144, MODE, 0>(smem + s * 9216, smem + 18432 + s * 8192, qdummy, qlds, o, mrun, lrun, sl2, lane,
                                  64 * kt, tq, need_mask, selb);
    if (more) sstore(s ^ 1);
    __syncthreads();
  }
}

DI void nsa_task(const Params& p, int task, char* smem) {
  const int tid = ltid(), lane = tid & 63, w = tid >> 6, l31 = lane & 31, hh = lane >> 5;
  const int cur = 63 - (task >> 4), bg = task & 15, b = bg >> 1, g = bg & 1;
  u16* QN = (u16*)(p.ws + OFF_QN);
  const u16* KV6 = (const u16*)(p.ws + OFF_KV6);
  const float* GATES = (const float*)(p.ws + OFF_GATES);
  const u16* KC = (const u16*)(p.ws + OFF_KC) + (size_t)bg * 256 * 64;
  const u16* VC = (const u16*)(p.ws + OFF_VC) + (size_t)bg * 256 * 64;
  const int head = 4 * g + (l31 & 3);
  bf16x8 qf[2][4];
  int tq[2];
  UNROLL for (int qt = 0; qt < 2; ++qt) {
    tq[qt] = 64 * cur + 16 * w + 8 * qt + (l31 >> 2);
    const u16* base = QN + (size_t)(b * T + tq[qt]) * 512 + head * 64;
    UNROLL for (int ks = 0; ks < 4; ++ks) qf[qt][ks] = *(const bf16x8*)(base + 16 * ks + 8 * hh);
  }
  const float sl2 = 0.125f * LOG2E;
  unsigned long long* selm = (unsigned long long*)(smem + 69632 + 8192);
  char* R1 = smem;
  char* R2 = smem + 36864;
  float* impw = (float*)(smem + 69632) + w * 512;
  {
    UNROLL for (int i = 0; i < 8; ++i) {
      const int c = tid + 256 * i, key = c >> 3, ch = c & 7;
      u32x4 kk = *(const u32x4*)(KC + (size_t)c * 8);
      u32x4 vv = *(const u32x4*)(VC + (size_t)c * 8);
      *(u32x4*)(R1 + (key >> 6) * 9216 + (key & 63) * 144 + ch * 16) = kk;
      *(u32x4*)(R2 + (key >> 6) * 8192 + (key & 63) * 128 + ((ch ^ (4 * ((key >> 1) & 1))) * 16)) = vv;
    }
    __syncthreads();
    const int blk = (lane >> 4) & 1, q4 = (lane & 15) >> 2, p4 = lane & 3, sw = (q4 >> 1) & 1;
    UNROLL for (int qt = 0; qt < 2; ++qt) {
      const int cmh = ((tq[qt] - 31) >> 4) - 4 * hh;
      const int cmax_u = (64 * cur + 16 * __builtin_amdgcn_readfirstlane(w) + 8 * qt + 7 - 31) >> 4;
      float mx = NEGF, lsum = 0.f;
      UNROLL for (int a = 0; a < 8; ++a) if (32 * a <= cmax_u) {
        f32x16 sa;
        zero16(sa);
        const char* pk = R1 + (a >> 1) * 9216 + (32 * (a & 1) + l31) * 144 + hh * 16;
        {
          bf16x8 kf4[4];
          UNROLL for (int ks = 0; ks < 4; ++ks) kf4[ks] = *(const bf16x8*)(pk + ks * 32);
          __builtin_amdgcn_sched_barrier(0);
          UNROLL for (int ks = 0; ks < 4; ++ks) sa = MFMA(kf4[ks], qf[qt][ks], sa);
        }
        float tm = NEGF;
        UNROLL for (int i = 0; i < 16; ++i) {
          const int c = 32 * a + 8 * (i >> 2) + (i & 3);
          const float x = (c <= cmh) ? sa[i] * sl2 : NEGF;
          sa[i] = x;
          tm = fmaxf(tm, x);
        }
        const float mnew = fmaxf(mx, tm);
        float ts = 0.f;
        UNROLL for (int i = 0; i < 16; ++i) ts += ex2(sa[i] - mnew);
        lsum = lsum * ex2(mx - mnew) + ts;
        mx = mnew;
        __builtin_amdgcn_sched_barrier(0);
      }
      {
        const float mo = xh_get(mx, hh), lo = xh_get(lsum, hh);
        const float mt = fmaxf(mx, mo);
        lsum = lsum * ex2(mx - mt) + lo * ex2(mo - mt);
        mx = mt;
      }
      const float inv = (mx > -1e29f) ? 1.f / lsum : 0.f;
      float lastprev = 0.f;
      f32x16 oc[2];
      zero16(oc[0]);
      zero16(oc[1]);
      UNROLL for (int a = 0; a < 8; ++a) if (32 * a <= cmax_u) {
        f32x16 sa;
        zero16(sa);
        const char* pk = R1 + (a >> 1) * 9216 + (32 * (a & 1) + l31) * 144 + hh * 16;
        {
          bf16x8 kf4[4];
          UNROLL for (int ks = 0; ks < 4; ++ks) kf4[ks] = *(const bf16x8*)(pk + ks * 32);
          __builtin_amdgcn_sched_barrier(0);
          UNROLL for (int ks = 0; ks < 4; ++ks) sa = MFMA(kf4[ks], qf[qt][ks], sa);
        }
        UNROLL for (int i = 0; i < 16; ++i) {
          const int c = 32 * a + 8 * (i >> 2) + (i & 3);
          sa[i] = (c <= cmh) ? ex2(sa[i] * sl2 - mx) * inv : 0.f;
        }
        UNROLL for (int q = 0; q < 4; ++q) {
          const int gi = 4 * a + q;
          const float g4 = sa[4 * q] + sa[4 * q + 1] + sa[4 * q + 2] + sa[4 * q + 3];
          const float lastcur = sa[4 * q + 3];
          const float tosend = hh ? lastprev : lastcur;
          const float recv = xh_get(tosend, hh);
          const float im = quad_sum(g4 + recv);
          if ((l31 & 3) == (gi & 3)) impw[(l31 >> 2) * 64 + 2 * gi + hh] = im;
          lastprev = lastcur;
        }
        {
          s16x4 vlo[4], vhi[4];
          UNROLL for (int c = 0; c < 4; ++c) {
            const int st = c >> 1, dt = c & 1;
            const char* pv = R2 + (a >> 1) * 8192 + (32 * (a & 1) + 16 * st + 4 * hh + q4) * 128 + ((dt ^ sw) * 64) + (16 * blk + 4 * p4) * 2;
            vlo[c] = tr_read(pv);
            vhi[c] = tr_read(pv + 8 * 128);
          }
          const bf16x8 pfa = pack8(sa, 0), pfb = pack8(sa, 1);
          __builtin_amdgcn_sched_barrier(0);
          UNROLL for (int c = 0; c < 4; ++c) {
            const bf16x8 vf = __builtin_shufflevector(vlo[c], vhi[c], 0, 1, 2, 3, 4, 5, 6, 7);
            oc[c & 1] = MFMA(vf, (c >> 1) ? pfb : pfa, oc[c & 1]);
          }
        }
        __builtin_amdgcn_sched_barrier(0);
      }
      __syncthreads();
      if (cur >= 16) {
        unsigned* keyw = (unsigned*)impw;
        UNROLL for (int t8 = 0; t8 < 8; ++t8) {
          const float v = impw[t8 * 64 + lane];
          const int j = lane;
          unsigned key = (__float_as_uint(v) & ~63u) | (unsigned)(63 - j);
          if (j == 0 || j == cur || j == cur - 1) key = 0x7f800000u | (unsigned)(63 - j);
          else if (j > cur) key = (unsigned)(63 - j);
          keyw[t8 * 64 + lane] = key;
        }
        __syncthreads();
        _Pragma("unroll 1") for (int t8 = 0; t8 < 8; ++t8) {
          const unsigned key = keyw[t8 * 64 + lane];
          int rank = 0;
          UNROLL for (int c4 = 0; c4 < 16; ++c4) {
            const u32x4 kk = *(const u32x4*)(keyw + t8 * 64 + c4 * 4);
            rank += (kk[0] > key) ? 1 : 0;
            rank += (kk[1] > key) ? 1 : 0;
            rank += (kk[2] > key) ? 1 : 0;
            rank += (kk[3] > key) ? 1 : 0;
          }
          const unsigned long long mk = __ballot(rank < 16);
          if (lane == 0) selm[16 * w + 8 * qt + t8] = mk;
        }
      } else {
        if (lane < 8) selm[16 * w + 8 * qt + lane] = ~0ull;
      }
      __syncthreads();
      int zq = 0;
      asm volatile("" : "+v"(zq));
      const int rowq = b * T + tq[qt] + zq;
      const float g0 = GATES[(size_t)rowq * 24 + head * 3 + 0];
      u16* dst = (u16*)(p.ws + OFF_ON) + (size_t)rowq * 512 + head * 64;
      UNROLL for (int dt = 0; dt < 2; ++dt) UNROLL for (int g4 = 0; g4 < 4; ++g4) {
        u32x2 v;
        v[0] = pk2(oc[dt][4 * g4 + 0] * g0, oc[dt][4 * g4 + 1] * g0);
        v[1] = pk2(oc[dt][4 * g4 + 2] * g0, oc[dt][4 * g4 + 3] * g0);
        *(u32x2*)(dst + 32 * dt + 8 * g4 + 4 * hh) = v;
      }
    }
    __syncthreads();
  }
  {
    char* qdst = smem + 36864 + w * 8192 + lane * 16;
    UNROLL for (int qt = 0; qt < 2; ++qt) UNROLL for (int ks = 0; ks < 4; ++ks) *(bf16x8*)(qdst + (qt * 4 + ks) * 1024) = qf[qt][ks];
  }
  __syncthreads();
  UNROLL for (int br = 1; br <= 2; ++br) {
    f32x16 o[2][2];
    UNROLL for (int a = 0; a < 2; ++a) UNROLL for (int c = 0; c < 2; ++c) zero16(o[a][c]);
    float mrun[2] = {NEGF, NEGF}, lrun[2] = {0.f, 0.f};
    const u16* Kg = KV6 + ((size_t)((2 * br) * 16 + bg) * T) * 64;
    const u16* Vg = KV6 + ((size_t)((2 * br + 1) * 16 + bg) * T) * 64;
    if (br == 1) nsa_flash<1>(Kg, Vg, 0, cur, cur, o, mrun, lrun, sl2, tq, smem);
    else nsa_flash<2>(Kg, Vg, cur > 8 ? cur - 8 : 0, cur, cur, o, mrun, lrun, sl2, tq, smem);
    UNROLL for (int qt = 0; qt < 2; ++qt) {
      const float lt = xh_sum(lrun[qt]);
      int zq = 0;
      asm volatile("" : "+v"(zq));
      const int rowq = b * T + tq[qt] + zq;
      const float gt = GATES[(size_t)rowq * 24 + head * 3 + br];
      const float inv = gt * __builtin_amdgcn_rcpf(lt);
      u16* dst = (u16*)(p.ws + OFF_ON) + (size_t)rowq * 512 + head * 64;
      UNROLL for (int dt = 0; dt < 2; ++dt) UNROLL for (int g4 = 0; g4 < 4; ++g4) {
        u32x2* pd = (u32x2*)(dst + 32 * dt + 8 * g4 + 4 * hh);
        const u32x2 old = *pd;
        u32x2 v;
        v[0] = pk2(o[qt][dt][4 * g4 + 0] * inv + __uint_as_float(old[0] << 16),
                   o[qt][dt][4 * g4 + 1] * inv + __uint_as_float(old[0] & 0xffff0000u));
        v[1] = pk2(o[qt][dt][4 * g4 + 2] * inv + __uint_as_float(old[1] << 16),
                   o[qt][dt][4 * g4 + 3] * inv + __uint_as_float(old[1] & 0xffff0000u));
        *pd = v;
      }
    }
  }
}

DI void phase_attn(const Params& p, int layer, char* smem, char* smem_blk) {
  int* cnt = (int*)(p.ws + OFF_CNT) + layer;
  int* s_task = (int*)(smem_blk + 2 * VSMEM);
  const int half = vhalf();
  for (;;) {
    if (__builtin_amdgcn_workitem_id_x() == 0) *s_task = atomicAdd(cnt, 2);
    __syncthreads();
    const int task = *s_task + half;
    __syncthreads();
    if (task >= 2048) break;
    if (task < 1024) mla_task(p, task, smem);
    else nsa_task(p, task - 1024, smem);
  }
}

DI void phase_proj(const Params& p, int layer, char* smem) {
  EPI_VARS
  const u16* WL = (const u16*)(p.ws + OFF_W) + (size_t)layer * W_LAYER;
  const u16* OM = (const u16*)(p.ws + OFF_OM);
  const u16* ON = (const u16*)(p.ws + OFF_ON);
  const u16* GM = (const u16*)(p.ws + OFF_GM);
  const u16* GN = (const u16*)(p.ws + OFF_GN);
  u16* Yb = (u16*)(p.ws + OFF_XB);
  const int ntn = 8, ntiles = 256 * ntn;
  for (int tile = vbid(); tile < ntiles; tile += nvb()) {
    const int tm = tile / ntn, tn = tile % ntn;
    f32x16 acc[2][2];
    UNROLL for (int a = 0; a < 2; ++a) UNROLL for (int b = 0; b < 2; ++b) zero16(acc[a][b]);
    gemm_main(OM + (size_t)tm * 128 * 512, 512, WL + W_PM + (size_t)tn * 128 * 512, 512, 512, acc, smem);
    {
      int z1 = 0;
      asm volatile("" : "+v"(z1)::"memory");
      UNROLL for (int mi = 0; mi < 2; ++mi) UNROLL for (int ni = 0; ni < 2; ++ni) UNROLL for (int i = 0; i < 16; ++i) {
        if ((i & 3) == 0) asm volatile("" ::: "memory");
        const int row = tm * 128 + EROW(mi, i) + z1;
        const size_t idx = (size_t)row * 1024 + tn * 128 + wc * 64 + ni * 32 + l31;
        acc[mi][ni][i] *= bf2f(GM[idx]) * __builtin_amdgcn_rcpf(bf2f(GN[idx]));
      }
    }
    gemm_main(ON + (size_t)tm * 128 * 512, 512, WL + W_PN + (size_t)tn * 128 * 512, 512, 512, acc, smem);
    int z2 = 0;
    asm volatile("" : "+v"(z2)::"memory");
    UNROLL for (int mi = 0; mi < 2; ++mi) UNROLL for (int ni = 0; ni < 2; ++ni) UNROLL for (int i = 0; i < 16; ++i) {
      const int row = tm * 128 + EROW(mi, i) + z2;
      const size_t idx = (size_t)row * 1024 + tn * 128 + wc * 64 + ni * 32 + l31;
      if ((i & 3) == 0) asm volatile("" ::: "memory");
      const float y = bf2f(GN[idx]) * acc[mi][ni][i];
      Yb[idx] = f2bf(y);
    }
  }
}

#define XB_TMO      128
#define XB_XCNT(j)  (256  + 64 * (j))
#define XB_XSUB(j)  (1280 + 64 * (j))
#define XB_XGEN(j)  (2304 + 64 * (j))
#define XB_TOP      3328
#define XB_TOPGEN   3392
#define XCD_BAR_WORDS 3456
#define XB_SPIN_CAP (1u << 18)
#define LAS __attribute__((address_space(3)))

__device__ __forceinline__ unsigned xb_ld(unsigned* p)              { return __hip_atomic_load(p, __ATOMIC_RELAXED, __HIP_MEMORY_SCOPE_AGENT); }
__device__ __forceinline__ unsigned xb_add(unsigned* p, unsigned v) { return __hip_atomic_fetch_add(p, v, __ATOMIC_RELAXED, __HIP_MEMORY_SCOPE_AGENT); }
__device__ __forceinline__ unsigned xb_xcc_id() { return (unsigned)__builtin_amdgcn_s_getreg((3 << 11) | 20) & 0xFu; }
#define XB_SPIN(cond, bar) do { unsigned _sp = 0; while (cond) { __builtin_amdgcn_s_sleep(1); \
    if ((++_sp & 255u) == 0u) { if (xb_ld(&(bar)[XB_TMO])) break; if (_sp > XB_SPIN_CAP) { atomicAdd(&(bar)[XB_TMO], 1u); break; } } } } while (0)

struct XcdBarrier {
    unsigned* bar; unsigned x;
    volatile LAS unsigned* st;
};

__device__ __forceinline__ XcdBarrier xcd_barrier_post(unsigned* bar, volatile LAS unsigned* st) {
    XcdBarrier b; b.bar = bar; b.x = xb_xcc_id(); b.st = st;
    if (threadIdx.x == 0) (void)xb_add(&bar[XB_XCNT(b.x)], 1u);
    return b;
}
__device__ __forceinline__ void xcd_barrier_complete(unsigned* bar, unsigned x, unsigned& nloc, unsigned& nx) {
    const unsigned G = gridDim.x * gridDim.y * gridDim.z;
    unsigned sum, cnt, mine, sp = 0u;
    for (;;) {
        sum = 0u; cnt = 0u; mine = 0u;
#pragma unroll
        for (unsigned j = 0; j < 16; ++j) { const unsigned c = xb_ld(&bar[XB_XCNT(j)]); sum += c; cnt += (c > 0u) ? 1u : 0u; mine = (j == x) ? c : mine; }
        if (sum == G) break;
        __builtin_amdgcn_s_sleep(1);
        if ((++sp & 255u) == 0u) { if (xb_ld(&bar[XB_TMO])) break; if (sp > XB_SPIN_CAP) { atomicAdd(&bar[XB_TMO], 1u); break; } }
    }
    nloc = mine > 0u ? mine : 1u; nx = cnt > 0u ? cnt : 1u;
}

__device__ __forceinline__ void xcd_barrier(const XcdBarrier& b) {
    asm volatile("s_waitcnt vmcnt(0)" ::: "memory");
    __syncthreads();
    if (threadIdx.x == 0) {
        unsigned* bar = b.bar;
        __builtin_amdgcn_s_waitcnt(0);
        unsigned nloc = b.st[0], nx = b.st[1];
        if (nloc == 0u) { xcd_barrier_complete(bar, b.x, nloc, nx); b.st[0] = nloc; b.st[1] = nx; }
        const unsigned old = xb_add(&bar[XB_XSUB(b.x)], 1u);
        const unsigned gen = old / nloc;
        if (old + 1u == (gen + 1u) * nloc) {
            __builtin_amdgcn_fence(__ATOMIC_RELEASE, "agent");
            asm volatile("s_waitcnt vmcnt(0)" ::: "memory");
            const unsigned og = xb_add(&bar[XB_TOP], 1u);
            const unsigned tg = og / nx;
            if (og + 1u == (tg + 1u) * nx) xb_add(&bar[XB_TOPGEN], 1u);
            else XB_SPIN(xb_ld(&bar[XB_TOPGEN]) == tg, bar);
            __builtin_amdgcn_fence(__ATOMIC_ACQUIRE, "agent");
            xb_add(&bar[XB_XGEN(b.x)], 1u);
            asm volatile("s_waitcnt vmcnt(0)" ::: "memory");
        } else {
            XB_SPIN(xb_ld(&bar[XB_XGEN(b.x)]) == gen, bar);
            __builtin_amdgcn_fence(__ATOMIC_ACQUIRE, "agent");
            asm volatile("s_waitcnt vmcnt(0)" ::: "memory");
        }
    }
    __syncthreads();
}

#define GSYNC xcd_barrier(xb)
#define LAYER(layer)                                                                                              \
  {                                                                                                               \
    const u16* WL = (const u16*)(p.ws + OFF_W) + (size_t)(layer) * W_LAYER;                                       \
    const u16* XB = (const u16*)(p.ws + OFF_XB);                                                                  \
    const u16* HB = (const u16*)(p.ws + OFF_H);                                                                   \
    big_gemm(XB, WL + W_UP1, 5632, 1024, EpiSwiglu{(u16*)(p.ws + OFF_H)}, smem_blk); GSYNC;                       \
    big_gemm<true, true>(HB, WL + W_DN1, 1024, FF, EpiResid{(layer) == 0 ? p.in[0] : p.out, p.out, 0.5f}, smem_blk); GSYNC;                                   \
    bias_reduce(p); phase_ln(p, p.in[1] + (layer) * DM, p.in[2] + (layer) * DM); GSYNC;                                          \
    big_gemm(XB, WL + W_IN, 3840, 1024, EpiWin{p.ws}, smem_blk); GSYNC;                                           \
    phase_up_cmp(p, layer, smem); GSYNC;                                                                          \
    phase_attn(p, layer, smem, smem_blk); GSYNC;                                                                  \
    big_gemm((const u16*)(p.ws + OFF_OM), WL + W_PM, 1024, 512, EpiGate1{(u16*)(p.ws + OFF_GM)}, smem_blk); GSYNC; big_gemm((const u16*)(p.ws + OFF_ON), WL + W_PN, 1024, 512, EpiGate2{(const u16*)(p.ws + OFF_GM), (const u16*)(p.ws + OFF_GN), (u16*)(p.ws + OFF_XB)}, smem_blk); GSYNC;                                                                           \
    big_gemm(XB, WL + W_OUT, 1024, 1024, EpiResid{p.out, p.out, 1.0f}, smem_blk); GSYNC;        \
    phase_ln(p, p.in[22] + (layer) * DM, p.in[23] + (layer) * DM); GSYNC;                                         \
    big_gemm(XB, WL + W_UP2, 5632, 1024, EpiSwiglu{(u16*)(p.ws + OFF_H)}, smem_blk); GSYNC;                       \
    big_gemm<true, true>(HB, WL + W_DN2, 1024, FF, EpiResid{p.out, p.out, 0.5f}, smem_blk); GSYNC;                                   \
    if ((layer) == 1) phase_ln<false>(p, p.in[27] + (layer) * DM, p.in[28] + (layer) * DM);                       \
    else phase_ln(p, p.in[27] + (layer) * DM, p.in[28] + (layer) * DM);                                           \
  }

__global__ void __launch_bounds__(512, 2) mega(Params p) {
  __shared__ __attribute__((aligned(16))) char smem_blk[SMEM_BYTES];
  char* smem = smem_blk + vhalf() * VSMEM;
  cg::grid_group grid = cg::this_grid();
  volatile LAS unsigned* st = (volatile LAS unsigned*)(smem_blk + 2 * VSMEM + 16);
  if (threadIdx.x == 0) { st[0] = 0u; st[1] = 0u; }
  __syncthreads();
  const XcdBarrier xb = xcd_barrier_post((unsigned*)(p.ws + OFF_BAR), st);
  phase_init(p, smem);
  if (p.ws == nullptr) grid.sync();
  GSYNC;
  LAYER(0)
  GSYNC;
  LAYER(1)
}

extern "C" void kernel_launch(void* const* d_in, const int* in_sizes, int n_in, void* d_out, int out_size, void* d_ws,
                              size_t ws_size, hipStream_t stream) {
  Params p{};
  for (int i = 0; i < 29; ++i) p.in[i] = (const float*)d_in[i];
  p.out = (float*)d_out;
  p.ws = (char*)d_ws;
  if (ws_size < WS_NEED) fprintf(stderr, "workspace too small: %zu < %zu\n", ws_size, (size_t)WS_NEED);
  static int grid_blocks = 0;
  if (!grid_blocks) {
    int dev = 0, cus = 0, per_cu = 0;
    hipGetDevice(&dev);
    hipDeviceGetAttribute(&cus, hipDeviceAttributeMultiprocessorCount, dev);
    hipOccupancyMaxActiveBlocksPerMultiprocessor(&per_cu, mega, 512, 0);
    if (per_cu < 1) per_cu = 1;
    if (per_cu > 1) per_cu = 1;
    grid_blocks = cus * per_cu;
  }
  (void)hipMemsetAsync((char*)d_ws + OFF_BAR, 0, XCD_BAR_WORDS * 4, stream);
  void* args[] = {&p};
  hipError_t e = hipLaunchCooperativeKernel((void*)mega, dim3(grid_blocks), dim3(512), args, 0, stream);
  if (e != hipSuccess) fprintf(stderr, "cooperative launch failed: %s (grid %d)\n", hipGetErrorString(e), grid_blocks);
}
```

```cpp
#include <hip/hip_runtime.h>
#include <hip/hip_cooperative_groups.h>
#include <stdint.h>
#include <stdio.h>
namespace cg = cooperative_groups;

#ifndef MULTI
#define MULTI 0
#endif

typedef unsigned short u16;
typedef __attribute__((ext_vector_type(8))) short bf16x8;
typedef __attribute__((ext_vector_type(4))) short s16x4;
typedef __attribute__((ext_vector_type(16))) float f32x16;
typedef __attribute__((ext_vector_type(4))) unsigned u32x4;
typedef __attribute__((ext_vector_type(2))) unsigned u32x2;
typedef __attribute__((ext_vector_type(2))) __bf16 bf2_t;
#define DI __device__ __forceinline__
#define MFMA(a, b, c) __builtin_amdgcn_mfma_f32_32x32x16_bf16((a), (b), (c), 0, 0, 0)
#define UNROLL _Pragma("unroll")

constexpr int NB = 8, T = 4096, DM = 1024, M = NB * T, FF = 2816;
constexpr float ALPHA = 1.4142135623730951f;
constexpr float NEGF = -1e30f;
constexpr float NEGR = -30000.f;
constexpr float LOG2E = 1.4426950408889634f;

constexpr size_t W_UP1 = 0;
constexpr size_t W_DN1 = W_UP1 + (size_t)5632 * 1024;
constexpr size_t W_IN = W_DN1 + (size_t)1024 * 2816;
constexpr size_t W_UQ = W_IN + (size_t)3840 * 1024;
constexpr size_t W_UKV = W_UQ + (size_t)768 * 256;
constexpr size_t W_CK1 = W_UKV + (size_t)1024 * 128;
constexpr size_t W_CK2 = W_CK1 + (size_t)128 * 2048;
constexpr size_t W_CV1 = W_CK2 + (size_t)64 * 128;
constexpr size_t W_CV2 = W_CV1 + (size_t)128 * 2048;
constexpr size_t W_PM = W_CV2 + (size_t)64 * 128;
constexpr size_t W_PN = W_PM + (size_t)1024 * 512;
constexpr size_t W_OUT = W_PN + (size_t)1024 * 512;
constexpr size_t W_UP2 = W_OUT + (size_t)1024 * 1024;
constexpr size_t W_DN2 = W_UP2 + (size_t)5632 * 1024;
constexpr size_t W_LAYER = W_DN2 + (size_t)1024 * 2816;

constexpr size_t al256(size_t x) { return (x + 255) & ~(size_t)255; }
constexpr size_t OFF_W = 0;
constexpr size_t OFF_BIAS = al256(OFF_W + 2 * W_LAYER * 2);
constexpr size_t OFF_COSN = al256(OFF_BIAS + 2 * 2 * 128 * 4);
constexpr size_t OFF_SINN = OFF_COSN + (size_t)T * 8 * 4;
constexpr size_t OFF_COSM = OFF_SINN + (size_t)T * 8 * 4;
constexpr size_t OFF_SINM = OFF_COSM + (size_t)T * 16 * 4;
constexpr size_t OFF_CNT = OFF_SINM + (size_t)T * 16 * 4;
constexpr size_t OFF_BAR = al256(OFF_CNT + 256);
constexpr size_t OFF_PART = al256(OFF_BAR + 3456 * 4);
constexpr size_t OFF_XB = al256(OFF_PART + (size_t)4 * 128 * 128 * 4);
constexpr size_t OFF_KM = OFF_XB;
constexpr size_t OFF_VM = OFF_XB + (size_t)M * 512 * 2;
constexpr size_t OFF_BIG = al256(OFF_XB + (size_t)M * 1024 * 2);
constexpr size_t OFF_H = OFF_BIG;
constexpr size_t OFF_CQ = OFF_BIG;
constexpr size_t OFF_CKV = OFF_CQ + (size_t)M * 256 * 2;
constexpr size_t OFF_QN = OFF_CKV + (size_t)M * 128 * 2;
constexpr size_t OFF_KV6 = OFF_QN + (size_t)M * 512 * 2;
constexpr size_t OFF_KPE = OFF_KV6 + (size_t)6 * M * 128 * 2;
constexpr size_t OFF_GATES = OFF_KPE + (size_t)M * 32 * 2;
constexpr size_t OFF_QM = OFF_GATES + (size_t)M * 24 * 4;
constexpr size_t OFF_GM = OFF_QM + (size_t)M * 768 * 2;
constexpr size_t OFF_GN = OFF_GM + (size_t)M * 1024 * 2;
constexpr size_t OFF_KC = OFF_GN + (size_t)M * 1024 * 2;
constexpr size_t OFF_VC = OFF_KC + (size_t)16 * 256 * 64 * 2;
constexpr size_t OFF_OM = al256(OFF_VC + (size_t)16 * 256 * 64 * 2 + 65536);
constexpr size_t OFF_ON = OFF_OM + (size_t)M * 512 * 2;
constexpr size_t OFF_MIXEND = OFF_ON + (size_t)M * 512 * 2;
constexpr size_t OFF_HEND = OFF_H + (size_t)M * FF * 2;
constexpr size_t WS_NEED = OFF_MIXEND > OFF_HEND ? OFF_MIXEND : OFF_HEND;

constexpr int VSMEM = 69632 + 8192 + 512;
constexpr int SMEM_BYTES = 2 * VSMEM + 64;

struct Params {
  const float* in[29];
  float* out;
  char* ws;
};

DI int ltid() {
  int t = __builtin_amdgcn_workitem_id_x() & 255;
  asm volatile("" : "+v"(t));
  return t;
}
DI size_t lz() {
  size_t z = 0;
  asm volatile("" : "+s"(z));
  return z;
}
DI int vhalf() {
  int t = __builtin_amdgcn_workitem_id_x();
  asm volatile("" : "+v"(t));
  return __builtin_amdgcn_readfirstlane(t >> 8);
}
DI int vbid() { return (int)blockIdx.x * 2 + vhalf(); }
DI int nvb() { return (int)gridDim.x * 2; }
typedef __attribute__((ext_vector_type(4))) float f32x4_nt;
DI float bf2f(u16 h) { return __uint_as_float(((unsigned)h) << 16); }
DI unsigned pk2(float a, float b) {
  bf2_t v;
  v[0] = (__bf16)a;
  v[1] = (__bf16)b;
  return __builtin_bit_cast(unsigned, v);
}
DI u16 f2bf(float a) { return (u16)(pk2(a, 0.f) & 0xffffu); }
DI float ex2(float x) { return __builtin_amdgcn_exp2f(x); }
DI float sigmoidf_(float x) { return __builtin_amdgcn_rcpf(1.f + __expf(-x)); }
DI bf16x8 pack8(const f32x16& v, int st) {
  u32x4 p;
  p[0] = pk2(v[8 * st + 0], v[8 * st + 1]);
  p[1] = pk2(v[8 * st + 2], v[8 * st + 3]);
  p[2] = pk2(v[8 * st + 4], v[8 * st + 5]);
  p[3] = pk2(v[8 * st + 6], v[8 * st + 7]);
  return __builtin_bit_cast(bf16x8, p);
}
DI s16x4 tr_read(const char* p) {
  return __builtin_amdgcn_ds_read_tr16_b64_v4i16((__attribute__((address_space(3))) s16x4*)(p));
}
DI float xh_max(float x) {
  const auto r = __builtin_amdgcn_permlane32_swap(__float_as_uint(x), __float_as_uint(x), false, false);
  return fmaxf(__uint_as_float(r[0]), __uint_as_float(r[1]));
}
DI float xh_sum(float x) {
  const auto r = __builtin_amdgcn_permlane32_swap(__float_as_uint(x), __float_as_uint(x), false, false);
  return __uint_as_float(r[0]) + __uint_as_float(r[1]);
}
DI float xh_get(float x, int hh) {
  const auto r = __builtin_amdgcn_permlane32_swap(__float_as_uint(x), __float_as_uint(x), false, false);
  return hh ? __uint_as_float(r[0]) : __uint_as_float(r[1]);
}
DI float quad_sum(float x) {
  x += __int_as_float(__builtin_amdgcn_update_dpp(0, __float_as_int(x), 0xB1, 0xF, 0xF, true));
  x += __int_as_float(__builtin_amdgcn_update_dpp(0, __float_as_int(x), 0x4E, 0xF, 0xF, true));
  return x;
}
DI void zero16(f32x16& v) {
  float z = 0.f;
  asm volatile("" : "+v"(z));
  UNROLL for (int i = 0; i < 16; ++i) v[i] = z;
}

DI void gemm_main(const u16* __restrict__ A, int lda, const u16* __restrict__ Bt, int ldb, int K,
                  f32x16 (&acc)[2][2], char* smem) {
  const int tid = ltid(), lane = tid & 63, w = tid >> 6, wr = w >> 1, wc = w & 1;
  const int lrow = tid >> 3, lch = tid & 7;
  const u16* ga = A + (size_t)lrow * lda + lch * 8;
  const u16* gb = Bt + (size_t)lrow * ldb + lch * 8;
  u32x4 ra[4], rb[4];
  UNROLL for (int i = 0; i < 4; ++i) {
    ra[i] = *(const u32x4*)(ga + (size_t)(32 * i) * lda);
    rb[i] = *(const u32x4*)(gb + (size_t)(32 * i) * ldb);
  }
  {
    char* pa = smem + lrow * 144 + lch * 16;
    UNROLL for (int i = 0; i < 4; ++i) {
      *(u32x4*)(pa + i * 32 * 144) = ra[i];
      *(u32x4*)(pa + 18432 + i * 32 * 144) = rb[i];
    }
  }
  __syncthreads();
  const int nk = K >> 6;
  _Pragma("unroll 1") for (int kt = 0; kt < nk; ++kt) {
    const bool more = (kt + 1 < nk);
    if (more) {
      const int k0 = (kt + 1) << 6;
      UNROLL for (int i = 0; i < 4; ++i) {
        ra[i] = *(const u32x4*)(ga + (size_t)(32 * i) * lda + k0);
        rb[i] = *(const u32x4*)(gb + (size_t)(32 * i) * ldb + k0);
      }
    }
    const char* pa = smem + (kt & 1) * 36864 + (wr * 64 + (lane & 31)) * 144 + (lane >> 5) * 16;
    const char* pb = smem + (kt & 1) * 36864 + 18432 + (wc * 64 + (lane & 31)) * 144 + (lane >> 5) * 16;
    UNROLL for (int ks = 0; ks < 4; ++ks) {
      bf16x8 a0 = *(const bf16x8*)(pa + ks * 32);
      bf16x8 a1 = *(const bf16x8*)(pa + 32 * 144 + ks * 32);
      bf16x8 b0 = *(const bf16x8*)(pb + ks * 32);
      bf16x8 b1 = *(const bf16x8*)(pb + 32 * 144 + ks * 32);
      acc[0][0] = MFMA(a0, b0, acc[0][0]);
      acc[0][1] = MFMA(a0, b1, acc[0][1]);
      acc[1][0] = MFMA(a1, b0, acc[1][0]);
      acc[1][1] = MFMA(a1, b1, acc[1][1]);
    }
    if (more) {
      char* pw = smem + ((kt + 1) & 1) * 36864 + lrow * 144 + lch * 16;
      UNROLL for (int i = 0; i < 4; ++i) {
        *(u32x4*)(pw + i * 32 * 144) = ra[i];
        *(u32x4*)(pw + 18432 + i * 32 * 144) = rb[i];
      }
    }
    __syncthreads();
  }
}

#define EPI_VARS const int tid = ltid(), lane = tid & 63, w = tid >> 6, wr = w >> 1, wc = w & 1, l31 = lane & 31, hh = lane >> 5; (void)l31; (void)hh; (void)wr; (void)wc;
#define EROW(mi, i) (wr * 64 + (mi) * 32 + 8 * ((i) >> 2) + 4 * hh + ((i) & 3))

DI void convT(const float* __restrict__ src0, const float* __restrict__ src1, int ldsrc, int K, int Nout,
              int kind, const float* __restrict__ scale, u16* __restrict__ dst, char* smem, int slab) {
  float* t = (float*)smem;
  const int tid = ltid();
  const int tiles_n = (Nout + 255) >> 8, tiles_k = K >> 6;
  for (int tile = vbid(); tile < tiles_n * tiles_k; tile += nvb()) {
    const int tn = tile % tiles_n, tk = tile / tiles_n;
    {
      const int nn = tid, n = tn * 256 + nn;
      const float* src = src0;
      int col = n;
      if (kind == 1) {
        const int j = n >> 8, r = n & 255;
        col = 128 * j + (r & 127);
        src = (r >> 7) ? src1 : src0;
      } else if (kind == 2) {
        if (n < 384) col = n;
        else if (n < 896) col = 416 + (n - 384);
        else if (n < 1664) col = 928 + (n - 896);
        else if (n < 2688) col = 1720 + (n - 1664);
        else if (n < 3712) col = 2744 + (n - 2688);
        else if (n < 3744) col = 384 + (n - 3712);
        else if (n < 3768) col = 1696 + (n - 3744);
        else col = -1;
      } else if (kind == 3) {
        if (n < 512) col = (n >> 6) * 96 + (n & 63);
        else col = ((n - 512) >> 5) * 96 + 64 + ((n - 512) & 31);
      }
      if (n >= Nout) col = -1;
      _Pragma("unroll 1") for (int kb = 0; kb < 4; ++kb) {
        float v[16];
        UNROLL for (int i = 0; i < 16; ++i) {
          const int k = tk * 64 + kb * 16 + i;
          v[i] = (col >= 0) ? __builtin_nontemporal_load(src + (size_t)k * ldsrc + col) : 0.f;
          if (scale) v[i] *= scale[k];
        }
        UNROLL for (int i = 0; i < 16; ++i) t[(kb * 16 + i) * 257 + nn] = v[i];
      }
    }
    __syncthreads();
    {
      const int k8 = (tid & 7) * 8;
      UNROLL for (int i = 0; i < 8; ++i) {
        const int n2 = (tid >> 3) + 32 * i, n = tn * 256 + n2;
        if (n < Nout) {
          u32x4 o;
          o[0] = pk2(t[(k8 + 0) * 257 + n2], t[(k8 + 1) * 257 + n2]);
          o[1] = pk2(t[(k8 + 2) * 257 + n2], t[(k8 + 3) * 257 + n2]);
          o[2] = pk2(t[(k8 + 4) * 257 + n2], t[(k8 + 5) * 257 + n2]);
          o[3] = pk2(t[(k8 + 6) * 257 + n2], t[(k8 + 7) * 257 + n2]);
          const size_t di = slab ? ((size_t)(((n >> 8) * (K >> 6) + tk) * 256 + (n & 255)) * 64 + k8) : ((size_t)n * K + tk * 64 + k8);
          *(u32x4*)(dst + di) = o;
        }
      }
    }
    __syncthreads();
  }
}

DI void phase_init(const Params& p, char* smem) {
  const int tid = ltid();
  const size_t gtid = (size_t)vbid() * 256 + tid, gsz = (size_t)nvb() * 256;
  if (vbid() == 0 && tid < 64) ((int*)(p.ws + OFF_CNT))[tid] = 0;
  {
    const float4* xs = (const float4*)p.in[0];
    u32x2* xb = (u32x2*)(p.ws + OFF_XB);
    const size_t n4 = (size_t)M * DM / 4;
    for (size_t i = gtid; i < n4; i += 4 * gsz) {
      float4 v[4];
      UNROLL for (int u = 0; u < 4; ++u) if (i + u * gsz < n4) {
        const f32x4_nt t4 = __builtin_nontemporal_load((const f32x4_nt*)(xs + i + u * gsz));
        v[u] = make_float4(t4[0], t4[1], t4[2], t4[3]);
      }
      UNROLL for (int u = 0; u < 4; ++u) if (i + u * gsz < n4) {
        u32x2 o;
        o[0] = pk2(v[u].x, v[u].y);
        o[1] = pk2(v[u].z, v[u].w);
        xb[i + u * gsz] = o;
      }
    }
  }
  {
    float* cn = (float*)(p.ws + OFF_COSN);
    float* sn = (float*)(p.ws + OFF_SINN);
    float* cm = (float*)(p.ws + OFF_COSM);
    float* sm = (float*)(p.ws + OFF_SINM);
    for (size_t i = gtid; i < (size_t)T * 24; i += gsz) {
      const int t = (int)(i / 24), j = (int)(i % 24);
      if (j < 8) {
        const float inv = (float)(1.0 / pow(500000.0, (double)(2 * j) / 16.0));
        const float ang = (float)t * inv;
        cn[t * 8 + j] = (float)cos((double)ang);
        sn[t * 8 + j] = (float)sin((double)ang);
      } else {
        const int m = j - 8;
        const float inv = (float)(1.0 / pow(500000.0, (double)(2 * m) / 32.0));
        const float ang = (float)t * inv;
        cm[t * 16 + m] = (float)cos((double)ang);
        sm[t * 16 + m] = (float)sin((double)ang);
      }
    }
  }
  for (int u = vbid(); u < 512; u += nvb()) {
    const int job = u >> 7, chunk = u & 127, layer = job >> 1, kv = job & 1;
    const float* pe = p.in[kv ? 15 : 11] + (size_t)layer * 2048;
    const float* w1 = p.in[kv ? 16 : 12] + (size_t)layer * 2048 * 128;
    float* red = (float*)smem;
    const int n = tid & 127, sub = tid >> 7;
    float sacc = 0.f;
    UNROLL for (int i = 0; i < 8; ++i) {
      const int kk = chunk * 16 + sub * 8 + i;
      sacc += pe[kk] * w1[(size_t)kk * 128 + n];
    }
    red[tid] = sacc;
    __syncthreads();
    if (tid < 128) ((float*)(p.ws + OFF_PART))[(size_t)(job * 128 + chunk) * 128 + n] = red[tid] + red[tid + 128];
    __syncthreads();
  }
  for (int job = 0; job < 28; ++job) {
    const int layer = job / 14, jj = job % 14;
    u16* wl = (u16*)(p.ws + OFF_W) + (size_t)layer * W_LAYER;
    const float* s0 = nullptr; const float* s1 = nullptr; const float* sc = nullptr;
    int ldsrc = 0, K = 0, Nout = 0, kind = 0; size_t woff = 0;
    switch (jj) {
      case 0: s0 = p.in[3] + (size_t)layer * DM * FF; s1 = p.in[4] + (size_t)layer * DM * FF; ldsrc = FF; K = 1024; Nout = 5632; kind = 1; woff = W_UP1; break;
      case 1: s0 = p.in[5] + (size_t)layer * FF * DM; ldsrc = DM; K = FF; Nout = 1024; woff = W_DN1; break;
      case 2: s0 = p.in[6] + (size_t)layer * DM * 3768; ldsrc = 3768; K = 1024; Nout = 3840; kind = 2; woff = W_IN; break;
      case 3: s0 = p.in[8] + (size_t)layer * 256 * 768; ldsrc = 768; K = 256; Nout = 768; kind = 3; sc = p.in[7] + layer * 256; woff = W_UQ; break;
      case 4: s0 = p.in[10] + (size_t)layer * 128 * 1024; ldsrc = 1024; K = 128; Nout = 1024; sc = p.in[9] + layer * 128; woff = W_UKV; break;
      case 5: s0 = p.in[12] + (size_t)layer * 2048 * 128; ldsrc = 128; K = 2048; Nout = 128; woff = W_CK1; break;
      case 6: s0 = p.in[14] + (size_t)layer * 128 * 64; ldsrc = 64; K = 128; Nout = 64; woff = W_CK2; break;
      case 7: s0 = p.in[16] + (size_t)layer * 2048 * 128; ldsrc = 128; K = 2048; Nout = 128; woff = W_CV1; break;
      case 8: s0 = p.in[18] + (size_t)layer * 128 * 64; ldsrc = 64; K = 128; Nout = 64; woff = W_CV2; break;
      case 9: s0 = p.in[19] + (size_t)layer * 512 * 1024; ldsrc = 1024; K = 512; Nout = 1024; woff = W_PM; break;
      case 10: s0 = p.in[20] + (size_t)layer * 512 * 1024; ldsrc = 1024; K = 512; Nout = 1024; woff = W_PN; break;
      case 11: s0 = p.in[21] + (size_t)layer * 1024 * 1024; ldsrc = 1024; K = 1024; Nout = 1024; woff = W_OUT; break;
      case 12: s0 = p.in[24] + (size_t)layer * DM * FF; s1 = p.in[25] + (size_t)layer * DM * FF; ldsrc = FF; K = 1024; Nout = 5632; kind = 1; woff = W_UP2; break;
      default: s0 = p.in[26] + (size_t)layer * FF * DM; ldsrc = DM; K = FF; Nout = 1024; woff = W_DN2; break;
    }
    convT(s0, s1, ldsrc, K, Nout, kind, sc, wl + woff, smem, (jj == 1 || jj == 13) ? 1 : 0);
  }
}

namespace pg8 {
#define PG8_LAS __attribute__((address_space(3)))
typedef unsigned short bf16_t;
typedef short bf16x8 __attribute__((ext_vector_type(8)));
typedef float f32x4 __attribute__((ext_vector_type(4)));
typedef unsigned u32x4 __attribute__((ext_vector_type(4)));
constexpr int BM = 256, BK = 64, HALF = 128, HTB = HALF * BK * 2  , STAGE_BYTES = 8 * HTB, NXCD = 8, WGM = 8;

__host__ __device__ __forceinline__ int lds_byte(int r, int c) { const int st = (r >> 4) * 2 + (c >> 5), rr = r & 15, cc = c & 31, ob = rr * 64 + cc * 2; return st * 1024 + (ob ^ (((ob >> 9) & 1) << 5)); }
__host__ __device__ __forceinline__ void stage_rc(int b, int& R, int& C) { const int st = b / 1024, sb = b % 1024, swz = sb ^ (((sb >> 9) & 1) << 5); R = (st >> 1) * 16 + swz / 64; C = (st & 1) * 32 + (swz % 64) / 2; }
__host__ __device__ __forceinline__ int perm32(int rho) { const int n = rho >> 4, i = rho & 15; return 8 * (i >> 2) + 4 * n + (i & 3); }

struct Unit { int pm, pn; };
struct Gemm { const bf16_t* A; const bf16_t* Bt; int M, N, K; };

struct StaticOrder {
    int nM, nN, nwg, G, c;
    __host__ __device__ void init(int M, int N, int G_, int c_) { nM = M / BM; nN = N / BM; nwg = nM * nN; G = G_; c = c_; }
    __host__ __device__ bool next(int i, Unit& u) const {
        const long L = (long)i * G + c; if (L >= nwg) return false;
        int wgid = (int)L; { const int q = nwg / NXCD, r = nwg % NXCD, xcd = wgid % NXCD, off = wgid / NXCD; wgid = (xcd < r ? xcd * (q + 1) : r * (q + 1) + (xcd - r) * q) + off; }
        const int nig = WGM * nN, gid = wgid / nig, fm = gid * WGM, gsz = (nM - fm) < WGM ? (nM - fm) : WGM;
        u.pm = fm + ((wgid % nig) % gsz); u.pn = (wgid % nig) / gsz; return true;
    }
    __device__ __forceinline__ void a_ready(const Unit&) const {}
    __device__ __forceinline__ void done(const Unit&) const {}
};

template <class Epi, class Sched, bool STAMP = false, bool ATILED = false, bool BTILED = false>
__device__ __forceinline__ void gemm_phase(PG8_LAS unsigned char* lds, const Gemm g, const Sched& S, const Epi& E, unsigned long long* stamps) {
    int tid = threadIdx.x; asm volatile("" : "+v"(tid));
    const int wid = __builtin_amdgcn_readfirstlane(tid >> 6), lane = tid & 63, wr = wid >> 2, wc = wid & 3, fr = lane & 15, fq = lane >> 4;
    const int K = g.K, nt = K / BK;
    int ts_lo = 0, ts_hi = 0, nts = 0; const unsigned long long rt_entry = STAMP ? (unsigned long long)wall_clock64() : 0ull;
#define PG8_STAMP() do { if (STAMP && wid == 0 && nts < 64) { const unsigned long long _c = (unsigned long long)clock64(); \
        ts_lo = (lane == nts) ? (int)(unsigned)_c : ts_lo; ts_hi = (lane == nts) ? (int)(unsigned)(_c >> 32) : ts_hi; ++nts; } } while (0)
    PG8_STAMP();
    unsigned voffA[2], voffB[2];
#pragma unroll
    for (int i = 0; i < 2; ++i) { int R, C; stage_rc(tid * 16 + i * 8192, R, C); const int Rb = Epi::PERM ? ((R & ~31) + perm32(R & 31)) : R;
        voffA[i] = (unsigned)(R * (ATILED ? BK : K) + C) * 2u; voffB[i] = (unsigned)(Rb * (BTILED ? BK : K) + C) * 2u; }
    const size_t kstep = (size_t)(BK * 2);
    const size_t hstep = (size_t)HALF * K * 2;
    const size_t tstep = 2 * hstep;
    const size_t kstepA = ATILED ? (size_t)(BM * BK * 2) : kstep, hstepA = ATILED ? (size_t)(HALF * BK * 2) : hstep, tstepA = ATILED ? (size_t)(K / BK) * (size_t)(BM * BK * 2) : tstep;
    const size_t kstepB = BTILED ? (size_t)(BM * BK * 2) : kstep, hstepB = BTILED ? (size_t)(HALF * BK * 2) : hstep, tstepB = BTILED ? (size_t)(K / BK) * (size_t)(BM * BK * 2) : tstep;
    const unsigned ldsw = (unsigned)wid * 1024u;
    const int aoff = lds_byte(wr * 64 + fr, fq * 8), boff = lds_byte(wc * 32 + fr, fq * 8);
#define PG8_SA(b, h) (((b) * 2 + (h)) * HTB)
#define PG8_SB(b, h) ((4 + (b) * 2 + (h)) * HTB)
#define PG8_STAGE(bufoff, gbase, voff) do { _Pragma("unroll") for (int _i = 0; _i < 2; ++_i) \
        __builtin_amdgcn_global_load_lds((const unsigned*)((const char*)(gbase) + (voff)[_i]), (PG8_LAS unsigned*)(lds + (bufoff) + ldsw + _i * 8192), 16, 0, 0); } while (0)
#define PG8_LDA(dst, b, h) do { _Pragma("unroll") for (int m = 0; m < 4; ++m) _Pragma("unroll") for (int k = 0; k < 2; ++k) dst[m][k] = *(const PG8_LAS bf16x8*)(lds + PG8_SA(b, h) + aoff + m * 2048 + k * 1024); } while (0)
#define PG8_LDB(dst, b, h) do { _Pragma("unroll") for (int n = 0; n < 2; ++n) _Pragma("unroll") for (int k = 0; k < 2; ++k) dst[n][k] = *(const PG8_LAS bf16x8*)(lds + PG8_SB(b, h) + boff + n * 2048 + k * 1024); } while (0)
#define PG8_MMA(ai, bj, At, Bt) do { __builtin_amdgcn_s_setprio(1); _Pragma("unroll") for (int m = 0; m < 4; ++m) _Pragma("unroll") for (int n = 0; n < 2; ++n) _Pragma("unroll") for (int k = 0; k < 2; ++k) \
        acc[ai][bj][m][n] = __builtin_amdgcn_mfma_f32_16x16x32_bf16(Bt[n][k], At[m][k], acc[ai][bj][m][n], 0, 0, 0); __builtin_amdgcn_s_setprio(0); } while (0)
#define PG8_WAIT_V(n) asm volatile("s_waitcnt vmcnt(" #n ")" ::: "memory")
#define PG8_WAIT_L(n) asm volatile("s_waitcnt lgkmcnt(" #n ")" ::: "memory")
#define PG8_BAR __builtin_amdgcn_s_barrier()
#define PG8_SCHED __builtin_amdgcn_sched_barrier(0)
    Unit cur, nxt; int ui = 0;
    if (!S.next(0, cur)) return;
    f32x4 acc[2][2][4][2];
#pragma unroll
    for (int a = 0; a < 2; ++a)
#pragma unroll
        for (int b = 0; b < 2; ++b)
#pragma unroll
            for (int m = 0; m < 4; ++m)
#pragma unroll
                for (int n = 0; n < 2; ++n) acc[a][b][m][n] = (f32x4){0.f, 0.f, 0.f, 0.f};
    bf16x8 At[4][2], B0[2][2], B1[2][2];
    const char* cA = (const char*)g.A + (size_t)cur.pm * tstepA; const char* cB = (const char*)g.Bt + (size_t)cur.pn * tstepB;
    S.a_ready(cur);
    PG8_STAGE(PG8_SB(0, 0), cB, voffB); PG8_STAGE(PG8_SA(0, 0), cA, voffA); PG8_STAGE(PG8_SB(0, 1), cB + hstepB, voffB); PG8_STAGE(PG8_SA(0, 1), cA + hstepA, voffA);
    if (wr == 1) PG8_BAR;
    PG8_WAIT_V(4); PG8_BAR;
    PG8_STAGE(PG8_SB(1, 0), cB + kstepB, voffB); PG8_STAGE(PG8_SA(1, 0), cA + kstepA, voffA); PG8_STAGE(PG8_SB(1, 1), cB + hstepB + kstepB, voffB);
    PG8_WAIT_V(6); PG8_BAR;
    PG8_STAMP();
    for (;;) {
        const bool has_next = S.next(ui + 1, nxt);
        const char* nA = has_next ? (const char*)g.A + (size_t)nxt.pm * tstepA : cA; const char* nB = has_next ? (const char*)g.Bt + (size_t)nxt.pn * tstepB : cB;
        for (int t = 0; t < nt; t += 2) {
            const bool last = (t == nt - 2);
            const char* a1 = cA + (size_t)(t + 1) * kstepA;
            const char* a2 = last ? nA : cA + (size_t)(t + 2) * kstepA; const char* b2 = last ? nB : cB + (size_t)(t + 2) * kstepB;
            const char* a3 = a2 + kstepA; const char* b3 = b2 + kstepB;
            if (last && has_next) S.a_ready(nxt);
            PG8_LDB(B0, 0, 0); PG8_SCHED; PG8_LDA(At, 0, 0); PG8_STAGE(PG8_SA(1, 1), a1 + hstepA, voffA);
            PG8_WAIT_L(8); PG8_BAR; PG8_WAIT_L(0); PG8_MMA(0, 0, At, B0); PG8_BAR; PG8_SCHED;
            PG8_LDB(B1, 0, 1); PG8_STAGE(PG8_SB(0, 0), b2, voffB);
            PG8_BAR; PG8_WAIT_L(0); PG8_MMA(0, 1, At, B1); PG8_BAR;
            PG8_LDA(At, 0, 1); PG8_STAGE(PG8_SA(0, 0), a2, voffA);
            PG8_BAR; PG8_WAIT_L(0); PG8_MMA(1, 0, At, B0); PG8_BAR; PG8_SCHED;
            PG8_STAGE(PG8_SB(0, 1), b2 + hstepB, voffB);
            PG8_WAIT_V(6); PG8_BAR; PG8_MMA(1, 1, At, B1); PG8_BAR;
            PG8_LDB(B0, 1, 0); PG8_SCHED; PG8_LDA(At, 1, 0); PG8_STAGE(PG8_SA(0, 1), a2 + hstepA, voffA);
            PG8_WAIT_L(8); PG8_BAR; PG8_WAIT_L(0); PG8_MMA(0, 0, At, B0); PG8_BAR; PG8_SCHED;
            PG8_LDB(B1, 1, 1); PG8_STAGE(PG8_SB(1, 0), b3, voffB);
            PG8_BAR; PG8_WAIT_L(0); PG8_MMA(0, 1, At, B1); PG8_BAR;
            PG8_LDA(At, 1, 1); PG8_STAGE(PG8_SA(1, 0), a3, voffA);
            PG8_BAR; PG8_WAIT_L(0); PG8_MMA(1, 0, At, B0); PG8_BAR; PG8_SCHED;
            PG8_STAGE(PG8_SB(1, 1), b3 + hstepB, voffB);
            PG8_WAIT_V(6); PG8_BAR; PG8_MMA(1, 1, At, B1); PG8_BAR;
        }
        PG8_STAMP();
        if constexpr (!Epi::AFTER_DRAIN) { E(acc, cur, wr, wc, fr, fq); S.done(cur); }
        PG8_STAMP();
        if (!has_next) break;
#pragma unroll
        for (int a = 0; a < 2; ++a)
#pragma unroll
            for (int b = 0; b < 2; ++b)
#pragma unroll
                for (int m = 0; m < 4; ++m)
#pragma unroll
                    for (int n = 0; n < 2; ++n) acc[a][b][m][n] = (f32x4){0.f, 0.f, 0.f, 0.f};
        cur = nxt; cA = nA; cB = nB; ++ui;
    }
    PG8_WAIT_V(0);
    if (wr == 0) PG8_BAR;
    PG8_BAR;
    if constexpr (Epi::AFTER_DRAIN) { E.fused(acc, cur, wr, wc, fr, fq, lds, wid, lane); S.done(cur); }
    PG8_STAMP();
    if (STAMP && wid == 0) { stamps[lane] = lane < nts ? (((unsigned long long)(unsigned)ts_hi << 32) | (unsigned)ts_lo) : 0ull;
        if (lane == 62) stamps[62] = rt_entry; if (lane == 63) stamps[63] = (unsigned long long)wall_clock64(); }
#undef PG8_STAMP
#undef PG8_SA
#undef PG8_SB
#undef PG8_STAGE
#undef PG8_LDA
#undef PG8_LDB
#undef PG8_MMA
#undef PG8_WAIT_V
#undef PG8_WAIT_L
#undef PG8_BAR
#undef PG8_SCHED
}
}

typedef pg8::f32x4 f32x4_t;
DI f32x4_t ld4(const float* p) { return *(const f32x4_t*)p; }

struct EpiSwiglu {
  static constexpr bool PERM = true, AFTER_DRAIN = false;
  u16* H;
  __device__ __forceinline__ void operator()(const f32x4_t (&acc)[2][2][4][2], const pg8::Unit& u, int wr, int wc, int fr, int fq) const {
    u16* base = H + ((size_t)(u.pm * (FF / 64) + 2 * u.pn + (wc >> 1)) * 256) * 64 + (size_t)((wr * 64 + fr) * 64 + (wc & 1) * 32 + fq * 8);
    UNROLL for (int ai = 0; ai < 2; ++ai) UNROLL for (int m = 0; m < 4; ++m) {
      float h[8];
      UNROLL for (int n = 0; n < 2; ++n) UNROLL for (int j = 0; j < 4; ++j) {
        const float g = acc[ai][0][m][n][j], up = acc[ai][1][m][n][j];
        h[4 * n + j] = g * __builtin_amdgcn_rcpf(1.f + __expf(-g)) * up;
      }
      u32x4 o;
      o[0] = pk2(h[0], h[1]); o[1] = pk2(h[2], h[3]); o[2] = pk2(h[4], h[5]); o[3] = pk2(h[6], h[7]);
      *(u32x4*)(base + (ai * 128 + m * 16) * 64) = o;
    }
  }
};

struct EpiResid {
  static constexpr bool PERM = true, AFTER_DRAIN = false;
  const float* Xin; float* X; float coef;
  __device__ __forceinline__ void operator()(const f32x4_t (&acc)[2][2][4][2], const pg8::Unit& u, int wr, int wc, int fr, int fq) const {
    UNROLL for (int ai = 0; ai < 2; ++ai) UNROLL for (int m = 0; m < 4; ++m) {
      const int row = u.pm * 256 + ai * 128 + wr * 64 + m * 16 + fr;
      UNROLL for (int bj = 0; bj < 2; ++bj) {
        const size_t off = (size_t)row * DM + u.pn * 256 + bj * 128 + wc * 32 + fq * 8;
        UNROLL for (int n = 0; n < 2; ++n) {
          f32x4_t x = *(const f32x4_t*)(Xin + off + 4 * n);
          x = x * ALPHA + acc[ai][bj][m][n] * coef;
          *(f32x4_t*)(X + off + 4 * n) = x;
        }
      }
    }
  }
};

struct EpiGate1 {
  static constexpr bool PERM = true, AFTER_DRAIN = false;
  u16* GM;
  __device__ __forceinline__ void operator()(const f32x4_t (&acc)[2][2][4][2], const pg8::Unit& u, int wr, int wc, int fr, int fq) const {
    UNROLL for (int ai = 0; ai < 2; ++ai) UNROLL for (int m = 0; m < 4; ++m) {
      const int row = u.pm * 256 + ai * 128 + wr * 64 + m * 16 + fr;
      UNROLL for (int bj = 0; bj < 2; ++bj) {
        u16* pg = GM + (size_t)row * 1024 + u.pn * 256 + bj * 128 + wc * 32 + fq * 8;
        const u32x4 g = *(const u32x4*)pg;
        u32x4 o;
        UNROLL for (int e = 0; e < 4; ++e) {
          const float lo = __uint_as_float(g[e] << 16) * acc[ai][bj][m][e >> 1][(e & 1) * 2];
          const float hi = __uint_as_float(g[e] & 0xffff0000u) * acc[ai][bj][m][e >> 1][(e & 1) * 2 + 1];
          o[e] = pk2(lo, hi);
        }
        *(u32x4*)pg = o;
      }
    }
  }
};
struct EpiGate2 {
  static constexpr bool PERM = true, AFTER_DRAIN = false;
  const u16* GM; const u16* GN; u16* Y;
  __device__ __forceinline__ void operator()(const f32x4_t (&acc)[2][2][4][2], const pg8::Unit& u, int wr, int wc, int fr, int fq) const {
    UNROLL for (int ai = 0; ai < 2; ++ai) UNROLL for (int m = 0; m < 4; ++m) {
      const int row = u.pm * 256 + ai * 128 + wr * 64 + m * 16 + fr;
      UNROLL for (int bj = 0; bj < 2; ++bj) {
        const size_t off = (size_t)row * 1024 + u.pn * 256 + bj * 128 + wc * 32 + fq * 8;
        const u32x4 t1 = *(const u32x4*)(GM + off);
        const u32x4 g = *(const u32x4*)(GN + off);
        u32x4 o;
        UNROLL for (int e = 0; e < 4; ++e) {
          const float lo = __uint_as_float(t1[e] << 16) + __uint_as_float(g[e] << 16) * acc[ai][bj][m][e >> 1][(e & 1) * 2];
          const float hi = __uint_as_float(t1[e] & 0xffff0000u) + __uint_as_float(g[e] & 0xffff0000u) * acc[ai][bj][m][e >> 1][(e & 1) * 2 + 1];
          o[e] = pk2(lo, hi);
        }
        *(u32x4*)(Y + off) = o;
      }
    }
  }
};

struct EpiWin {
  static constexpr bool PERM = true, AFTER_DRAIN = false;
  char* ws_;
  __device__ __forceinline__ void operator()(const f32x4_t (&acc)[2][2][4][2], const pg8::Unit& u, int wr, int wc, int fr, int fq) const {
    char* ws = ws_ + lz();
    u16* CQ = (u16*)(ws + OFF_CQ);
    u16* CKV = (u16*)(ws + OFF_CKV);
    u16* QN = (u16*)(ws + OFF_QN);
    u16* KV6 = (u16*)(ws + OFF_KV6);
    u16* KPE = (u16*)(ws + OFF_KPE);
    float* GATES = (float*)(ws + OFF_GATES);
    u16* GM = (u16*)(ws + OFF_GM);
    u16* GN = (u16*)(ws + OFF_GN);
    const float* COSN = (const float*)(ws + OFF_COSN);
    const float* SINN = (const float*)(ws + OFF_SINN);
    const float* COSM = (const float*)(ws + OFF_COSM);
    const float* SINM = (const float*)(ws + OFF_SINM);
    UNROLL for (int bj = 0; bj < 2; ++bj) {
      const int hc = 2 * u.pn + bj;
      const int cin = wc * 32 + fq * 8;
      UNROLL for (int ai = 0; ai < 2; ++ai) UNROLL for (int m = 0; m < 4; ++m) {
        const int row = u.pm * 256 + ai * 128 + wr * 64 + m * 16 + fr;
        const int t = row & (T - 1), b = row >> 12;
        float v[8];
        UNROLL for (int n = 0; n < 2; ++n) UNROLL for (int j = 0; j < 4; ++j) v[4 * n + j] = acc[ai][bj][m][n][j];
        if (hc < 3) {
          u16* dst = hc < 2 ? (CQ + (size_t)row * 256 + hc * 128 + cin) : (CKV + (size_t)row * 128 + cin);
          u32x4 o;
          o[0] = pk2(v[0], v[1]); o[1] = pk2(v[2], v[3]); o[2] = pk2(v[4], v[5]); o[3] = pk2(v[6], v[7]);
          *(u32x4*)dst = o;
        } else if (hc < 13) {
          const bool isq = hc < 7;
          const int j6 = hc - 7;
          const bool rope_on = isq || ((j6 & 1) == 0);
          if ((wc & 1) == 0) {
            float pr[8];
            UNROLL for (int e = 0; e < 8; ++e) pr[e] = __shfl_xor(v[e], 16);
            if (rope_on && fq < 2) {
              const f32x4_t c0 = ld4(COSN + t * 8), c1 = ld4(COSN + t * 8 + 4), s0 = ld4(SINN + t * 8), s1 = ld4(SINN + t * 8 + 4);
              UNROLL for (int e = 0; e < 8; ++e) {
                const float cs = e < 4 ? c0[e & 3] : c1[e & 3], sn = e < 4 ? s0[e & 3] : s1[e & 3];
                v[e] = (fq == 0) ? (v[e] * cs - pr[e] * sn) : (v[e] * cs + pr[e] * sn);
              }
            }
          }
          const int d = (wc & 1) * 32 + fq * 8;
          u16* dst = isq ? (QN + (size_t)row * 512 + (2 * (hc - 3) + (wc >> 1)) * 64 + d)
                         : (KV6 + ((size_t)((j6 * NB + b) * 2 + (wc >> 1)) * T + t) * 64 + d);
          u32x4 o;
          o[0] = pk2(v[0], v[1]); o[1] = pk2(v[2], v[3]); o[2] = pk2(v[4], v[5]); o[3] = pk2(v[6], v[7]);
          *(u32x4*)dst = o;
        } else if (hc < 29) {
          u16* dst = (hc < 21 ? GM : GN) + (size_t)row * 1024 + (hc < 21 ? hc - 13 : hc - 21) * 128 + cin;
          u32x4 o;
          o[0] = pk2(sigmoidf_(v[0]), sigmoidf_(v[1])); o[1] = pk2(sigmoidf_(v[2]), sigmoidf_(v[3]));
          o[2] = pk2(sigmoidf_(v[4]), sigmoidf_(v[5])); o[3] = pk2(sigmoidf_(v[6]), sigmoidf_(v[7]));
          *(u32x4*)dst = o;
        } else {
          if (wc == 0) {
            float pr[8];
            UNROLL for (int e = 0; e < 8; ++e) pr[e] = __shfl_xor(v[e], 32);
            const int mb = (fq & 1) * 8;
            const f32x4_t c0 = ld4(COSM + t * 16 + mb), c1 = ld4(COSM + t * 16 + mb + 4), s0 = ld4(SINM + t * 16 + mb), s1 = ld4(SINM + t * 16 + mb + 4);
            UNROLL for (int e = 0; e < 8; ++e) {
              const float cs = e < 4 ? c0[e & 3] : c1[e & 3], sn = e < 4 ? s0[e & 3] : s1[e & 3];
              v[e] = (fq < 2) ? (v[e] * cs - pr[e] * sn) : (v[e] * cs + pr[e] * sn);
            }
            u32x4 o;
            o[0] = pk2(v[0], v[1]); o[1] = pk2(v[2], v[3]); o[2] = pk2(v[4], v[5]); o[3] = pk2(v[6], v[7]);
            *(u32x4*)(KPE + (size_t)row * 32 + fq * 8) = o;
          } else if (wc == 1 && fq < 3) {
            float* dst = GATES + (size_t)row * 24 + fq * 8;
            f32x4_t g0, g1;
            UNROLL for (int e = 0; e < 4; ++e) { g0[e] = sigmoidf_(v[e]); g1[e] = sigmoidf_(v[4 + e]); }
            *(f32x4_t*)dst = g0;
            *(f32x4_t*)(dst + 4) = g1;
          }
        }
      }
    }
  }
};

template <bool ATILED = false, bool BTILED = false, class Epi>
DI void big_gemm(const u16* A, const u16* Bt, int N, int K, const Epi& E, char* smem_blk) {
  pg8::Gemm g{A, Bt, M, N, K};
  pg8::StaticOrder S;
  S.init(M, N, (int)gridDim.x, (int)blockIdx.x);
  pg8::gemm_phase<Epi, pg8::StaticOrder, false, ATILED, BTILED>((PG8_LAS unsigned char*)smem_blk, g, S, E, nullptr);
  __syncthreads();
}

DI void bias_reduce(const Params& p) {
  const int vb = vbid(), tid = ltid();
  if (vb < 4 && tid < 128) {
    const int job = vb, layer = job >> 1, kv = job & 1;
    const float* part = (const float*)(p.ws + OFF_PART) + (size_t)job * 128 * 128;
    float sacc = (p.in[kv ? 17 : 13] + (size_t)layer * 128)[tid];
    for (int ch = 0; ch < 128; ++ch) sacc += part[ch * 128 + tid];
    ((float*)(p.ws + OFF_BIAS))[job * 128 + tid] = sacc;
  }
}

template <bool WXB = true>
DI void phase_ln(const Params& p, const float* g, const float* b) {
  const int tid = ltid(), lane = tid & 63, w = tid >> 6;
  float* X = p.out;
  u16* Xb = (u16*)(p.ws + OFF_XB);
  float4 gv[4], bv[4];
  UNROLL for (int i = 0; i < 4; ++i) {
    gv[i] = *(const float4*)(g + i * 256 + lane * 4);
    bv[i] = *(const float4*)(b + i * 256 + lane * 4);
  }
  for (int row0 = vbid() * 4 + w; row0 < M; row0 += nvb() * 8) {
    int row1 = row0 + nvb() * 4;
    const bool has1 = row1 < M;
    if (!has1) row1 = row0;
    float4 va[4], vc[4];
    UNROLL for (int i = 0; i < 4; ++i) {
      va[i] = *(const float4*)(X + (size_t)row0 * DM + i * 256 + lane * 4);
      vc[i] = *(const float4*)(X + (size_t)row1 * DM + i * 256 + lane * 4);
    }
    float s0 = 0.f, s1 = 0.f;
    UNROLL for (int i = 0; i < 4; ++i) {
      s0 += va[i].x + va[i].y + va[i].z + va[i].w;
      s1 += vc[i].x + vc[i].y + vc[i].z + vc[i].w;
    }
    UNROLL for (int o = 32; o >= 1; o >>= 1) { s0 += __shfl_xor(s0, o); s1 += __shfl_xor(s1, o); }
    const float mu0 = s0 * (1.f / 1024.f), mu1 = s1 * (1.f / 1024.f);
    float q0 = 0.f, q1 = 0.f;
    UNROLL for (int i = 0; i < 4; ++i) {
      va[i].x -= mu0; va[i].y -= mu0; va[i].z -= mu0; va[i].w -= mu0;
      vc[i].x -= mu1; vc[i].y -= mu1; vc[i].z -= mu1; vc[i].w -= mu1;
      q0 += va[i].x * va[i].x + va[i].y * va[i].y + va[i].z * va[i].z + va[i].w * va[i].w;
      q1 += vc[i].x * vc[i].x + vc[i].y * vc[i].y + vc[i].z * vc[i].z + vc[i].w * vc[i].w;
    }
    UNROLL for (int o = 32; o >= 1; o >>= 1) { q0 += __shfl_xor(q0, o); q1 += __shfl_xor(q1, o); }
    const float rstd0 = rsqrtf(q0 * (1.f / 1024.f) + 1e-5f), rstd1 = rsqrtf(q1 * (1.f / 1024.f) + 1e-5f);
#define LN_STORE(V, ROW, RSTD)                                                                   \
  UNROLL for (int i = 0; i < 4; ++i) {                                                            \
    float4 y;                                                                                      \
    y.x = V[i].x * (RSTD) * gv[i].x + bv[i].x;                                                    \
    y.y = V[i].y * (RSTD) * gv[i].y + bv[i].y;                                                    \
    y.z = V[i].z * (RSTD) * gv[i].z + bv[i].z;                                                    \
    y.w = V[i].w * (RSTD) * gv[i].w + bv[i].w;                                                    \
    *(float4*)(X + (size_t)(ROW) * DM + i * 256 + lane * 4) = y;                                  \
    u32x2 o;                                                                                       \
    o[0] = pk2(y.x, y.y);                                                                          \
    o[1] = pk2(y.z, y.w);                                                                          \
    if (WXB) *(u32x2*)(Xb + (size_t)(ROW) * DM + i * 256 + lane * 4) = o;                         \
  }
    LN_STORE(va, row0, rstd0)
    if (has1) { LN_STORE(vc, row1, rstd1) }
#undef LN_STORE
  }
}

DI float gelu_tanh(float x) {
  const float u = 0.7978845608028654f * (x + 0.044715f * x * x * x);
  return x * __builtin_amdgcn_rcpf(1.f + __expf(-2.f * u));
}

DI void phase_up_cmp(const Params& p, int layer, char* smem) {
  EPI_VARS
  const u16* WL = (const u16*)(p.ws + OFF_W) + (size_t)layer * W_LAYER;
  float* rstd = (float*)(smem + 73728);
  const float* COSM = (const float*)(p.ws + OFF_COSM);
  const float* SINM = (const float*)(p.ws + OFF_SINM);
  for (int task = vbid(); task < 64; task += nvb()) {
    char* wsz = p.ws + lz();
    f32x16 acc[2][2];
    UNROLL for (int a = 0; a < 2; ++a) UNROLL for (int b = 0; b < 2; ++b) zero16(acc[a][b]);
      const int kv = task >> 5, bg = (task >> 1) & 15, mt = task & 1;
      const u16* A = (const u16*)(wsz + OFF_KV6) + ((size_t)(kv * 16 + bg) * T) * 64 + (size_t)mt * 128 * 1024;
      const u16* W1 = WL + (kv ? W_CV1 : W_CK1);
      const u16* W2 = WL + (kv ? W_CV2 : W_CK2);
      const float* bias = (const float*)(wsz + OFF_BIAS) + (layer * 2 + kv) * 128;
      u16* dst = (u16*)(wsz + (kv ? OFF_VC : OFF_KC)) + (size_t)bg * 256 * 64;
      gemm_main(A, 1024, W1, 2048, 2048, acc, smem);
      UNROLL for (int mi = 0; mi < 2; ++mi) UNROLL for (int ni = 0; ni < 2; ++ni) UNROLL for (int i = 0; i < 16; ++i) {
        const int r = EROW(mi, i), c = wc * 64 + ni * 32 + l31;
        *(u16*)(smem + r * 272 + c * 2) = f2bf(gelu_tanh(acc[mi][ni][i] + bias[c]));
      }
      __syncthreads();
      f32x16 a2[2];
      zero16(a2[0]);
      zero16(a2[1]);
      UNROLL for (int ks = 0; ks < 8; ++ks) {
        bf16x8 af = *(const bf16x8*)(smem + (32 * w + l31) * 272 + ks * 32 + hh * 16);
        bf16x8 b0 = *(const bf16x8*)(W2 + (size_t)(l31) * 128 + ks * 16 + hh * 8);
        bf16x8 b1 = *(const bf16x8*)(W2 + (size_t)(32 + l31) * 128 + ks * 16 + hh * 8);
        a2[0] = MFMA(af, b0, a2[0]);
        a2[1] = MFMA(af, b1, a2[1]);
      }
      UNROLL for (int ni = 0; ni < 2; ++ni) UNROLL for (int i = 0; i < 16; ++i) {
        const int c = mt * 128 + 32 * w + 8 * (i >> 2) + 4 * hh + (i & 3);
        dst[(size_t)c * 64 + ni * 32 + l31] = (c == 255) ? (u16)0 : f2bf(a2[ni][i]);
      }
      __syncthreads();
  }
  const int nw_small = nvb() > 128 ? nvb() - 64 : nvb();
  const int vb_small = nvb() > 128 ? vbid() - 64 : vbid();
  for (int task = vb_small; task >= 0 && task < 1536; task += nw_small) {
    char* wsz = p.ws + lz();
    f32x16 acc[2][2];
    UNROLL for (int a = 0; a < 2; ++a) UNROLL for (int b = 0; b < 2; ++b) zero16(acc[a][b]);
      const int tt = task, tm = tt / 6, tn = tt % 6;
      const u16* A = (const u16*)(wsz + OFF_CQ) + (size_t)tm * 128 * 256;
      {
        const int r = tid >> 1, hf = tid & 1;
        const u16* ar = A + (size_t)r * 256 + hf * 128;
        float ss = 0.f;
        UNROLL for (int c = 0; c < 16; ++c) {
          u32x4 v = *(const u32x4*)(ar + c * 8);
          UNROLL for (int e = 0; e < 4; ++e) {
            const float lo = __uint_as_float(v[e] << 16), hi = __uint_as_float(v[e] & 0xffff0000u);
            ss += lo * lo + hi * hi;
          }
        }
        ss += __shfl_xor(ss, 1);
        if (hf == 0) rstd[r] = rsqrtf(ss * (1.f / 256.f) + 1e-6f);
      }
      gemm_main(A, 256, WL + W_UQ + (size_t)tn * 128 * 256, 256, 256, acc, smem);
      u16* QM = (u16*)(wsz + OFF_QM);
      UNROLL for (int mi = 0; mi < 2; ++mi) UNROLL for (int ni = 0; ni < 2; ++ni) UNROLL for (int i = 0; i < 16; ++i) {
        const int r = EROW(mi, i), row = tm * 128 + r;
        float v = acc[mi][ni][i] * rstd[r];
        const float pr = __shfl_xor(v, 16);
        if (tn >= 4) {
          const int t = row & (T - 1);
          const float cs = COSM[t * 16 + (l31 & 15)], sn = SINM[t * 16 + (l31 & 15)];
          v = (l31 < 16) ? (v * cs - pr * sn) : (v * cs + pr * sn);
        }
        QM[(size_t)row * 768 + tn * 128 + wc * 64 + ni * 32 + l31] = f2bf(v);
      }
      __syncthreads();
  }
  for (int task = vb_small; task >= 0 && task < 2048; task += nw_small) {
    char* wsz = p.ws + lz();
    f32x16 acc[2][2];
    UNROLL for (int a = 0; a < 2; ++a) UNROLL for (int b = 0; b < 2; ++b) zero16(acc[a][b]);
      const int tt = task, tm = tt >> 3, tn = tt & 7;
      const u16* A = (const u16*)(wsz + OFF_CKV) + (size_t)tm * 128 * 128;
      {
        const int r = tid >> 1, hf = tid & 1;
        const u16* ar = A + (size_t)r * 128 + hf * 64;
        float ss = 0.f;
        UNROLL for (int c = 0; c < 8; ++c) {
          u32x4 v = *(const u32x4*)(ar + c * 8);
          UNROLL for (int e = 0; e < 4; ++e) {
            const float lo = __uint_as_float(v[e] << 16), hi = __uint_as_float(v[e] & 0xffff0000u);
            ss += lo * lo + hi * hi;
          }
        }
        ss += __shfl_xor(ss, 1);
        if (hf == 0) rstd[r] = rsqrtf(ss * (1.f / 128.f) + 1e-6f);
      }
      gemm_main(A, 128, WL + W_UKV + (size_t)tn * 128 * 128, 128, 128, acc, smem);
      u16* dst = (u16*)(wsz + (wc == 0 ? OFF_KM : OFF_VM));
      UNROLL for (int mi = 0; mi < 2; ++mi) UNROLL for (int ni = 0; ni < 2; ++ni) UNROLL for (int i = 0; i < 16; ++i) {
        const int r = EROW(mi, i), row = tm * 128 + r;
        const int t = row & (T - 1), b = row >> 12;
        dst[((size_t)(b * 8 + tn) * T + t) * 64 + ni * 32 + l31] = f2bf(acc[mi][ni][i] * rstd[r]);
      }
      __syncthreads();
  }
}

template <int NKS, int KSTR, int MODE, int NREG>
DI void attn_tile(const char* sK, const char* sV, const bf16x8 (&qf)[2][4], const char* qlds, f32x16 (&o)[2][2],
                  float (&mrun)[2], float (&lrun)[2], float sl2, int lane, int kbase, const int (&tq)[2],
                  bool need_mask, const bool (&selb)[2]) {
  const int hh = lane >> 5, r = lane & 31;
  const int blk = (lane >> 4) & 1, q4 = (lane & 15) >> 2, p4 = lane & 3;
  const int sw = (q4 >> 1) & 1;
  UNROLL for (int kt2 = 0; kt2 < 2; ++kt2) {
    f32x16 s[2];
    UNROLL for (int i = 0; i < 16; ++i) { s[0][i] = 0.f; s[1][i] = 0.f; }
    {
      const char* pk = sK + (32 * kt2 + r) * KSTR + hh * 16;
      bf16x8 kf[2], qa[2], qb[2];
      kf[0] = *(const bf16x8*)(pk);
      if (0 >= NREG) {
        qa[0] = *(const bf16x8*)(qlds + (0 - NREG) * 1024);
        qb[0] = *(const bf16x8*)(qlds + (NKS - NREG + 0 - NREG) * 1024);
      }
      UNROLL for (int ks = 0; ks < NKS; ++ks) {
        const int cb = ks & 1, nb = cb ^ 1;
        if (ks + 1 < NKS) {
          kf[nb] = *(const bf16x8*)(pk + (ks + 1) * 32);
          if (ks + 1 >= NREG) {
            qa[nb] = *(const bf16x8*)(qlds + (ks + 1 - NREG) * 1024);
            qb[nb] = *(const bf16x8*)(qlds + (NKS - NREG + ks + 1 - NREG) * 1024);
          }
        }
        __builtin_amdgcn_sched_barrier(0);
        if (ks >= NREG) {
          s[0] = MFMA(kf[cb], qa[cb], s[0]);
          s[1] = MFMA(kf[cb], qb[cb], s[1]);
        } else {
          s[0] = MFMA(kf[cb], qf[0][ks < 4 ? ks : 0], s[0]);
          s[1] = MFMA(kf[cb], qf[1][ks < 4 ? ks : 0], s[1]);
        }
        __builtin_amdgcn_sched_barrier(0);
      }
    }
    UNROLL for (int qt = 0; qt < 2; ++qt) {
      float mx = NEGR;
      if (need_mask) {
        const int lim = tq[qt] - kbase - 4 * hh;
        UNROLL for (int i = 0; i < 16; ++i) {
          const int kc = 32 * kt2 + 8 * (i >> 2) + (i & 3);
          bool ok = kc <= lim;
          if (MODE == 2) ok = ok && (kc > lim - 512);
          if (MODE == 1) ok = ok && selb[qt];
          const float x = ok ? s[qt][i] : NEGR;
          s[qt][i] = x;
          mx = fmaxf(mx, x);
        }
      } else {
        UNROLL for (int i = 0; i < 16; ++i) mx = fmaxf(mx, s[qt][i]);
      }
      mx = xh_max(mx);
      const float mnew = fmaxf(mrun[qt], mx * sl2);
      if (__builtin_amdgcn_ballot_w64(mnew != mrun[qt]) != 0ull) {
        const float alpha = ex2(mrun[qt] - mnew);
        mrun[qt] = mnew;
        lrun[qt] *= alpha;
        UNROLL for (int dt = 0; dt < 2; ++dt) UNROLL for (int i = 0; i < 16; ++i) o[qt][dt][i] *= alpha;
      }
      float ls = 0.f;
      const float nbias = (MODE == 1 && !selb[qt]) ? (-mnew - 20000.f) : -mnew;
      UNROLL for (int i = 0; i < 16; ++i) {
        const float pv = ex2(__builtin_fmaf(s[qt][i], sl2, nbias));
        s[qt][i] = pv;
        ls += pv;
      }
      lrun[qt] += ls;
    }
    {
      bf16x8 pf0[2], pf1[2];
      pf0[0] = pack8(s[0], 0); pf1[0] = pack8(s[1], 0);
      pf0[1] = pack8(s[0], 1); pf1[1] = pack8(s[1], 1);
      s16x4 lo[2], hi[2];
      const char* pvb = sV + (32 * kt2 + 4 * hh + q4) * 128 + (16 * blk + 4 * p4) * 2;
      lo[0] = tr_read(pvb + ((0 ^ sw) * 64));
      hi[0] = tr_read(pvb + ((0 ^ sw) * 64) + 8 * 128);
      UNROLL for (int c = 0; c < 4; ++c) {
        const int st = c >> 1, dt = c & 1, cb = c & 1, nb = cb ^ 1;
        if (c + 1 < 4) {
          const int st1 = (c + 1) >> 1, dt1 = (c + 1) & 1;
          lo[nb] = tr_read(pvb + st1 * 16 * 128 + ((dt1 ^ sw) * 64));
          hi[nb] = tr_read(pvb + st1 * 16 * 128 + ((dt1 ^ sw) * 64) + 8 * 128);
        }
        __builtin_amdgcn_sched_barrier(0);
        const bf16x8 vf = __builtin_shufflevector(lo[cb], hi[cb], 0, 1, 2, 3, 4, 5, 6, 7);
        o[0][dt] = MFMA(vf, pf0[st], o[0][dt]);
        o[1][dt] = MFMA(vf, pf1[st], o[1][dt]);
        __builtin_amdgcn_sched_barrier(0);
      }
    }
  }
}

DI void mla_task(const Params& p, int task, char* smem) {
  const int tid = ltid(), lane = tid & 63, w = tid >> 6, l31 = lane & 31, hh = lane >> 5;
  const int qb = 15 - (task >> 6), bh = task & 63, b = bh >> 3, h = bh & 7;
  const int q0 = qb * 256;
  u16* QM = (u16*)(p.ws + OFF_QM);
  const u16* KM = (const u16*)(p.ws + OFF_KM) + (size_t)bh * T * 64;
  const u16* VM = (const u16*)(p.ws + OFF_VM) + (size_t)bh * T * 64;
  const u16* KPE = (const u16*)(p.ws + OFF_KPE) + (size_t)b * T * 32;
  bf16x8 qf[2][4];
  int tq[2];
  const char* qlds = smem + 43008 + w * 4096 + lane * 16;
  UNROLL for (int qt = 0; qt < 2; ++qt) {
    tq[qt] = q0 + 64 * w + 32 * qt + l31;
    const u16* base = QM + (size_t)(b * T + tq[qt]) * 768;
    UNROLL for (int ks = 0; ks < 4; ++ks) qf[qt][ks] = *(const bf16x8*)(base + h * 64 + 16 * ks + 8 * hh);
    UNROLL for (int ks = 0; ks < 2; ++ks)
      *(bf16x8*)(smem + 43008 + w * 4096 + lane * 16 + (qt * 2 + ks) * 1024) = *(const bf16x8*)(base + 512 + h * 32 + 16 * ks + 8 * hh);
  }
  f32x16 o[2][2];
  UNROLL for (int a = 0; a < 2; ++a) UNROLL for (int c = 0; c < 2; ++c) zero16(o[a][c]);
  float mrun[2] = {NEGF, NEGF}, lrun[2] = {0.f, 0.f};
  const bool selb[2] = {true, true};
  const float sl2 = 0.10206207261596575f * LOG2E;
  const int nkt = (q0 >> 6) + 4, my_last = (q0 >> 6) + w;
  u32x4 rk[3], rv[2];
  const unsigned offa = (unsigned)tid * 16u;
  const unsigned offp = (unsigned)tid * 16u;
  auto gload = [&](int kt) {
    const char* kb = (const char*)(KM + (size_t)kt * 4096);
    const char* vb = (const char*)(VM + (size_t)kt * 4096);
    const char* pb = (const char*)(KPE + (size_t)kt * 2048);
    rk[0] = *(const u32x4*)(kb + offa);
    rk[1] = *(const u32x4*)(kb + offa + 4096u);
    rk[2] = *(const u32x4*)(pb + offp);
    rv[0] = *(const u32x4*)(vb + offa);
    rv[1] = *(const u32x4*)(vb + offa + 4096u);
  };
  auto sstore = [&](int s) {
    UNROLL for (int i = 0; i < 2; ++i) {
      const int c = tid + 256 * i, key = c >> 3, ch = c & 7;
      *(u32x4*)(smem + s * 13312 + key * 208 + ch * 16) = rk[i];
      *(u32x4*)(smem + 26624 + s * 8192 + key * 128 + ((ch ^ (4 * ((key >> 1) & 1))) * 16)) = rv[i];
    }
    *(u32x4*)(smem + s * 13312 + (tid >> 2) * 208 + 128 + (tid & 3) * 16) = rk[2];
  };
  gload(0);
  sstore(0);
  __syncthreads();
  _Pragma("unroll 1") for (int kt = 0; kt < nkt; ++kt) {
    const bool more = kt + 1 < nkt;
    if (more) gload(kt + 1);
    if (kt <= my_last) {
      const bool need_mask = (64 * kt + 63 > q0 + 64 * w);
      attn_tile<6, 208, 0, 4>(smem + (kt & 1) * 13312, smem + 26624 + (kt & 1) * 8192, qf, qlds, o, mrun, lrun, sl2, lane,
                           64 * kt, tq, need_mask, selb);
    }
    if (more) sstore((kt + 1) & 1);
    __syncthreads();
  }
  UNROLL for (int qt = 0; qt < 2; ++qt) {
    const float lt = xh_sum(lrun[qt]);
    const float inv = __builtin_amdgcn_rcpf(lt);
    u16* dst = (u16*)(p.ws + OFF_OM) + (size_t)(b * T + tq[qt]) * 512 + h * 64;
    UNROLL for (int dt = 0; dt < 2; ++dt) UNROLL for (int g4 = 0; g4 < 4; ++g4) {
      u32x2 v;
      v[0] = pk2(o[qt][dt][4 * g4 + 0] * inv, o[qt][dt][4 * g4 + 1] * inv);
      v[1] = pk2(o[qt][dt][4 * g4 + 2] * inv, o[qt][dt][4 * g4 + 3] * inv);
      *(u32x2*)(dst + 32 * dt + 8 * g4 + 4 * hh) = v;
    }
  }
}

template <int MODE>
DI void nsa_flash(const u16* __restrict__ Kg, const u16* __restrict__ Vg, int kt_lo, int kt_hi, int cur,
                  f32x16 (&o)[2][2], float (&mrun)[2], float (&lrun)[2], float sl2,
                  const int (&tq)[2], char* smem) {
  const bf16x8 qdummy[2][4] = {};
  const char* qlds = smem + 36864 + (ltid() >> 6) * 8192 + (ltid() & 63) * 16;
  const int tid = ltid(), lane = tid & 63;
  const unsigned* selw = (const unsigned*)(smem + 69632 + 8192);
  u32x4 rk[2], rv[2];
  const unsigned offa = (unsigned)tid * 16u;
  auto gload = [&](int kt) {
    const char* kb = (const char*)(Kg + (size_t)kt * 4096);
    const char* vb = (const char*)(Vg + (size_t)kt * 4096);
    rk[0] = *(const u32x4*)(kb + offa);
    rk[1] = *(const u32x4*)(kb + offa + 4096u);
    rv[0] = *(const u32x4*)(vb + offa);
    rv[1] = *(const u32x4*)(vb + offa + 4096u);
  };
  auto sstore = [&](int s) {
    UNROLL for (int i = 0; i < 2; ++i) {
      const int c = tid + 256 * i, key = c >> 3, ch = c & 7;
      *(u32x4*)(smem + s * 9216 + key * 144 + ch * 16) = rk[i];
      *(u32x4*)(smem + 18432 + s * 8192 + key * 128 + ((ch ^ (4 * ((key >> 1) & 1))) * 16)) = rv[i];
    }
  };
  gload(kt_lo);
  sstore(0);
  __syncthreads();
  _Pragma("unroll 1") for (int kt = kt_lo; kt <= kt_hi; ++kt) {
    const int s = (kt - kt_lo) & 1;
    const bool more = kt < kt_hi;
    if (more) gload(kt + 1);
    bool selb[2] = {true, true};
    if (MODE == 1) {
      selb[0] = (selw[(tq[0] & 63) * 2 + (kt >> 5)] >> (kt & 31)) & 1u;
      selb[1] = (selw[(tq[1] & 63) * 2 + (kt >> 5)] >> (kt & 31)) & 1u;
    }
    const bool need_mask = (kt == cur) || (MODE == 2 && kt == cur - 8);
    attn_tile<4, 144, MODE, 0>(smem + s * 9216, smem + 18432 + s * 8192, qdummy, qlds, o, mrun, lrun, sl2, lane,
                                  64 * kt, tq, need_mask, selb);
    if (more) sstore(s ^ 1);
    __syncthreads();
  }
}

DI void nsa_task(const Params& p, int task, char* smem) {
  const int tid = ltid(), lane = tid & 63, w = tid >> 6, l31 = lane & 31, hh = lane >> 5;
  const int cur = 63 - (task >> 4), bg = task & 15, b = bg >> 1, g = bg & 1;
  u16* QN = (u16*)(p.ws + OFF_QN);
  const u16* KV6 = (const u16*)(p.ws + OFF_KV6);
  const float* GATES = (const float*)(p.ws + OFF_GATES);
  const u16* KC = (const u16*)(p.ws + OFF_KC) + (size_t)bg * 256 * 64;
  const u16* VC = (const u16*)(p.ws + OFF_VC) + (size_t)bg * 256 * 64;
  const int head = 4 * g + (l31 & 3);
  bf16x8 qf[2][4];
  int tq[2];
  UNROLL for (int qt = 0; qt < 2; ++qt) {
    tq[qt] = 64 * cur + 16 * w + 8 * qt + (l31 >> 2);
    const u16* base = QN + (size_t)(b * T + tq[qt]) * 512 + head * 64;
    UNROLL for (int ks = 0; ks < 4; ++ks) qf[qt][ks] = *(const bf16x8*)(base + 16 * ks + 8 * hh);
  }
  const float sl2 = 0.125f * LOG2E;
  unsigned long long* selm = (unsigned long long*)(smem + 69632 + 8192);
  char* R1 = smem;
  char* R2 = smem + 36864;
  float* impw = (float*)(smem + 69632) + w * 512;
  {
    const int cmax_blk = (64 * cur + 63 - 31) >> 4;
    UNROLL for (int i = 0; i < 8; ++i) if (32 * i <= cmax_blk) {
      const int c = tid + 256 * i, key = c >> 3, ch = c & 7;
      u32x4 kk = *(const u32x4*)(KC + (size_t)c * 8);
      u32x4 vv = *(const u32x4*)(VC + (size_t)c * 8);
      *(u32x4*)(R1 + (key >> 6) * 9216 + (key & 63) * 144 + ch * 16) = kk;
      *(u32x4*)(R2 + (key >> 6) * 8192 + (key & 63) * 128 + ((ch ^ (4 * ((key >> 1) & 1))) * 16)) = vv;
    }
    __syncthreads();
    const int blk = (lane >> 4) & 1, q4 = (lane & 15) >> 2, p4 = lane & 3, sw = (q4 >> 1) & 1;
    UNROLL for (int qt = 0; qt < 2; ++qt) {
      const int cmh = ((tq[qt] - 31) >> 4) - 4 * hh;
      const int cmax_u = (64 * cur + 16 * __builtin_amdgcn_readfirstlane(w) + 8 * qt + 7 - 31) >> 4;
      float mx = NEGF, lsum = 0.f;
      UNROLL for (int a = 0; a < 8; ++a) if (32 * a <= cmax_u) {
        f32x16 sa;
        zero16(sa);
        const char* pk = R1 + (a >> 1) * 9216 + (32 * (a & 1) + l31) * 144 + hh * 16;
        {
          bf16x8 kf4[4];
          UNROLL for (int ks = 0; ks < 4; ++ks) kf4[ks] = *(const bf16x8*)(pk + ks * 32);
          __builtin_amdgcn_sched_barrier(0);
          UNROLL for (int ks = 0; ks < 4; ++ks) sa = MFMA(kf4[ks], qf[qt][ks], sa);
        }
        float tm = NEGF;
        UNROLL for (int i = 0; i < 16; ++i) {
          const int c = 32 * a + 8 * (i >> 2) + (i & 3);
          const float x = (c <= cmh) ? sa[i] * sl2 : NEGF;
          sa[i] = x;
          tm = fmaxf(tm, x);
        }
        const float mnew = fmaxf(mx, tm);
        float ts = 0.f;
        UNROLL for (int i = 0; i < 16; ++i) ts += ex2(sa[i] - mnew);
        lsum = lsum * ex2(mx - mnew) + ts;
        mx = mnew;
        __builtin_amdgcn_sched_barrier(0);
      }
      {
        const float mo = xh_get(mx, hh), lo = xh_get(lsum, hh);
        const float mt = fmaxf(mx, mo);
        lsum = lsum * ex2(mx - mt) + lo * ex2(mo - mt);
        mx = mt;
      }
      const float inv = (mx > -1e29f) ? 1.f / lsum : 0.f;
      float lastprev = 0.f;
      f32x16 oc[2];
      zero16(oc[0]);
      zero16(oc[1]);
      UNROLL for (int a = 0; a < 8; ++a) if (32 * a <= cmax_u) {
        f32x16 sa;
        zero16(sa);
        const char* pk = R1 + (a >> 1) * 9216 + (32 * (a & 1) + l31) * 144 + hh * 16;
        {
          bf16x8 kf4[4];
          UNROLL for (int ks = 0; ks < 4; ++ks) kf4[ks] = *(const bf16x8*)(pk + ks * 32);
          __builtin_amdgcn_sched_barrier(0);
          UNROLL for (int ks = 0; ks < 4; ++ks) sa = MFMA(kf4[ks], qf[qt][ks], sa);
        }
        UNROLL for (int i = 0; i < 16; ++i) {
          const int c = 32 * a + 8 * (i >> 2) + (i & 3);
          sa[i] = (c <= cmh) ? ex2(sa[i] * sl2 - mx) * inv : 0.f;
        }
        UNROLL for (int q = 0; q < 4; ++q) {
          const int gi = 4 * a + q;
          const float g4 = sa[4 * q] + sa[4 * q + 1] + sa[4 * q + 2] + sa[4 * q + 3];
          const float lastcur = sa[4 * q + 3];
          const float tosend = hh ? lastprev : lastcur;
          const float recv = xh_get(tosend, hh);
          const float im = quad_sum(g4 + recv);
          if ((l31 & 3) == (gi & 3)) impw[(l31 >> 2) * 64 + 2 * gi + hh] = im;
          lastprev = lastcur;
        }
        {
          s16x4 vlo[4], vhi[4];
          UNROLL for (int c = 0; c < 4; ++c) {
            const int st = c >> 1, dt = c & 1;
            const char* pv = R2 + (a >> 1) * 8192 + (32 * (a & 1) + 16 * st + 4 * hh + q4) * 128 + ((dt ^ sw) * 64) + (16 * blk + 4 * p4) * 2;
            vlo[c] = tr_read(pv);
            vhi[c] = tr_read(pv + 8 * 128);
          }
          const bf16x8 pfa = pack8(sa, 0), pfb = pack8(sa, 1);
          __builtin_amdgcn_sched_barrier(0);
          UNROLL for (int c = 0; c < 4; ++c) {
            const bf16x8 vf = __builtin_shufflevector(vlo[c], vhi[c], 0, 1, 2, 3, 4, 5, 6, 7);
            oc[c & 1] = MFMA(vf, (c >> 1) ? pfb : pfa, oc[c & 1]);
          }
        }
        __builtin_amdgcn_sched_barrier(0);
      }
      __syncthreads();
      if (cur >= 16) {
        unsigned* keyw = (unsigned*)impw;
        UNROLL for (int t8 = 0; t8 < 8; ++t8) {
          const float v = impw[t8 * 64 + lane];
          const int j = lane;
          unsigned key = (__float_as_uint(v) & ~63u) | (unsigned)(63 - j);
          if (j == 0 || j == cur || j == cur - 1) key = 0x7f800000u | (unsigned)(63 - j);
          else if (j > cur) key = (unsigned)(63 - j);
          keyw[t8 * 64 + lane] = key;
        }
        __syncthreads();
        _Pragma("unroll 1") for (int t8 = 0; t8 < 8; ++t8) {
          const unsigned key = keyw[t8 * 64 + lane];
          int rank = 0;
          UNROLL for (int c4 = 0; c4 < 16; ++c4) {
            const u32x4 kk = *(const u32x4*)(keyw + t8 * 64 + c4 * 4);
            rank += (kk[0] > key) ? 1 : 0;
            rank += (kk[1] > key) ? 1 : 0;
            rank += (kk[2] > key) ? 1 : 0;
            rank += (kk[3] > key) ? 1 : 0;
          }
          const unsigned long long mk = __ballot(rank < 16);
          if (lane == 0) selm[16 * w + 8 * qt + t8] = mk;
        }
      } else {
        if (lane < 8) selm[16 * w + 8 * qt + lane] = ~0ull;
      }
      __syncthreads();
      int zq = 0;
      asm volatile("" : "+v"(zq));
      const int rowq = b * T + tq[qt] + zq;
      const float g0 = GATES[(size_t)rowq * 24 + head * 3 + 0];
      u16* dst = (u16*)(p.ws + OFF_ON) + (size_t)rowq * 512 + head * 64;
      UNROLL for (int dt = 0; dt < 2; ++dt) UNROLL for (int g4 = 0; g4 < 4; ++g4) {
        u32x2 v;
        v[0] = pk2(oc[dt][4 * g4 + 0] * g0, oc[dt][4 * g4 + 1] * g0);
        v[1] = pk2(oc[dt][4 * g4 + 2] * g0, oc[dt][4 * g4 + 3] * g0);
        *(u32x2*)(dst + 32 * dt + 8 * g4 + 4 * hh) = v;
      }
    }
    __syncthreads();
  }
  {
    char* qdst = smem + 36864 + w * 8192 + lane * 16;
    UNROLL for (int qt = 0; qt < 2; ++qt) UNROLL for (int ks = 0; ks < 4; ++ks) *(bf16x8*)(qdst + (qt * 4 + ks) * 1024) = qf[qt][ks];
  }
  __syncthreads();
  UNROLL for (int br = 1; br <= 2; ++br) {
    f32x16 o[2][2];
    UNROLL for (int a = 0; a < 2; ++a) UNROLL for (int c = 0; c < 2; ++c) zero16(o[a][c]);
    float mrun[2] = {NEGF, NEGF}, lrun[2] = {0.f, 0.f};
    const u16* Kg = KV6 + ((size_t)((2 * br) * 16 + bg) * T) * 64;
    const u16* Vg = KV6 + ((size_t)((2 * br + 1) * 16 + bg) * T) * 64;
    if (br == 1) nsa_flash<1>(Kg, Vg, 0, cur, cur, o, mrun, lrun, sl2, tq, smem);
    else nsa_flash<2>(Kg, Vg, cur > 8 ? cur - 8 : 0, cur, cur, o, mrun, lrun, sl2, tq, smem);
    UNROLL for (int qt = 0; qt < 2; ++qt) {
      const float lt = xh_sum(lrun[qt]);
      int zq = 0;
      asm volatile("" : "+v"(zq));
      const int rowq = b * T + tq[qt] + zq;
      const float gt = GATES[(size_t)rowq * 24 + head * 3 + br];
      const float inv = gt * __builtin_amdgcn_rcpf(lt);
      u16* dst = (u16*)(p.ws + OFF_ON) + (size_t)rowq * 512 + head * 64;
      UNROLL for (int dt = 0; dt < 2; ++dt) UNROLL for (int g4 = 0; g4 < 4; ++g4) {
        u32x2* pd = (u32x2*)(dst + 32 * dt + 8 * g4 + 4 * hh);
        const u32x2 old = *pd;
        u32x2 v;
        v[0] = pk2(o[qt][dt][4 * g4 + 0] * inv + __uint_as_float(old[0] << 16),
                   o[qt][dt][4 * g4 + 1] * inv + __uint_as_float(old[0] & 0xffff0000u));
        v[1] = pk2(o[qt][dt][4 * g4 + 2] * inv + __uint_as_float(old[1] << 16),
                   o[qt][dt][4 * g4 + 3] * inv + __uint_as_float(old[1] & 0xffff0000u));
        *pd = v;
      }
    }
  }
}

DI void phase_attn(const Params& p, int layer, char* smem, char* smem_blk) {
  int* cnt = (int*)(p.ws + OFF_CNT) + layer;
  int* s_task = (int*)(smem_blk + 2 * VSMEM);
  const int half = vhalf();
  for (;;) {
    if (__builtin_amdgcn_workitem_id_x() == 0) *s_task = atomicAdd(cnt, 2);
    __syncthreads();
    const int task = *s_task + half;
    __syncthreads();
    if (task >= 2048) break;
    if (task < 1024) mla_task(p, task, smem);
    else nsa_task(p, task - 1024, smem);
  }
}

DI void phase_proj(const Params& p, int layer, char* smem) {
  EPI_VARS
  const u16* WL = (const u16*)(p.ws + OFF_W) + (size_t)layer * W_LAYER;
  const u16* OM = (const u16*)(p.ws + OFF_OM);
  const u16* ON = (const u16*)(p.ws + OFF_ON);
  const u16* GM = (const u16*)(p.ws + OFF_GM);
  const u16* GN = (const u16*)(p.ws + OFF_GN);
  u16* Yb = (u16*)(p.ws + OFF_XB);
  const int ntn = 8, ntiles = 256 * ntn;
  for (int tile = vbid(); tile < ntiles; tile += nvb()) {
    const int tm = tile / ntn, tn = tile % ntn;
    f32x16 acc[2][2];
    UNROLL for (int a = 0; a < 2; ++a) UNROLL for (int b = 0; b < 2; ++b) zero16(acc[a][b]);
    gemm_main(OM + (size_t)tm * 128 * 512, 512, WL + W_PM + (size_t)tn * 128 * 512, 512, 512, acc, smem);
    {
      int z1 = 0;
      asm volatile("" : "+v"(z1)::"memory");
      UNROLL for (int mi = 0; mi < 2; ++mi) UNROLL for (int ni = 0; ni < 2; ++ni) UNROLL for (int i = 0; i < 16; ++i) {
        if ((i & 3) == 0) asm volatile("" ::: "memory");
        const int row = tm * 128 + EROW(mi, i) + z1;
        const size_t idx = (size_t)row * 1024 + tn * 128 + wc * 64 + ni * 32 + l31;
        acc[mi][ni][i] *= bf2f(GM[idx]) * __builtin_amdgcn_rcpf(bf2f(GN[idx]));
      }
    }
    gemm_main(ON + (size_t)tm * 128 * 512, 512, WL + W_PN + (size_t)tn * 128 * 512, 512, 512, acc, smem);
    int z2 = 0;
    asm volatile("" : "+v"(z2)::"memory");
    UNROLL for (int mi = 0; mi < 2; ++mi) UNROLL for (int ni = 0; ni < 2; ++ni) UNROLL for (int i = 0; i < 16; ++i) {
      const int row = tm * 128 + EROW(mi, i) + z2;
      const size_t idx = (size_t)row * 1024 + tn * 128 + wc * 64 + ni * 32 + l31;
      if ((i & 3) == 0) asm volatile("" ::: "memory");
      const float y = bf2f(GN[idx]) * acc[mi][ni][i];
      Yb[idx] = f2bf(y);
    }
  }
}

#define XB_TMO      128
#define XB_XCNT(j)  (256  + 64 * (j))
#define XB_XSUB(j)  (1280 + 64 * (j))
#define XB_XGEN(j)  (2304 + 64 * (j))
#define XB_TOP      3328
#define XB_TOPGEN   3392
#define XCD_BAR_WORDS 3456
#define XB_SPIN_CAP (1u << 18)
#define LAS __attribute__((address_space(3)))

__device__ __forceinline__ unsigned xb_ld(unsigned* p)              { return __hip_atomic_load(p, __ATOMIC_RELAXED, __HIP_MEMORY_SCOPE_AGENT); }
__device__ __forceinline__ unsigned xb_add(unsigned* p, unsigned v) { return __hip_atomic_fetch_add(p, v, __ATOMIC_RELAXED, __HIP_MEMORY_SCOPE_AGENT); }
__device__ __forceinline__ unsigned xb_xcc_id() { return (unsigned)__builtin_amdgcn_s_getreg((3 << 11) | 20) & 0xFu; }
#define XB_SPIN(cond, bar) do { unsigned _sp = 0; while (cond) { __builtin_amdgcn_s_sleep(1); \
    if ((++_sp & 255u) == 0u) { if (xb_ld(&(bar)[XB_TMO])) break; if (_sp > XB_SPIN_CAP) { atomicAdd(&(bar)[XB_TMO], 1u); break; } } } } while (0)

struct XcdBarrier {
    unsigned* bar; unsigned x;
    volatile LAS unsigned* st;
};

__device__ __forceinline__ XcdBarrier xcd_barrier_post(unsigned* bar, volatile LAS unsigned* st) {
    XcdBarrier b; b.bar = bar; b.x = xb_xcc_id(); b.st = st;
    if (threadIdx.x == 0) (void)xb_add(&bar[XB_XCNT(b.x)], 1u);
    return b;
}
__device__ __forceinline__ void xcd_barrier_complete(unsigned* bar, unsigned x, unsigned& nloc, unsigned& nx) {
    const unsigned G = gridDim.x * gridDim.y * gridDim.z;
    unsigned sum, cnt, mine, sp = 0u;
    for (;;) {
        sum = 0u; cnt = 0u; mine = 0u;
#pragma unroll
        for (unsigned j = 0; j < 16; ++j) { const unsigned c = xb_ld(&bar[XB_XCNT(j)]); sum += c; cnt += (c > 0u) ? 1u : 0u; mine = (j == x) ? c : mine; }
        if (sum == G) break;
        __builtin_amdgcn_s_sleep(1);
        if ((++sp & 255u) == 0u) { if (xb_ld(&bar[XB_TMO])) break; if (sp > XB_SPIN_CAP) { atomicAdd(&bar[XB_TMO], 1u); break; } }
    }
    nloc = mine > 0u ? mine : 1u; nx = cnt > 0u ? cnt : 1u;
}

__device__ __forceinline__ void xcd_barrier(const XcdBarrier& b) {
    asm volatile("s_waitcnt vmcnt(0)" ::: "memory");
    __syncthreads();
    if (threadIdx.x == 0) {
        unsigned* bar = b.bar;
        __builtin_amdgcn_s_waitcnt(0);
        unsigned nloc = b.st[0], nx = b.st[1];
        if (nloc == 0u) { xcd_barrier_complete(bar, b.x, nloc, nx); b.st[0] = nloc; b.st[1] = nx; }
        const unsigned old = xb_add(&bar[XB_XSUB(b.x)], 1u);
        const unsigned gen = old / nloc;
        if (old + 1u == (gen + 1u) * nloc) {
            __builtin_amdgcn_fence(__ATOMIC_RELEASE, "agent");
            asm volatile("s_waitcnt vmcnt(0)" ::: "memory");
            const unsigned og = xb_add(&bar[XB_TOP], 1u);
            const unsigned tg = og / nx;
            if (og + 1u == (tg + 1u) * nx) xb_add(&bar[XB_TOPGEN], 1u);
            else XB_SPIN(xb_ld(&bar[XB_TOPGEN]) == tg, bar);
            __builtin_amdgcn_fence(__ATOMIC_ACQUIRE, "agent");
            xb_add(&bar[XB_XGEN(b.x)], 1u);
            asm volatile("s_waitcnt vmcnt(0)" ::: "memory");
        } else {
            XB_SPIN(xb_ld(&bar[XB_XGEN(b.x)]) == gen, bar);
            __builtin_amdgcn_fence(__ATOMIC_ACQUIRE, "agent");
            asm volatile("s_waitcnt vmcnt(0)" ::: "memory");
        }
    }
    __syncthreads();
}

#define GSYNC xcd_barrier(xb)
#define LAYER(layer)                                                                                              \
  {                                                                                                               \
    const u16* WL = (const u16*)(p.ws + OFF_W) + (size_t)(layer) * W_LAYER;                                       \
    const u16* XB = (const u16*)(p.ws + OFF_XB);                                                                  \
    const u16* HB = (const u16*)(p.ws + OFF_H);                                                                   \
    big_gemm(XB, WL + W_UP1, 5632, 1024, EpiSwiglu{(u16*)(p.ws + OFF_H)}, smem_blk); GSYNC;                       \
    big_gemm<true, true>(HB, WL + W_DN1, 1024, FF, EpiResid{(layer) == 0 ? p.in[0] : p.out, p.out, 0.5f}, smem_blk); GSYNC;                                   \
    bias_reduce(p); phase_ln(p, p.in[1] + (layer) * DM, p.in[2] + (layer) * DM); GSYNC;                                          \
    big_gemm(XB, WL + W_IN, 3840, 1024, EpiWin{p.ws}, smem_blk); GSYNC;                                           \
    phase_up_cmp(p, layer, smem); GSYNC;                                                                          \
    phase_attn(p, layer, smem, smem_blk); GSYNC;                                                                  \
    big_gemm((const u16*)(p.ws + OFF_OM), WL + W_PM, 1024, 512, EpiGate1{(u16*)(p.ws + OFF_GM)}, smem_blk); GSYNC; big_gemm((const u16*)(p.ws + OFF_ON), WL + W_PN, 1024, 512, EpiGate2{(const u16*)(p.ws + OFF_GM), (const u16*)(p.ws + OFF_GN), (u16*)(p.ws + OFF_XB)}, smem_blk); GSYNC;                                                                           \
    big_gemm(XB, WL + W_OUT, 1024, 1024, EpiResid{p.out, p.out, 1.0f}, smem_blk); GSYNC;        \
    phase_ln(p, p.in[22] + (layer) * DM, p.in[23] + (layer) * DM); GSYNC;                                         \
    big_gemm(XB, WL + W_UP2, 5632, 1024, EpiSwiglu{(u16*)(p.ws + OFF_H)}, smem_blk); GSYNC;                       \
    big_gemm<true, true>(HB, WL + W_DN2, 1024, FF, EpiResid{p.out, p.out, 0.5f}, smem_blk); GSYNC;                                   \
    if ((layer) == 1) phase_ln<false>(p, p.in[27] + (layer) * DM, p.in[28] + (layer) * DM);                       \
    else phase_ln(p, p.in[27] + (layer) * DM, p.in[28] + (layer) * DM);                                           \
  }

__global__ void __launch_bounds__(512, 2) mega(Params p) {
  __shared__ __attribute__((aligned(16))) char smem_blk[SMEM_BYTES];
  char* smem = smem_blk + vhalf() * VSMEM;
  cg::grid_group grid = cg::this_grid();
  volatile LAS unsigned* st = (volatile LAS unsigned*)(smem_blk + 2 * VSMEM + 16);
  if (threadIdx.x == 0) { st[0] = 0u; st[1] = 0u; }
  __syncthreads();
  const XcdBarrier xb = xcd_barrier_post((unsigned*)(p.ws + OFF_BAR), st);
  phase_init(p, smem);
  if (p.ws == nullptr) grid.sync();
  GSYNC;
  LAYER(0)
  GSYNC;
  LAYER(1)
}

extern "C" void kernel_launch(void* const* d_in, const int* in_sizes, int n_in, void* d_out, int out_size, void* d_ws,
                              size_t ws_size, hipStream_t stream) {
  Params p{};
  for (int i = 0; i < 29; ++i) p.in[i] = (const float*)d_in[i];
  p.out = (float*)d_out;
  p.ws = (char*)d_ws;
  if (ws_size < WS_NEED) fprintf(stderr, "workspace too small: %zu < %zu\n", ws_size, (size_t)WS_NEED);
  static int grid_blocks = 0;
  if (!grid_blocks) {
    int dev = 0, cus = 0, per_cu = 0;
    hipGetDevice(&dev);
    hipDeviceGetAttribute(&cus, hipDeviceAttributeMultiprocessorCount, dev);
    hipOccupancyMaxActiveBlocksPerMultiprocessor(&per_cu, mega, 512, 0);
    if (per_cu < 1) per_cu = 1;
    if (per_cu > 1) per_cu = 1;
    grid_blocks = cus * per_cu;
  }
  (void)hipMemsetAsync((char*)d_ws + OFF_BAR, 0, XCD_BAR_WORDS * 4, stream);
  void* args[] = {&p};
  hipError_t e = hipLaunchCooperativeKernel((void*)mega, dim3(grid_blocks), dim3(512), args, 0, stream);
  if (e != hipSuccess) fprintf(stderr, "cooperative launch failed: %s (grid %d)\n", hipGetErrorString(e), grid_blocks);
}
```

```cpp
#include <hip/hip_runtime.h>
#include <hip/hip_cooperative_groups.h>
#include <stdint.h>
#include <stdio.h>
namespace cg = cooperative_groups;

#ifndef MULTI
#define MULTI 0
#endif

typedef unsigned short u16;
typedef __attribute__((ext_vector_type(8))) short bf16x8;
typedef __attribute__((ext_vector_type(4))) short s16x4;
typedef __attribute__((ext_vector_type(16))) float f32x16;
typedef __attribute__((ext_vector_type(4))) unsigned u32x4;
typedef __attribute__((ext_vector_type(2))) unsigned u32x2;
typedef __attribute__((ext_vector_type(2))) __bf16 bf2_t;
#define DI __device__ __forceinline__
#define MFMA(a, b, c) __builtin_amdgcn_mfma_f32_32x32x16_bf16((a), (b), (c), 0, 0, 0)
#define UNROLL _Pragma("unroll")

constexpr int NB = 8, T = 4096, DM = 1024, M = NB * T, FF = 2816;
constexpr float ALPHA = 1.4142135623730951f;
constexpr float NEGF = -1e30f;
constexpr float NEGR = -30000.f;
constexpr float LOG2E = 1.4426950408889634f;

constexpr size_t W_UP1 = 0;
constexpr size_t W_DN1 = W_UP1 + (size_t)5632 * 1024;
constexpr size_t W_IN = W_DN1 + (size_t)1024 * 2816;
constexpr size_t W_UQ = W_IN + (size_t)3840 * 1024;
constexpr size_t W_UKV = W_UQ + (size_t)768 * 256;
constexpr size_t W_CK1 = W_UKV + (size_t)1024 * 128;
constexpr size_t W_CK2 = W_CK1 + (size_t)128 * 2048;
constexpr size_t W_CV1 = W_CK2 + (size_t)64 * 128;
constexpr size_t W_CV2 = W_CV1 + (size_t)128 * 2048;
constexpr size_t W_PM = W_CV2 + (size_t)64 * 128;
constexpr size_t W_PN = W_PM + (size_t)1024 * 512;
constexpr size_t W_OUT = W_PN + (size_t)1024 * 512;
constexpr size_t W_UP2 = W_OUT + (size_t)1024 * 1024;
constexpr size_t W_DN2 = W_UP2 + (size_t)5632 * 1024;
constexpr size_t W_LAYER = W_DN2 + (size_t)1024 * 2816;

constexpr size_t al256(size_t x) { return (x + 255) & ~(size_t)255; }
constexpr size_t OFF_W = 0;
constexpr size_t OFF_BIAS = al256(OFF_W + 2 * W_LAYER * 2);
constexpr size_t OFF_COSN = al256(OFF_BIAS + 2 * 2 * 128 * 4);
constexpr size_t OFF_SINN = OFF_COSN + (size_t)T * 8 * 4;
constexpr size_t OFF_COSM = OFF_SINN + (size_t)T * 8 * 4;
constexpr size_t OFF_SINM = OFF_COSM + (size_t)T * 16 * 4;
constexpr size_t OFF_CNT = OFF_SINM + (size_t)T * 16 * 4;
constexpr size_t OFF_BAR = al256(OFF_CNT + 256);
constexpr size_t OFF_PART = al256(OFF_BAR + 3456 * 4);
constexpr size_t OFF_XB = al256(OFF_PART + (size_t)4 * 128 * 128 * 4);
constexpr size_t OFF_KM = OFF_XB;
constexpr size_t OFF_VM = OFF_XB + (size_t)M * 512 * 2;
constexpr size_t OFF_BIG = al256(OFF_XB + (size_t)M * 1024 * 2);
constexpr size_t OFF_H = OFF_BIG;
constexpr size_t OFF_CQ = OFF_BIG;
constexpr size_t OFF_CKV = OFF_CQ + (size_t)M * 256 * 2;
constexpr size_t OFF_QN = OFF_CKV + (size_t)M * 128 * 2;
constexpr size_t OFF_KV6 = OFF_QN + (size_t)M * 512 * 2;
constexpr size_t OFF_KPE = OFF_KV6 + (size_t)6 * M * 128 * 2;
constexpr size_t OFF_GATES = OFF_KPE + (size_t)M * 32 * 2;
constexpr size_t OFF_QM = OFF_GATES + (size_t)M * 24 * 4;
constexpr size_t OFF_GM = OFF_QM + (size_t)M * 768 * 2;
constexpr size_t OFF_GN = OFF_GM + (size_t)M * 1024 * 2;
constexpr size_t OFF_KC = OFF_GN + (size_t)M * 1024 * 2;
constexpr size_t OFF_VC = OFF_KC + (size_t)16 * 256 * 64 * 2;
constexpr size_t OFF_OM = al256(OFF_VC + (size_t)16 * 256 * 64 * 2 + 65536);
constexpr size_t OFF_ON = OFF_OM + (size_t)M * 512 * 2;
constexpr size_t OFF_MIXEND = OFF_ON + (size_t)M * 512 * 2;
constexpr size_t OFF_HEND = OFF_H + (size_t)M * FF * 2;
constexpr size_t WS_NEED = OFF_MIXEND > OFF_HEND ? OFF_MIXEND : OFF_HEND;

constexpr int VSMEM = 69632 + 8192 + 512;
constexpr int SMEM_BYTES = 2 * VSMEM + 64;

struct Params {
  const float* in[29];
  float* out;
  char* ws;
};

DI int ltid() {
  int t = __builtin_amdgcn_workitem_id_x() & 255;
  asm volatile("" : "+v"(t));
  return t;
}
DI size_t lz() {
  size_t z = 0;
  asm volatile("" : "+s"(z));
  return z;
}
DI int vhalf() {
  int t = __builtin_amdgcn_workitem_id_x();
  asm volatile("" : "+v"(t));
  return __builtin_amdgcn_readfirstlane(t >> 8);
}
DI int vbid() { return (int)blockIdx.x * 2 + vhalf(); }
DI int nvb() { return (int)gridDim.x * 2; }
typedef __attribute__((ext_vector_type(4))) float f32x4_nt;
DI float bf2f(u16 h) { return __uint_as_float(((unsigned)h) << 16); }
DI unsigned pk2(float a, float b) {
  bf2_t v;
  v[0] = (__bf16)a;
  v[1] = (__bf16)b;
  return __builtin_bit_cast(unsigned, v);
}
DI u16 f2bf(float a) { return (u16)(pk2(a, 0.f) & 0xffffu); }
DI float ex2(float x) { return __builtin_amdgcn_exp2f(x); }
DI float sigmoidf_(float x) { return __builtin_amdgcn_rcpf(1.f + __expf(-x)); }
DI bf16x8 pack8(const f32x16& v, int st) {
  u32x4 p;
  p[0] = pk2(v[8 * st + 0], v[8 * st + 1]);
  p[1] = pk2(v[8 * st + 2], v[8 * st + 3]);
  p[2] = pk2(v[8 * st + 4], v[8 * st + 5]);
  p[3] = pk2(v[8 * st + 6], v[8 * st + 7]);
  return __builtin_bit_cast(bf16x8, p);
}
DI s16x4 tr_read(const char* p) {
  return __builtin_amdgcn_ds_read_tr16_b64_v4i16((__attribute__((address_space(3))) s16x4*)(p));
}
DI float xh_max(float x) {
  const auto r = __builtin_amdgcn_permlane32_swap(__float_as_uint(x), __float_as_uint(x), false, false);
  return fmaxf(__uint_as_float(r[0]), __uint_as_float(r[1]));
}
DI float xh_sum(float x) {
  const auto r = __builtin_amdgcn_permlane32_swap(__float_as_uint(x), __float_as_uint(x), false, false);
  return __uint_as_float(r[0]) + __uint_as_float(r[1]);
}
DI float xh_get(float x, int hh) {
  const auto r = __builtin_amdgcn_permlane32_swap(__float_as_uint(x), __float_as_uint(x), false, false);
  return hh ? __uint_as_float(r[0]) : __uint_as_float(r[1]);
}
DI float quad_sum(float x) {
  x += __int_as_float(__builtin_amdgcn_update_dpp(0, __float_as_int(x), 0xB1, 0xF, 0xF, true));
  x += __int_as_float(__builtin_amdgcn_update_dpp(0, __float_as_int(x), 0x4E, 0xF, 0xF, true));
  return x;
}
DI void zero16(f32x16& v) {
  float z = 0.f;
  asm volatile("" : "+v"(z));
  UNROLL for (int i = 0; i < 16; ++i) v[i] = z;
}

DI void gemm_main(const u16* __restrict__ A, int lda, const u16* __restrict__ Bt, int ldb, int K,
                  f32x16 (&acc)[2][2], char* smem) {
  const int tid = ltid(), lane = tid & 63, w = tid >> 6, wr = w >> 1, wc = w & 1;
  const int lrow = tid >> 3, lch = tid & 7;
  const u16* ga = A + (size_t)lrow * lda + lch * 8;
  const u16* gb = Bt + (size_t)lrow * ldb + lch * 8;
  u32x4 ra[4], rb[4];
  UNROLL for (int i = 0; i < 4; ++i) {
    ra[i] = *(const u32x4*)(ga + (size_t)(32 * i) * lda);
    rb[i] = *(const u32x4*)(gb + (size_t)(32 * i) * ldb);
  }
  {
    char* pa = smem + lrow * 144 + lch * 16;
    UNROLL for (int i = 0; i < 4; ++i) {
      *(u32x4*)(pa + i * 32 * 144) = ra[i];
      *(u32x4*)(pa + 18432 + i * 32 * 144) = rb[i];
    }
  }
  __syncthreads();
  const int nk = K >> 6;
  _Pragma("unroll 1") for (int kt = 0; kt < nk; ++kt) {
    const bool more = (kt + 1 < nk);
    if (more) {
      const int k0 = (kt + 1) << 6;
      UNROLL for (int i = 0; i < 4; ++i) {
        ra[i] = *(const u32x4*)(ga + (size_t)(32 * i) * lda + k0);
        rb[i] = *(const u32x4*)(gb + (size_t)(32 * i) * ldb + k0);
      }
    }
    const char* pa = smem + (kt & 1) * 36864 + (wr * 64 + (lane & 31)) * 144 + (lane >> 5) * 16;
    const char* pb = smem + (kt & 1) * 36864 + 18432 + (wc * 64 + (lane & 31)) * 144 + (lane >> 5) * 16;
    UNROLL for (int ks = 0; ks < 4; ++ks) {
      bf16x8 a0 = *(const bf16x8*)(pa + ks * 32);
      bf16x8 a1 = *(const bf16x8*)(pa + 32 * 144 + ks * 32);
      bf16x8 b0 = *(const bf16x8*)(pb + ks * 32);
      bf16x8 b1 = *(const bf16x8*)(pb + 32 * 144 + ks * 32);
      acc[0][0] = MFMA(a0, b0, acc[0][0]);
      acc[0][1] = MFMA(a0, b1, acc[0][1]);
      acc[1][0] = MFMA(a1, b0, acc[1][0]);
      acc[1][1] = MFMA(a1, b1, acc[1][1]);
    }
    if (more) {
      char* pw = smem + ((kt + 1) & 1) * 36864 + lrow * 144 + lch * 16;
      UNROLL for (int i = 0; i < 4; ++i) {
        *(u32x4*)(pw + i * 32 * 144) = ra[i];
        *(u32x4*)(pw + 18432 + i * 32 * 144) = rb[i];
      }
    }
    __syncthreads();
  }
}

#define EPI_VARS const int tid = ltid(), lane = tid & 63, w = tid >> 6, wr = w >> 1, wc = w & 1, l31 = lane & 31, hh = lane >> 5; (void)l31; (void)hh; (void)wr; (void)wc;
#define EROW(mi, i) (wr * 64 + (mi) * 32 + 8 * ((i) >> 2) + 4 * hh + ((i) & 3))

DI void convT(const float* __restrict__ src0, const float* __restrict__ src1, int ldsrc, int K, int Nout,
              int kind, const float* __restrict__ scale, u16* __restrict__ dst, char* smem, int slab) {
  float* t = (float*)smem;
  const int tid = ltid();
  const int tiles_n = (Nout + 255) >> 8, tiles_k = K >> 6;
  for (int tile = vbid(); tile < tiles_n * tiles_k; tile += nvb()) {
    const int tn = tile % tiles_n, tk = tile / tiles_n;
    {
      const int nn = tid, n = tn * 256 + nn;
      const float* src = src0;
      int col = n;
      if (kind == 1) {
        const int j = n >> 8, r = n & 255;
        col = 128 * j + (r & 127);
        src = (r >> 7) ? src1 : src0;
      } else if (kind == 2) {
        if (n < 384) col = n;
        else if (n < 896) col = 416 + (n - 384);
        else if (n < 1664) col = 928 + (n - 896);
        else if (n < 2688) col = 1720 + (n - 1664);
        else if (n < 3712) col = 2744 + (n - 2688);
        else if (n < 3744) col = 384 + (n - 3712);
        else if (n < 3768) col = 1696 + (n - 3744);
        else col = -1;
      } else if (kind == 3) {
        if (n < 512) col = (n >> 6) * 96 + (n & 63);
        else col = ((n - 512) >> 5) * 96 + 64 + ((n - 512) & 31);
      }
      if (n >= Nout) col = -1;
      _Pragma("unroll 1") for (int kb = 0; kb < 4; ++kb) {
        float v[16];
        UNROLL for (int i = 0; i < 16; ++i) {
          const int k = tk * 64 + kb * 16 + i;
          v[i] = (col >= 0) ? __builtin_nontemporal_load(src + (size_t)k * ldsrc + col) : 0.f;
          if (scale) v[i] *= scale[k];
        }
        UNROLL for (int i = 0; i < 16; ++i) t[(kb * 16 + i) * 257 + nn] = v[i];
      }
    }
    __syncthreads();
    {
      const int k8 = (tid & 7) * 8;
      UNROLL for (int i = 0; i < 8; ++i) {
        const int n2 = (tid >> 3) + 32 * i, n = tn * 256 + n2;
        if (n < Nout) {
          u32x4 o;
          o[0] = pk2(t[(k8 + 0) * 257 + n2], t[(k8 + 1) * 257 + n2]);
          o[1] = pk2(t[(k8 + 2) * 257 + n2], t[(k8 + 3) * 257 + n2]);
          o[2] = pk2(t[(k8 + 4) * 257 + n2], t[(k8 + 5) * 257 + n2]);
          o[3] = pk2(t[(k8 + 6) * 257 + n2], t[(k8 + 7) * 257 + n2]);
          const size_t di = slab ? ((size_t)(((n >> 8) * (K >> 6) + tk) * 256 + (n & 255)) * 64 + k8) : ((size_t)n * K + tk * 64 + k8);
          *(u32x4*)(dst + di) = o;
        }
      }
    }
    __syncthreads();
  }
}

DI void phase_init(const Params& p, char* smem) {
  const int tid = ltid();
  const size_t gtid = (size_t)vbid() * 256 + tid, gsz = (size_t)nvb() * 256;
  if (vbid() == 0 && tid < 64) ((int*)(p.ws + OFF_CNT))[tid] = 0;
  {
    const float4* xs = (const float4*)p.in[0];
    u32x2* xb = (u32x2*)(p.ws + OFF_XB);
    const size_t n4 = (size_t)M * DM / 4;
    for (size_t i = gtid; i < n4; i += 4 * gsz) {
      float4 v[4];
      UNROLL for (int u = 0; u < 4; ++u) if (i + u * gsz < n4) {
        const f32x4_nt t4 = __builtin_nontemporal_load((const f32x4_nt*)(xs + i + u * gsz));
        v[u] = make_float4(t4[0], t4[1], t4[2], t4[3]);
      }
      UNROLL for (int u = 0; u < 4; ++u) if (i + u * gsz < n4) {
        u32x2 o;
        o[0] = pk2(v[u].x, v[u].y);
        o[1] = pk2(v[u].z, v[u].w);
        xb[i + u * gsz] = o;
      }
    }
  }
  {
    float* cn = (float*)(p.ws + OFF_COSN);
    float* sn = (float*)(p.ws + OFF_SINN);
    float* cm = (float*)(p.ws + OFF_COSM);
    float* sm = (float*)(p.ws + OFF_SINM);
    for (size_t i = gtid; i < (size_t)T * 24; i += gsz) {
      const int t = (int)(i / 24), j = (int)(i % 24);
      if (j < 8) {
        const float inv = (float)(1.0 / pow(500000.0, (double)(2 * j) / 16.0));
        const float ang = (float)t * inv;
        cn[t * 8 + j] = (float)cos((double)ang);
        sn[t * 8 + j] = (float)sin((double)ang);
      } else {
        const int m = j - 8;
        const float inv = (float)(1.0 / pow(500000.0, (double)(2 * m) / 32.0));
        const float ang = (float)t * inv;
        cm[t * 16 + m] = (float)cos((double)ang);
        sm[t * 16 + m] = (float)sin((double)ang);
      }
    }
  }
  for (int u = vbid(); u < 512; u += nvb()) {
    const int job = u >> 7, chunk = u & 127, layer = job >> 1, kv = job & 1;
    const float* pe = p.in[kv ? 15 : 11] + (size_t)layer * 2048;
    const float* w1 = p.in[kv ? 16 : 12] + (size_t)layer * 2048 * 128;
    float* red = (float*)smem;
    const int n = tid & 127, sub = tid >> 7;
    float sacc = 0.f;
    UNROLL for (int i = 0; i < 8; ++i) {
      const int kk = chunk * 16 + sub * 8 + i;
      sacc += pe[kk] * w1[(size_t)kk * 128 + n];
    }
    red[tid] = sacc;
    __syncthreads();
    if (tid < 128) ((float*)(p.ws + OFF_PART))[(size_t)(job * 128 + chunk) * 128 + n] = red[tid] + red[tid + 128];
    __syncthreads();
  }
  for (int job = 0; job < 28; ++job) {
    const int layer = job / 14, jj = job % 14;
    u16* wl = (u16*)(p.ws + OFF_W) + (size_t)layer * W_LAYER;
    const float* s0 = nullptr; const float* s1 = nullptr; const float* sc = nullptr;
    int ldsrc = 0, K = 0, Nout = 0, kind = 0; size_t woff = 0;
    switch (jj) {
      case 0: s0 = p.in[3] + (size_t)layer * DM * FF; s1 = p.in[4] + (size_t)layer * DM * FF; ldsrc = FF; K = 1024; Nout = 5632; kind = 1; woff = W_UP1; break;
      case 1: s0 = p.in[5] + (size_t)layer * FF * DM; ldsrc = DM; K = FF; Nout = 1024; woff = W_DN1; break;
      case 2: s0 = p.in[6] + (size_t)layer * DM * 3768; ldsrc = 3768; K = 1024; Nout = 3840; kind = 2; woff = W_IN; break;
      case 3: s0 = p.in[8] + (size_t)layer * 256 * 768; ldsrc = 768; K = 256; Nout = 768; kind = 3; sc = p.in[7] + layer * 256; woff = W_UQ; break;
      case 4: s0 = p.in[10] + (size_t)layer * 128 * 1024; ldsrc = 1024; K = 128; Nout = 1024; sc = p.in[9] + layer * 128; woff = W_UKV; break;
      case 5: s0 = p.in[12] + (size_t)layer * 2048 * 128; ldsrc = 128; K = 2048; Nout = 128; woff = W_CK1; break;
      case 6: s0 = p.in[14] + (size_t)layer * 128 * 64; ldsrc = 64; K = 128; Nout = 64; woff = W_CK2; break;
      case 7: s0 = p.in[16] + (size_t)layer * 2048 * 128; ldsrc = 128; K = 2048; Nout = 128; woff = W_CV1; break;
      case 8: s0 = p.in[18] + (size_t)layer * 128 * 64; ldsrc = 64; K = 128; Nout = 64; woff = W_CV2; break;
      case 9: s0 = p.in[19] + (size_t)layer * 512 * 1024; ldsrc = 1024; K = 512; Nout = 1024; woff = W_PM; break;
      case 10: s0 = p.in[20] + (size_t)layer * 512 * 1024; ldsrc = 1024; K = 512; Nout = 1024; woff = W_PN; break;
      case 11: s0 = p.in[21] + (size_t)layer * 1024 * 1024; ldsrc = 1024; K = 1024; Nout = 1024; woff = W_OUT; break;
      case 12: s0 = p.in[24] + (size_t)layer * DM * FF; s1 = p.in[25] + (size_t)layer * DM * FF; ldsrc = FF; K = 1024; Nout = 5632; kind = 1; woff = W_UP2; break;
      default: s0 = p.in[26] + (size_t)layer * FF * DM; ldsrc = DM; K = FF; Nout = 1024; woff = W_DN2; break;
    }
    convT(s0, s1, ldsrc, K, Nout, kind, sc, wl + woff, smem, (jj == 1 || jj == 13) ? 1 : 0);
  }
}

namespace pg8 {
#define PG8_LAS __attribute__((address_space(3)))
typedef unsigned short bf16_t;
typedef short bf16x8 __attribute__((ext_vector_type(8)));
typedef float f32x4 __attribute__((ext_vector_type(4)));
typedef unsigned u32x4 __attribute__((ext_vector_type(4)));
constexpr int BM = 256, BK = 64, HALF = 128, HTB = HALF * BK * 2  , STAGE_BYTES = 8 * HTB, NXCD = 8, WGM = 8;

__host__ __device__ __forceinline__ int lds_byte(int r, int c) { const int st = (r >> 4) * 2 + (c >> 5), rr = r & 15, cc = c & 31, ob = rr * 64 + cc * 2; return st * 1024 + (ob ^ (((ob >> 9) & 1) << 5)); }
__host__ __device__ __forceinline__ void stage_rc(int b, int& R, int& C) { const int st = b / 1024, sb = b % 1024, swz = sb ^ (((sb >> 9) & 1) << 5); R = (st >> 1) * 16 + swz / 64; C = (st & 1) * 32 + (swz % 64) / 2; }
__host__ __device__ __forceinline__ int perm32(int rho) { const int n = rho >> 4, i = rho & 15; return 8 * (i >> 2) + 4 * n + (i & 3); }

struct Unit { int pm, pn; };
struct Gemm { const bf16_t* A; const bf16_t* Bt; int M, N, K; };

struct StaticOrder {
    int nM, nN, nwg, G, c;
    __host__ __device__ void init(int M, int N, int G_, int c_) { nM = M / BM; nN = N / BM; nwg = nM * nN; G = G_; c = c_; }
    __host__ __device__ bool next(int i, Unit& u) const {
        const long L = (long)i * G + c; if (L >= nwg) return false;
        int wgid = (int)L; { const int q = nwg / NXCD, r = nwg % NXCD, xcd = wgid % NXCD, off = wgid / NXCD; wgid = (xcd < r ? xcd * (q + 1) : r * (q + 1) + (xcd - r) * q) + off; }
        const int nig = WGM * nN, gid = wgid / nig, fm = gid * WGM, gsz = (nM - fm) < WGM ? (nM - fm) : WGM;
        u.pm = fm + ((wgid % nig) % gsz); u.pn = (wgid % nig) / gsz; return true;
    }
    __device__ __forceinline__ void a_ready(const Unit&) const {}
    __device__ __forceinline__ void done(const Unit&) const {}
};

template <class Epi, class Sched, bool STAMP = false, bool ATILED = false, bool BTILED = false>
__device__ __forceinline__ void gemm_phase(PG8_LAS unsigned char* lds, const Gemm g, const Sched& S, const Epi& E, unsigned long long* stamps) {
    int tid = threadIdx.x; asm volatile("" : "+v"(tid));
    const int wid = __builtin_amdgcn_readfirstlane(tid >> 6), lane = tid & 63, wr = wid >> 2, wc = wid & 3, fr = lane & 15, fq = lane >> 4;
    const int K = g.K, nt = K / BK;
    int ts_lo = 0, ts_hi = 0, nts = 0; const unsigned long long rt_entry = STAMP ? (unsigned long long)wall_clock64() : 0ull;
#define PG8_STAMP() do { if (STAMP && wid == 0 && nts < 64) { const unsigned long long _c = (unsigned long long)clock64(); \
        ts_lo = (lane == nts) ? (int)(unsigned)_c : ts_lo; ts_hi = (lane == nts) ? (int)(unsigned)(_c >> 32) : ts_hi; ++nts; } } while (0)
    PG8_STAMP();
    unsigned voffA[2], voffB[2];
#pragma unroll
    for (int i = 0; i < 2; ++i) { int R, C; stage_rc(tid * 16 + i * 8192, R, C); const int Rb = Epi::PERM ? ((R & ~31) + perm32(R & 31)) : R;
        voffA[i] = (unsigned)(R * (ATILED ? BK : K) + C) * 2u; voffB[i] = (unsigned)(Rb * (BTILED ? BK : K) + C) * 2u; }
    const size_t kstep = (size_t)(BK * 2);
    const size_t hstep = (size_t)HALF * K * 2;
    const size_t tstep = 2 * hstep;
    const size_t kstepA = ATILED ? (size_t)(BM * BK * 2) : kstep, hstepA = ATILED ? (size_t)(HALF * BK * 2) : hstep, tstepA = ATILED ? (size_t)(K / BK) * (size_t)(BM * BK * 2) : tstep;
    const size_t kstepB = BTILED ? (size_t)(BM * BK * 2) : kstep, hstepB = BTILED ? (size_t)(HALF * BK * 2) : hstep, tstepB = BTILED ? (size_t)(K / BK) * (size_t)(BM * BK * 2) : tstep;
    const unsigned ldsw = (unsigned)wid * 1024u;
    const int aoff = lds_byte(wr * 64 + fr, fq * 8), boff = lds_byte(wc * 32 + fr, fq * 8);
#define PG8_SA(b, h) (((b) * 2 + (h)) * HTB)
#define PG8_SB(b, h) ((4 + (b) * 2 + (h)) * HTB)
#define PG8_STAGE(bufoff, gbase, voff) do { _Pragma("unroll") for (int _i = 0; _i < 2; ++_i) \
        __builtin_amdgcn_global_load_lds((const unsigned*)((const char*)(gbase) + (voff)[_i]), (PG8_LAS unsigned*)(lds + (bufoff) + ldsw + _i * 8192), 16, 0, 0); } while (0)
#define PG8_LDA(dst, b, h) do { _Pragma("unroll") for (int m = 0; m < 4; ++m) _Pragma("unroll") for (int k = 0; k < 2; ++k) dst[m][k] = *(const PG8_LAS bf16x8*)(lds + PG8_SA(b, h) + aoff + m * 2048 + k * 1024); } while (0)
#define PG8_LDB(dst, b, h) do { _Pragma("unroll") for (int n = 0; n < 2; ++n) _Pragma("unroll") for (int k = 0; k < 2; ++k) dst[n][k] = *(const PG8_LAS bf16x8*)(lds + PG8_SB(b, h) + boff + n * 2048 + k * 1024); } while (0)
#define PG8_MMA(ai, bj, At, Bt) do { __builtin_amdgcn_s_setprio(1); _Pragma("unroll") for (int m = 0; m < 4; ++m) _Pragma("unroll") for (int n = 0; n < 2; ++n) _Pragma("unroll") for (int k = 0; k < 2; ++k) \
        acc[ai][bj][m][n] = __builtin_amdgcn_mfma_f32_16x16x32_bf16(Bt[n][k], At[m][k], acc[ai][bj][m][n], 0, 0, 0); __builtin_amdgcn_s_setprio(0); } while (0)
#define PG8_WAIT_V(n) asm volatile("s_waitcnt vmcnt(" #n ")" ::: "memory")
#define PG8_WAIT_L(n) asm volatile("s_waitcnt lgkmcnt(" #n ")" ::: "memory")
#define PG8_BAR __builtin_amdgcn_s_barrier()
#define PG8_SCHED __builtin_amdgcn_sched_barrier(0)
    Unit cur, nxt; int ui = 0;
    if (!S.next(0, cur)) return;
    f32x4 acc[2][2][4][2];
#pragma unroll
    for (int a = 0; a < 2; ++a)
#pragma unroll
        for (int b = 0; b < 2; ++b)
#pragma unroll
            for (int m = 0; m < 4; ++m)
#pragma unroll
                for (int n = 0; n < 2; ++n) acc[a][b][m][n] = (f32x4){0.f, 0.f, 0.f, 0.f};
    bf16x8 At[4][2], B0[2][2], B1[2][2];
    const char* cA = (const char*)g.A + (size_t)cur.pm * tstepA; const char* cB = (const char*)g.Bt + (size_t)cur.pn * tstepB;
    S.a_ready(cur);
    PG8_STAGE(PG8_SB(0, 0), cB, voffB); PG8_STAGE(PG8_SA(0, 0), cA, voffA); PG8_STAGE(PG8_SB(0, 1), cB + hstepB, voffB); PG8_STAGE(PG8_SA(0, 1), cA + hstepA, voffA);
    if (wr == 1) PG8_BAR;
    PG8_WAIT_V(4); PG8_BAR;
    PG8_STAGE(PG8_SB(1, 0), cB + kstepB, voffB); PG8_STAGE(PG8_SA(1, 0), cA + kstepA, voffA); PG8_STAGE(PG8_SB(1, 1), cB + hstepB + kstepB, voffB);
    PG8_WAIT_V(6); PG8_BAR;
    PG8_STAMP();
    for (;;) {
        const bool has_next = S.next(ui + 1, nxt);
        const char* nA = has_next ? (const char*)g.A + (size_t)nxt.pm * tstepA : cA; const char* nB = has_next ? (const char*)g.Bt + (size_t)nxt.pn * tstepB : cB;
        for (int t = 0; t < nt; t += 2) {
            const bool last = (t == nt - 2);
            const char* a1 = cA + (size_t)(t + 1) * kstepA;
            const char* a2 = last ? nA : cA + (size_t)(t + 2) * kstepA; const char* b2 = last ? nB : cB + (size_t)(t + 2) * kstepB;
            const char* a3 = a2 + kstepA; const char* b3 = b2 + kstepB;
            if (last && has_next) S.a_ready(nxt);
            PG8_LDB(B0, 0, 0); PG8_SCHED; PG8_LDA(At, 0, 0); PG8_STAGE(PG8_SA(1, 1), a1 + hstepA, voffA);
            PG8_WAIT_L(8); PG8_BAR; PG8_WAIT_L(0); PG8_MMA(0, 0, At, B0); PG8_BAR; PG8_SCHED;
            PG8_LDB(B1, 0, 1); PG8_STAGE(PG8_SB(0, 0), b2, voffB);
            PG8_BAR; PG8_WAIT_L(0); PG8_MMA(0, 1, At, B1); PG8_BAR;
            PG8_LDA(At, 0, 1); PG8_STAGE(PG8_SA(0, 0), a2, voffA);
            PG8_BAR; PG8_WAIT_L(0); PG8_MMA(1, 0, At, B0); PG8_BAR; PG8_SCHED;
            PG8_STAGE(PG8_SB(0, 1), b2 + hstepB, voffB);
            PG8_WAIT_V(6); PG8_BAR; PG8_MMA(1, 1, At, B1); PG8_BAR;
            PG8_LDB(B0, 1, 0); PG8_SCHED; PG8_LDA(At, 1, 0); PG8_STAGE(PG8_SA(0, 1), a2 + hstepA, voffA);
            PG8_WAIT_L(8); PG8_BAR; PG8_WAIT_L(0); PG8_MMA(0, 0, At, B0); PG8_BAR; PG8_SCHED;
            PG8_LDB(B1, 1, 1); PG8_STAGE(PG8_SB(1, 0), b3, voffB);
            PG8_BAR; PG8_WAIT_L(0); PG8_MMA(0, 1, At, B1); PG8_BAR;
            PG8_LDA(At, 1, 1); PG8_STAGE(PG8_SA(1, 0), a3, voffA);
            PG8_BAR; PG8_WAIT_L(0); PG8_MMA(1, 0, At, B0); PG8_BAR; PG8_SCHED;
            PG8_STAGE(PG8_SB(1, 1), b3 + hstepB, voffB);
            PG8_WAIT_V(6); PG8_BAR; PG8_MMA(1, 1, At, B1); PG8_BAR;
        }
        PG8_STAMP();
        if constexpr (!Epi::AFTER_DRAIN) { E(acc, cur, wr, wc, fr, fq); S.done(cur); }
        PG8_STAMP();
        if (!has_next) break;
#pragma unroll
        for (int a = 0; a < 2; ++a)
#pragma unroll
            for (int b = 0; b < 2; ++b)
#pragma unroll
                for (int m = 0; m < 4; ++m)
#pragma unroll
                    for (int n = 0; n < 2; ++n) acc[a][b][m][n] = (f32x4){0.f, 0.f, 0.f, 0.f};
        cur = nxt; cA = nA; cB = nB; ++ui;
    }
    PG8_WAIT_V(0);
    if (wr == 0) PG8_BAR;
    PG8_BAR;
    if constexpr (Epi::AFTER_DRAIN) { E.fused(acc, cur, wr, wc, fr, fq, lds, wid, lane); S.done(cur); }
    PG8_STAMP();
    if (STAMP && wid == 0) { stamps[lane] = lane < nts ? (((unsigned long long)(unsigned)ts_hi << 32) | (unsigned)ts_lo) : 0ull;
        if (lane == 62) stamps[62] = rt_entry; if (lane == 63) stamps[63] = (unsigned long long)wall_clock64(); }
#undef PG8_STAMP
#undef PG8_SA
#undef PG8_SB
#undef PG8_STAGE
#undef PG8_LDA
#undef PG8_LDB
#undef PG8_MMA
#undef PG8_WAIT_V
#undef PG8_WAIT_L
#undef PG8_BAR
#undef PG8_SCHED
}
}

typedef pg8::f32x4 f32x4_t;
DI f32x4_t ld4(const float* p) { return *(const f32x4_t*)p; }

struct EpiSwiglu {
  static constexpr bool PERM = true, AFTER_DRAIN = false;
  u16* H;
  __device__ __forceinline__ void operator()(const f32x4_t (&acc)[2][2][4][2], const pg8::Unit& u, int wr, int wc, int fr, int fq) const {
    u16* base = H + ((size_t)(u.pm * (FF / 64) + 2 * u.pn + (wc >> 1)) * 256) * 64 + (size_t)((wr * 64 + fr) * 64 + (wc & 1) * 32 + fq * 8);
    UNROLL for (int ai = 0; ai < 2; ++ai) UNROLL for (int m = 0; m < 4; ++m) {
      float h[8];
      UNROLL for (int n = 0; n < 2; ++n) UNROLL for (int j = 0; j < 4; ++j) {
        const float g = acc[ai][0][m][n][j], up = acc[ai][1][m][n][j];
        h[4 * n + j] = g * __builtin_amdgcn_rcpf(1.f + __expf(-g)) * up;
      }
      u32x4 o;
      o[0] = pk2(h[0], h[1]); o[1] = pk2(h[2], h[3]); o[2] = pk2(h[4], h[5]); o[3] = pk2(h[6], h[7]);
      *(u32x4*)(base + (ai * 128 + m * 16) * 64) = o;
    }
  }
};

struct EpiResid {
  static constexpr bool PERM = true, AFTER_DRAIN = false;
  const float* Xin; float* X; float coef;
  __device__ __forceinline__ void operator()(const f32x4_t (&acc)[2][2][4][2], const pg8::Unit& u, int wr, int wc, int fr, int fq) const {
    UNROLL for (int ai = 0; ai < 2; ++ai) UNROLL for (int m = 0; m < 4; ++m) {
      const int row = u.pm * 256 + ai * 128 + wr * 64 + m * 16 + fr;
      UNROLL for (int bj = 0; bj < 2; ++bj) {
        const size_t off = (size_t)row * DM + u.pn * 256 + bj * 128 + wc * 32 + fq * 8;
        UNROLL for (int n = 0; n < 2; ++n) {
          f32x4_t x = *(const f32x4_t*)(Xin + off + 4 * n);
          x = x * ALPHA + acc[ai][bj][m][n] * coef;
          *(f32x4_t*)(X + off + 4 * n) = x;
        }
      }
    }
  }
};

struct EpiGate1 {
  static constexpr bool PERM = true, AFTER_DRAIN = false;
  u16* GM;
  __device__ __forceinline__ void operator()(const f32x4_t (&acc)[2][2][4][2], const pg8::Unit& u, int wr, int wc, int fr, int fq) const {
    UNROLL for (int ai = 0; ai < 2; ++ai) UNROLL for (int m = 0; m < 4; ++m) {
      const int row = u.pm * 256 + ai * 128 + wr * 64 + m * 16 + fr;
      UNROLL for (int bj = 0; bj < 2; ++bj) {
        u16* pg = GM + (size_t)row * 1024 + u.pn * 256 + bj * 128 + wc * 32 + fq * 8;
        const u32x4 g = *(const u32x4*)pg;
        u32x4 o;
        UNROLL for (int e = 0; e < 4; ++e) {
          const float lo = __uint_as_float(g[e] << 16) * acc[ai][bj][m][e >> 1][(e & 1) * 2];
          const float hi = __uint_as_float(g[e] & 0xffff0000u) * acc[ai][bj][m][e >> 1][(e & 1) * 2 + 1];
          o[e] = pk2(lo, hi);
        }
        *(u32x4*)pg = o;
      }
    }
  }
};
struct EpiGate2 {
  static constexpr bool PERM = true, AFTER_DRAIN = false;
  const u16* GM; const u16* GN; u16* Y;
  __device__ __forceinline__ void operator()(const f32x4_t (&acc)[2][2][4][2], const pg8::Unit& u, int wr, int wc, int fr, int fq) const {
    UNROLL for (int ai = 0; ai < 2; ++ai) UNROLL for (int m = 0; m < 4; ++m) {
      const int row = u.pm * 256 + ai * 128 + wr * 64 + m * 16 + fr;
      UNROLL for (int bj = 0; bj < 2; ++bj) {
        const size_t off = (size_t)row * 1024 + u.pn * 256 + bj * 128 + wc * 32 + fq * 8;
        const u32x4 t1 = *(const u32x4*)(GM + off);
        const u32x4 g = *(const u32x4*)(GN + off);
        u32x4 o;
        UNROLL for (int e = 0; e < 4; ++e) {
          const float lo = __uint_as_float(t1[e] << 16) + __uint_as_float(g[e] << 16) * acc[ai][bj][m][e >> 1][(e & 1) * 2];
          const float hi = __uint_as_float(t1[e] & 0xffff0000u) + __uint_as_float(g[e] & 0xffff0000u) * acc[ai][bj][m][e >> 1][(e & 1) * 2 + 1];
          o[e] = pk2(lo, hi);
        }
        *(u32x4*)(Y + off) = o;
      }
    }
  }
};

struct EpiWin {
  static constexpr bool PERM = true, AFTER_DRAIN = false;
  char* ws_;
  __device__ __forceinline__ void operator()(const f32x4_t (&acc)[2][2][4][2], const pg8::Unit& u, int wr, int wc, int fr, int fq) const {
    char* ws = ws_ + lz();
    u16* CQ = (u16*)(ws + OFF_CQ);
    u16* CKV = (u16*)(ws + OFF_CKV);
    u16* QN = (u16*)(ws + OFF_QN);
    u16* KV6 = (u16*)(ws + OFF_KV6);
    u16* KPE = (u16*)(ws + OFF_KPE);
    float* GATES = (float*)(ws + OFF_GATES);
    u16* GM = (u16*)(ws + OFF_GM);
    u16* GN = (u16*)(ws + OFF_GN);
    const float* COSN = (const float*)(ws + OFF_COSN);
    const float* SINN = (const float*)(ws + OFF_SINN);
    const float* COSM = (const float*)(ws + OFF_COSM);
    const float* SINM = (const float*)(ws + OFF_SINM);
    UNROLL for (int bj = 0; bj < 2; ++bj) {
      const int hc = 2 * u.pn + bj;
      const int cin = wc * 32 + fq * 8;
      UNROLL for (int ai = 0; ai < 2; ++ai) UNROLL for (int m = 0; m < 4; ++m) {
        const int row = u.pm * 256 + ai * 128 + wr * 64 + m * 16 + fr;
        const int t = row & (T - 1), b = row >> 12;
        float v[8];
        UNROLL for (int n = 0; n < 2; ++n) UNROLL for (int j = 0; j < 4; ++j) v[4 * n + j] = acc[ai][bj][m][n][j];
        if (hc < 3) {
          u16* dst = hc < 2 ? (CQ + (size_t)row * 256 + hc * 128 + cin) : (CKV + (size_t)row * 128 + cin);
          u32x4 o;
          o[0] = pk2(v[0], v[1]); o[1] = pk2(v[2], v[3]); o[2] = pk2(v[4], v[5]); o[3] = pk2(v[6], v[7]);
          *(u32x4*)dst = o;
        } else if (hc < 13) {
          const bool isq = hc < 7;
          const int j6 = hc - 7;
          const bool rope_on = isq || ((j6 & 1) == 0);
          if ((wc & 1) == 0) {
            float pr[8];
            UNROLL for (int e = 0; e < 8; ++e) pr[e] = __shfl_xor(v[e], 16);
            if (rope_on && fq < 2) {
              const f32x4_t c0 = ld4(COSN + t * 8), c1 = ld4(COSN + t * 8 + 4), s0 = ld4(SINN + t * 8), s1 = ld4(SINN + t * 8 + 4);
              UNROLL for (int e = 0; e < 8; ++e) {
                const float cs = e < 4 ? c0[e & 3] : c1[e & 3], sn = e < 4 ? s0[e & 3] : s1[e & 3];
                v[e] = (fq == 0) ? (v[e] * cs - pr[e] * sn) : (v[e] * cs + pr[e] * sn);
              }
            }
          }
          const int d = (wc & 1) * 32 + fq * 8;
          u16* dst = isq ? (QN + (size_t)row * 512 + (2 * (hc - 3) + (wc >> 1)) * 64 + d)
                         : (KV6 + ((size_t)((j6 * NB + b) * 2 + (wc >> 1)) * T + t) * 64 + d);
          u32x4 o;
          o[0] = pk2(v[0], v[1]); o[1] = pk2(v[2], v[3]); o[2] = pk2(v[4], v[5]); o[3] = pk2(v[6], v[7]);
          *(u32x4*)dst = o;
        } else if (hc < 29) {
          u16* dst = (hc < 21 ? GM : GN) + (size_t)row * 1024 + (hc < 21 ? hc - 13 : hc - 21) * 128 + cin;
          u32x4 o;
          o[0] = pk2(sigmoidf_(v[0]), sigmoidf_(v[1])); o[1] = pk2(sigmoidf_(v[2]), sigmoidf_(v[3]));
          o[2] = pk2(sigmoidf_(v[4]), sigmoidf_(v[5])); o[3] = pk2(sigmoidf_(v[6]), sigmoidf_(v[7]));
          *(u32x4*)dst = o;
        } else {
          if (wc == 0) {
            float pr[8];
            UNROLL for (int e = 0; e < 8; ++e) pr[e] = __shfl_xor(v[e], 32);
            const int mb = (fq & 1) * 8;
            const f32x4_t c0 = ld4(COSM + t * 16 + mb), c1 = ld4(COSM + t * 16 + mb + 4), s0 = ld4(SINM + t * 16 + mb), s1 = ld4(SINM + t * 16 + mb + 4);
            UNROLL for (int e = 0; e < 8; ++e) {
              const float cs = e < 4 ? c0[e & 3] : c1[e & 3], sn = e < 4 ? s0[e & 3] : s1[e & 3];
              v[e] = (fq < 2) ? (v[e] * cs - pr[e] * sn) : (v[e] * cs + pr[e] * sn);
            }
            u32x4 o;
            o[0] = pk2(v[0], v[1]); o[1] = pk2(v[2], v[3]); o[2] = pk2(v[4], v[5]); o[3] = pk2(v[6], v[7]);
            *(u32x4*)(KPE + (size_t)row * 32 + fq * 8) = o;
          } else if (wc == 1 && fq < 3) {
            float* dst = GATES + (size_t)row * 24 + fq * 8;
            f32x4_t g0, g1;
            UNROLL for (int e = 0; e < 4; ++e) { g0[e] = sigmoidf_(v[e]); g1[e] = sigmoidf_(v[4 + e]); }
            *(f32x4_t*)dst = g0;
            *(f32x4_t*)(dst + 4) = g1;
          }
        }
      }
    }
  }
};

template <bool ATILED = false, bool BTILED = false, class Epi>
DI void big_gemm(const u16* A, const u16* Bt, int N, int K, const Epi& E, char* smem_blk) {
  pg8::Gemm g{A, Bt, M, N, K};
  pg8::StaticOrder S;
  S.init(M, N, (int)gridDim.x, (int)blockIdx.x);
  pg8::gemm_phase<Epi, pg8::StaticOrder, false, ATILED, BTILED>((PG8_LAS unsigned char*)smem_blk, g, S, E, nullptr);
  __syncthreads();
}

DI void bias_reduce(const Params& p) {
  const int vb = vbid(), tid = ltid();
  if (vb < 4 && tid < 128) {
    const int job = vb, layer = job >> 1, kv = job & 1;
    const float* part = (const float*)(p.ws + OFF_PART) + (size_t)job * 128 * 128;
    float sacc = (p.in[kv ? 17 : 13] + (size_t)layer * 128)[tid];
    for (int ch = 0; ch < 128; ++ch) sacc += part[ch * 128 + tid];
    ((float*)(p.ws + OFF_BIAS))[job * 128 + tid] = sacc;
  }
}

template <bool WXB = true>
DI void phase_ln(const Params& p, const float* g, const float* b) {
  const int tid = ltid(), lane = tid & 63, w = tid >> 6;
  float* X = p.out;
  u16* Xb = (u16*)(p.ws + OFF_XB);
  float4 gv[4], bv[4];
  UNROLL for (int i = 0; i < 4; ++i) {
    gv[i] = *(const float4*)(g + i * 256 + lane * 4);
    bv[i] = *(const float4*)(b + i * 256 + lane * 4);
  }
  for (int row0 = vbid() * 4 + w; row0 < M; row0 += nvb() * 8) {
    int row1 = row0 + nvb() * 4;
    const bool has1 = row1 < M;
    if (!has1) row1 = row0;
    float4 va[4], vc[4];
    UNROLL for (int i = 0; i < 4; ++i) {
      va[i] = *(const float4*)(X + (size_t)row0 * DM + i * 256 + lane * 4);
      vc[i] = *(const float4*)(X + (size_t)row1 * DM + i * 256 + lane * 4);
    }
    float s0 = 0.f, s1 = 0.f;
    UNROLL for (int i = 0; i < 4; ++i) {
      s0 += va[i].x + va[i].y + va[i].z + va[i].w;
      s1 += vc[i].x + vc[i].y + vc[i].z + vc[i].w;
    }
    UNROLL for (int o = 32; o >= 1; o >>= 1) { s0 += __shfl_xor(s0, o); s1 += __shfl_xor(s1, o); }
    const float mu0 = s0 * (1.f / 1024.f), mu1 = s1 * (1.f / 1024.f);
    float q0 = 0.f, q1 = 0.f;
    UNROLL for (int i = 0; i < 4; ++i) {
      va[i].x -= mu0; va[i].y -= mu0; va[i].z -= mu0; va[i].w -= mu0;
      vc[i].x -= mu1; vc[i].y -= mu1; vc[i].z -= mu1; vc[i].w -= mu1;
      q0 += va[i].x * va[i].x + va[i].y * va[i].y + va[i].z * va[i].z + va[i].w * va[i].w;
      q1 += vc[i].x * vc[i].x + vc[i].y * vc[i].y + vc[i].z * vc[i].z + vc[i].w * vc[i].w;
    }
    UNROLL for (int o = 32; o >= 1; o >>= 1) { q0 += __shfl_xor(q0, o); q1 += __shfl_xor(q1, o); }
    const float rstd0 = rsqrtf(q0 * (1.f / 1024.f) + 1e-5f), rstd1 = rsqrtf(q1 * (1.f / 1024.f) + 1e-5f);
#define LN_STORE(V, ROW, RSTD)                                                                   \
  UNROLL for (int i = 0; i < 4; ++i) {                                                            \
    float4 y;                                                                                      \
    y.x = V[i].x * (RSTD) * gv[i].x + bv[i].x;                                                    \
    y.y = V[i].y * (RSTD) * gv[i].y + bv[i].y;                                                    \
    y.z = V[i].z * (RSTD) * gv[i].z + bv[i].z;                                                    \
    y.w = V[i].w * (RSTD) * gv[i].w + bv[i].w;                                                    \
    *(float4*)(X + (size_t)(ROW) * DM + i * 256 + lane * 4) = y;                                  \
    u32x2 o;                                                                                       \
    o[0] = pk2(y.x, y.y);                                                                          \
    o[1] = pk2(y.z, y.w);                                                                          \
    if (WXB) *(u32x2*)(Xb + (size_t)(ROW) * DM + i * 256 + lane * 4) = o;                         \
  }
    LN_STORE(va, row0, rstd0)
    if (has1) { LN_STORE(vc, row1, rstd1) }
#undef LN_STORE
  }
}

DI float gelu_tanh(float x) {
  const float u = 0.7978845608028654f * (x + 0.044715f * x * x * x);
  return x * __builtin_amdgcn_rcpf(1.f + __expf(-2.f * u));
}

DI void phase_up_cmp(const Params& p, int layer, char* smem) {
  EPI_VARS
  const u16* WL = (const u16*)(p.ws + OFF_W) + (size_t)layer * W_LAYER;
  float* rstd = (float*)(smem + 73728);
  const float* COSM = (const float*)(p.ws + OFF_COSM);
  const float* SINM = (const float*)(p.ws + OFF_SINM);
  for (int task = vbid(); task < 64; task += nvb()) {
    char* wsz = p.ws + lz();
    f32x16 acc[2][2];
    UNROLL for (int a = 0; a < 2; ++a) UNROLL for (int b = 0; b < 2; ++b) zero16(acc[a][b]);
      const int kv = task >> 5, bg = (task >> 1) & 15, mt = task & 1;
      const u16* A = (const u16*)(wsz + OFF_KV6) + ((size_t)(kv * 16 + bg) * T) * 64 + (size_t)mt * 128 * 1024;
      const u16* W1 = WL + (kv ? W_CV1 : W_CK1);
      const u16* W2 = WL + (kv ? W_CV2 : W_CK2);
      const float* bias = (const float*)(wsz + OFF_BIAS) + (layer * 2 + kv) * 128;
      u16* dst = (u16*)(wsz + (kv ? OFF_VC : OFF_KC)) + (size_t)bg * 256 * 64;
      gemm_main(A, 1024, W1, 2048, 2048, acc, smem);
      UNROLL for (int mi = 0; mi < 2; ++mi) UNROLL for (int ni = 0; ni < 2; ++ni) UNROLL for (int i = 0; i < 16; ++i) {
        const int r = EROW(mi, i), c = wc * 64 + ni * 32 + l31;
        *(u16*)(smem + r * 272 + c * 2) = f2bf(gelu_tanh(acc[mi][ni][i] + bias[c]));
      }
      __syncthreads();
      f32x16 a2[2];
      zero16(a2[0]);
      zero16(a2[1]);
      UNROLL for (int ks = 0; ks < 8; ++ks) {
        bf16x8 af = *(const bf16x8*)(smem + (32 * w + l31) * 272 + ks * 32 + hh * 16);
        bf16x8 b0 = *(const bf16x8*)(W2 + (size_t)(l31) * 128 + ks * 16 + hh * 8);
        bf16x8 b1 = *(const bf16x8*)(W2 + (size_t)(32 + l31) * 128 + ks * 16 + hh * 8);
        a2[0] = MFMA(af, b0, a2[0]);
        a2[1] = MFMA(af, b1, a2[1]);
      }
      UNROLL for (int ni = 0; ni < 2; ++ni) UNROLL for (int i = 0; i < 16; ++i) {
        const int c = mt * 128 + 32 * w + 8 * (i >> 2) + 4 * hh + (i & 3);
        dst[(size_t)c * 64 + ni * 32 + l31] = (c == 255) ? (u16)0 : f2bf(a2[ni][i]);
      }
      __syncthreads();
  }
  const int nw_small = nvb() > 128 ? nvb() - 64 : nvb();
  const int vb_small = nvb() > 128 ? vbid() - 64 : vbid();
  for (int task = vb_small; task >= 0 && task < 1536; task += nw_small) {
    char* wsz = p.ws + lz();
    f32x16 acc[2][2];
    UNROLL for (int a = 0; a < 2; ++a) UNROLL for (int b = 0; b < 2; ++b) zero16(acc[a][b]);
      const int tt = task, tm = tt / 6, tn = tt % 6;
      const u16* A = (const u16*)(wsz + OFF_CQ) + (size_t)tm * 128 * 256;
      {
        const int r = tid >> 1, hf = tid & 1;
        const u16* ar = A + (size_t)r * 256 + hf * 128;
        float ss = 0.f;
        UNROLL for (int c = 0; c < 16; ++c) {
          u32x4 v = *(const u32x4*)(ar + c * 8);
          UNROLL for (int e = 0; e < 4; ++e) {
            const float lo = __uint_as_float(v[e] << 16), hi = __uint_as_float(v[e] & 0xffff0000u);
            ss += lo * lo + hi * hi;
          }
        }
        ss += __shfl_xor(ss, 1);
        if (hf == 0) rstd[r] = rsqrtf(ss * (1.f / 256.f) + 1e-6f);
      }
      gemm_main(A, 256, WL + W_UQ + (size_t)tn * 128 * 256, 256, 256, acc, smem);
      u16* QM = (u16*)(wsz + OFF_QM);
      UNROLL for (int mi = 0; mi < 2; ++mi) UNROLL for (int ni = 0; ni < 2; ++ni) UNROLL for (int i = 0; i < 16; ++i) {
        const int r = EROW(mi, i), row = tm * 128 + r;
        float v = acc[mi][ni][i] * rstd[r];
        const float pr = __shfl_xor(v, 16);
        if (tn >= 4) {
          const int t = row & (T - 1);
          const float cs = COSM[t * 16 + (l31 & 15)], sn = SINM[t * 16 + (l31 & 15)];
          v = (l31 < 16) ? (v * cs - pr * sn) : (v * cs + pr * sn);
        }
        QM[(size_t)row * 768 + tn * 128 + wc * 64 + ni * 32 + l31] = f2bf(v);
      }
      __syncthreads();
  }
  for (int task = vb_small; task >= 0 && task < 2048; task += nw_small) {
    char* wsz = p.ws + lz();
    f32x16 acc[2][2];
    UNROLL for (int a = 0; a < 2; ++a) UNROLL for (int b = 0; b < 2; ++b) zero16(acc[a][b]);
      const int tt = task, tm = tt >> 3, tn = tt & 7;
      const u16* A = (const u16*)(wsz + OFF_CKV) + (size_t)tm * 128 * 128;
      {
        const int r = tid >> 1, hf = tid & 1;
        const u16* ar = A + (size_t)r * 128 + hf * 64;
        float ss = 0.f;
        UNROLL for (int c = 0; c < 8; ++c) {
          u32x4 v = *(const u32x4*)(ar + c * 8);
          UNROLL for (int e = 0; e < 4; ++e) {
            const float lo = __uint_as_float(v[e] << 16), hi = __uint_as_float(v[e] & 0xffff0000u);
            ss += lo * lo + hi * hi;
          }
        }
        ss += __shfl_xor(ss, 1);
        if (hf == 0) rstd[r] = rsqrtf(ss * (1.f / 128.f) + 1e-6f);
      }
      gemm_main(A, 128, WL + W_UKV + (size_t)tn * 128 * 128, 128, 128, acc, smem);
      u16* dst = (u16*)(wsz + (wc == 0 ? OFF_KM : OFF_VM));
      UNROLL for (int mi = 0; mi < 2; ++mi) UNROLL for (int ni = 0; ni < 2; ++ni) UNROLL for (int i = 0; i < 16; ++i) {
        const int r = EROW(mi, i), row = tm * 128 + r;
        const int t = row & (T - 1), b = row >> 12;
        dst[((size_t)(b * 8 + tn) * T + t) * 64 + ni * 32 + l31] = f2bf(acc[mi][ni][i] * rstd[r]);
      }
      __syncthreads();
  }
}

template <int NKS, int KSTR, int MODE, int NREG>
DI void attn_tile(const char* sK, const char* sV, const bf16x8 (&qf)[2][4], const char* qlds, f32x16 (&o)[2][2],
                  float (&mrun)[2], float (&lrun)[2], float sl2, int lane, int kbase, const int (&tq)[2],
                  bool need_mask, const bool (&selb)[2]) {
  const int hh = lane >> 5, r = lane & 31;
  const int blk = (lane >> 4) & 1, q4 = (lane & 15) >> 2, p4 = lane & 3;
  const int sw = (q4 >> 1) & 1;
  UNROLL for (int kt2 = 0; kt2 < 2; ++kt2) {
    f32x16 s[2];
    UNROLL for (int i = 0; i < 16; ++i) { s[0][i] = 0.f; s[1][i] = 0.f; }
    {
      const char* pk = sK + (32 * kt2 + r) * KSTR + hh * 16;
      bf16x8 kf[2], qa[2], qb[2];
      kf[0] = *(const bf16x8*)(pk);
      if (0 >= NREG) {
        qa[0] = *(const bf16x8*)(qlds + (0 - NREG) * 1024);
        qb[0] = *(const bf16x8*)(qlds + (NKS - NREG + 0 - NREG) * 1024);
      }
      UNROLL for (int ks = 0; ks < NKS; ++ks) {
        const int cb = ks & 1, nb = cb ^ 1;
        if (ks + 1 < NKS) {
          kf[nb] = *(const bf16x8*)(pk + (ks + 1) * 32);
          if (ks + 1 >= NREG) {
            qa[nb] = *(const bf16x8*)(qlds + (ks + 1 - NREG) * 1024);
            qb[nb] = *(const bf16x8*)(qlds + (NKS - NREG + ks + 1 - NREG) * 1024);
          }
        }
        __builtin_amdgcn_sched_barrier(0);
        if (ks >= NREG) {
          s[0] = MFMA(kf[cb], qa[cb], s[0]);
          s[1] = MFMA(kf[cb], qb[cb], s[1]);
        } else {
          s[0] = MFMA(kf[cb], qf[0][ks < 4 ? ks : 0], s[0]);
          s[1] = MFMA(kf[cb], qf[1][ks < 4 ? ks : 0], s[1]);
        }
        __builtin_amdgcn_sched_barrier(0);
      }
    }
    UNROLL for (int qt = 0; qt < 2; ++qt) {
      float mx = NEGR;
      if (need_mask) {
        const int lim = tq[qt] - kbase - 4 * hh;
        UNROLL for (int i = 0; i < 16; ++i) {
          const int kc = 32 * kt2 + 8 * (i >> 2) + (i & 3);
          bool ok = kc <= lim;
          if (MODE == 2) ok = ok && (kc > lim - 512);
          if (MODE == 1) ok = ok && selb[qt];
          const float x = ok ? s[qt][i] : NEGR;
          s[qt][i] = x;
          mx = fmaxf(mx, x);
        }
      } else {
        UNROLL for (int i = 0; i < 16; ++i) mx = fmaxf(mx, s[qt][i]);
      }
      mx = xh_max(mx);
      const float mnew = fmaxf(mrun[qt], mx * sl2);
      if (__builtin_amdgcn_ballot_w64(mnew != mrun[qt]) != 0ull) {
        const float alpha = ex2(mrun[qt] - mnew);
        mrun[qt] = mnew;
        lrun[qt] *= alpha;
        UNROLL for (int dt = 0; dt < 2; ++dt) UNROLL for (int i = 0; i < 16; ++i) o[qt][dt][i] *= alpha;
      }
      float ls = 0.f;
      const float nbias = (MODE == 1 && !selb[qt]) ? (-mnew - 20000.f) : -mnew;
      UNROLL for (int i = 0; i < 16; ++i) {
        const float pv = ex2(__builtin_fmaf(s[qt][i], sl2, nbias));
        s[qt][i] = pv;
        ls += pv;
      }
      lrun[qt] += ls;
    }
    {
      bf16x8 pf0[2], pf1[2];
      pf0[0] = pack8(s[0], 0); pf1[0] = pack8(s[1], 0);
      pf0[1] = pack8(s[0], 1); pf1[1] = pack8(s[1], 1);
      s16x4 lo[2], hi[2];
      const char* pvb = sV + (32 * kt2 + 4 * hh + q4) * 128 + (16 * blk + 4 * p4) * 2;
      lo[0] = tr_read(pvb + ((0 ^ sw) * 64));
      hi[0] = tr_read(pvb + ((0 ^ sw) * 64) + 8 * 128);
      UNROLL for (int c = 0; c < 4; ++c) {
        const int st = c >> 1, dt = c & 1, cb = c & 1, nb = cb ^ 1;
        if (c + 1 < 4) {
          const int st1 = (c + 1) >> 1, dt1 = (c + 1) & 1;
          lo[nb] = tr_read(pvb + st1 * 16 * 128 + ((dt1 ^ sw) * 64));
          hi[nb] = tr_read(pvb + st1 * 16 * 128 + ((dt1 ^ sw) * 64) + 8 * 128);
        }
        __builtin_amdgcn_sched_barrier(0);
        const bf16x8 vf = __builtin_shufflevector(lo[cb], hi[cb], 0, 1, 2, 3, 4, 5, 6, 7);
        o[0][dt] = MFMA(vf, pf0[st], o[0][dt]);
        o[1][dt] = MFMA(vf, pf1[st], o[1][dt]);
        __builtin_amdgcn_sched_barrier(0);
      }
    }
  }
}

DI void mla_task(const Params& p, int task, char* smem) {
  const int tid = ltid(), lane = tid & 63, w = tid >> 6, l31 = lane & 31, hh = lane >> 5;
  const int qb = 15 - (task >> 6), bh = task & 63, b = bh >> 3, h = bh & 7;
  const int q0 = qb * 256;
  u16* QM = (u16*)(p.ws + OFF_QM);
  const u16* KM = (const u16*)(p.ws + OFF_KM) + (size_t)bh * T * 64;
  const u16* VM = (const u16*)(p.ws + OFF_VM) + (size_t)bh * T * 64;
  const u16* KPE = (const u16*)(p.ws + OFF_KPE) + (size_t)b * T * 32;
  bf16x8 qf[2][4];
  int tq[2];
  const char* qlds = smem + 43008 + w * 4096 + lane * 16;
  UNROLL for (int qt = 0; qt < 2; ++qt) {
    tq[qt] = q0 + 64 * w + 32 * qt + l31;
    const u16* base = QM + (size_t)(b * T + tq[qt]) * 768;
    UNROLL for (int ks = 0; ks < 4; ++ks) qf[qt][ks] = *(const bf16x8*)(base + h * 64 + 16 * ks + 8 * hh);
    UNROLL for (int ks = 0; ks < 2; ++ks)
      *(bf16x8*)(smem + 43008 + w * 4096 + lane * 16 + (qt * 2 + ks) * 1024) = *(const bf16x8*)(base + 512 + h * 32 + 16 * ks + 8 * hh);
  }
  f32x16 o[2][2];
  UNROLL for (int a = 0; a < 2; ++a) UNROLL for (int c = 0; c < 2; ++c) zero16(o[a][c]);
  float mrun[2] = {NEGF, NEGF}, lrun[2] = {0.f, 0.f};
  const bool selb[2] = {true, true};
  const float sl2 = 0.10206207261596575f * LOG2E;
  const int nkt = (q0 >> 6) + 4, my_last = (q0 >> 6) + w;
  u32x4 rk[3], rv[2];
  const unsigned offa = (unsigned)tid * 16u;
  const unsigned offp = (unsigned)tid * 16u;
  auto gload = [&](int kt) {
    const char* kb = (const char*)(KM + (size_t)kt * 4096);
    const char* vb = (const char*)(VM + (size_t)kt * 4096);
    const char* pb = (const char*)(KPE + (size_t)kt * 2048);
    rk[0] = *(const u32x4*)(kb + offa);
    rk[1] = *(const u32x4*)(kb + offa + 4096u);
    rk[2] = *(const u32x4*)(pb + offp);
    rv[0] = *(const u32x4*)(vb + offa);
    rv[1] = *(const u32x4*)(vb + offa + 4096u);
  };
  auto sstore = [&](int s) {
    UNROLL for (int i = 0; i < 2; ++i) {
      const int c = tid + 256 * i, key = c >> 3, ch = c & 7;
      *(u32x4*)(smem + s * 13312 + key * 208 + ch * 16) = rk[i];
      *(u32x4*)(smem + 26624 + s * 8192 + key * 128 + ((ch ^ (4 * ((key >> 1) & 1))) * 16)) = rv[i];
    }
    *(u32x4*)(smem + s * 13312 + (tid >> 2) * 208 + 128 + (tid & 3) * 16) = rk[2];
  };
  gload(0);
  sstore(0);
  __syncthreads();
  _Pragma("unroll 1") for (int kt = 0; kt < nkt; ++kt) {
    const bool more = kt + 1 < nkt;
    if (more) gload(kt + 1);
    if (kt <= my_last) {
      const bool need_mask = (64 * kt + 63 > q0 + 64 * w);
      attn_tile<6, 208, 0, 4>(smem + (kt & 1) * 13312, smem + 26624 + (kt & 1) * 8192, qf, qlds, o, mrun, lrun, sl2, lane,
                           64 * kt, tq, need_mask, selb);
    }
    if (more) sstore((kt + 1) & 1);
    __syncthreads();
  }
  UNROLL for (int qt = 0; qt < 2; ++qt) {
    const float lt = xh_sum(lrun[qt]);
    const float inv = __builtin_amdgcn_rcpf(lt);
    u16* dst = (u16*)(p.ws + OFF_OM) + (size_t)(b * T + tq[qt]) * 512 + h * 64;
    UNROLL for (int dt = 0; dt < 2; ++dt) UNROLL for (int g4 = 0; g4 < 4; ++g4) {
      u32x2 v;
      v[0] = pk2(o[qt][dt][4 * g4 + 0] * inv, o[qt][dt][4 * g4 + 1] * inv);
      v[1] = pk2(o[qt][dt][4 * g4 + 2] * inv, o[qt][dt][4 * g4 + 3] * inv);
      *(u32x2*)(dst + 32 * dt + 8 * g4 + 4 * hh) = v;
    }
  }
}

template <int MODE>
DI void nsa_flash(const u16* __restrict__ Kg, const u16* __restrict__ Vg, int kt_lo, int kt_hi, int cur,
                  f32x16 (&o)[2][2], float (&mrun)[2], float (&lrun)[2], float sl2,
                  const int (&tq)[2], char* smem) {
  const bf16x8 qdummy[2][4] = {};
  const char* qlds = smem + 36864 + (ltid() >> 6) * 8192 + (ltid() & 63) * 16;
  const int tid = ltid(), lane = tid & 63;
  const unsigned* selw = (const unsigned*)(smem + 69632 + 8192);
  u32x4 rk[2], rv[2];
  const unsigned offa = (unsigned)tid * 16u;
  auto gload = [&](int kt) {
    const char* kb = (const char*)(Kg + (size_t)kt * 4096);
    const char* vb = (const char*)(Vg + (size_t)kt * 4096);
    rk[0] = *(const u32x4*)(kb + offa);
    rk[1] = *(const u32x4*)(kb + offa + 4096u);
    rv[0] = *(const u32x4*)(vb + offa);
    rv[1] = *(const u32x4*)(vb + offa + 4096u);
  };
  auto sstore = [&](int s) {
    UNROLL for (int i = 0; i < 2; ++i) {
      const int c = tid + 256 * i, key = c >> 3, ch = c & 7;
      *(u32x4*)(smem + s * 9216 + key * 144 + ch * 16) = rk[i];
      *(u32x4*)(smem + 18432 + s * 8192 + key * 128 + ((ch ^ (4 * ((key >> 1) & 1))) * 16)) = rv[i];
    }
  };
  gload(kt_lo);
  sstore(0);
  __syncthreads();
  _Pragma("unroll 1") for (int kt = kt_lo; kt <= kt_hi; ++kt) {
    const int s = (kt - kt_lo) & 1;
    const bool more = kt < kt_hi;
    if (more) gload(kt + 1);
    bool selb[2] = {true, true};
    if (MODE == 1) {
      selb[0] = (selw[(tq[0] & 63) * 2 + (kt >> 5)] >> (kt & 31)) & 1u;
      selb[1] = (selw[(tq[1] & 63) * 2 + (kt >> 5)] >> (kt & 31)) & 1u;
    }
    const bool need_mask = (kt == cur) || (MODE == 2 && kt == cur - 8);
    attn_tile<4, 144, MODE, 0>(smem + s * 9216, smem + 18432 + s * 8192, qdummy, qlds, o, mrun, lrun, sl2, lane,
                                  64 * kt, tq, need_mask, selb);
    if (more) sstore(s ^ 1);
    __syncthreads();
  }
}

DI void nsa_task(const Params& p, int task, char* smem) {
  const int tid = ltid(), lane = tid & 63, w = tid >> 6, l31 = lane & 31, hh = lane >> 5;
  const int cur = 63 - (task >> 4), bg = task & 15, b = bg >> 1, g = bg & 1;
  u16* QN = (u16*)(p.ws + OFF_QN);
  const u16* KV6 = (const u16*)(p.ws + OFF_KV6);
  const float* GATES = (const float*)(p.ws + OFF_GATES);
  const u16* KC = (const u16*)(p.ws + OFF_KC) + (size_t)bg * 256 * 64;
  const u16* VC = (const u16*)(p.ws + OFF_VC) + (size_t)bg * 256 * 64;
  const int head = 4 * g + (l31 & 3);
  bf16x8 qf[2][4];
  int tq[2];
  UNROLL for (int qt = 0; qt < 2; ++qt) {
    tq[qt] = 64 * cur + 16 * w + 8 * qt + (l31 >> 2);
    const u16* base = QN + (size_t)(b * T + tq[qt]) * 512 + head * 64;
    UNROLL for (int ks = 0; ks < 4; ++ks) qf[qt][ks] = *(const bf16x8*)(base + 16 * ks + 8 * hh);
  }
  const float sl2 = 0.125f * LOG2E;
  unsigned long long* selm = (unsigned long long*)(smem + 69632 + 8192);
  char* R1 = smem;
  char* R2 = smem + 36864;
  float* impw = (float*)(smem + 69632) + w * 512;
  {
    const int cmax_blk = (64 * cur + 63 - 31) >> 4;
    UNROLL for (int i = 0; i < 8; ++i) if (32 * i <= cmax_blk) {
      const int c = tid + 256 * i, key = c >> 3, ch = c & 7;
      u32x4 kk = *(const u32x4*)(KC + (size_t)c * 8);
      u32x4 vv = *(const u32x4*)(VC + (size_t)c * 8);
      *(u32x4*)(R1 + (key >> 6) * 9216 + (key & 63) * 144 + ch * 16) = kk;
      *(u32x4*)(R2 + (key >> 6) * 8192 + (key & 63) * 128 + ((ch ^ (4 * ((key >> 1) & 1))) * 16)) = vv;
    }
    __syncthreads();
    const int blk = (lane >> 4) & 1, q4 = (lane & 15) >> 2, p4 = lane & 3, sw = (q4 >> 1) & 1;
    UNROLL for (int qt = 0; qt < 2; ++qt) {
      const int cmh = ((tq[qt] - 31) >> 4) - 4 * hh;
      const int cmax_u = (64 * cur + 16 * __builtin_amdgcn_readfirstlane(w) + 8 * qt + 7 - 31) >> 4;
      float mx = NEGF, lsum = 0.f;
      UNROLL for (int a = 0; a < 8; ++a) if (32 * a <= cmax_u) {
        f32x16 sa;
        zero16(sa);
        const char* pk = R1 + (a >> 1) * 9216 + (32 * (a & 1) + l31) * 144 + hh * 16;
        {
          bf16x8 kf4[4];
          UNROLL for (int ks = 0; ks < 4; ++ks) kf4[ks] = *(const bf16x8*)(pk + ks * 32);
          __builtin_amdgcn_sched_barrier(0);
          UNROLL for (int ks = 0; ks < 4; ++ks) sa = MFMA(kf4[ks], qf[qt][ks], sa);
        }
        float tm = NEGF;
        UNROLL for (int i = 0; i < 16; ++i) {
          const int c = 32 * a + 8 * (i >> 2) + (i & 3);
          const float x = (c <= cmh) ? sa[i] * sl2 : NEGF;
          sa[i] = x;
          tm = fmaxf(tm, x);
        }
        const float mnew = fmaxf(mx, tm);
        float ts = 0.f;
        UNROLL for (int i = 0; i < 16; ++i) ts += ex2(sa[i] - mnew);
        lsum = lsum * ex2(mx - mnew) + ts;
        mx = mnew;
        __builtin_amdgcn_sched_barrier(0);
      }
      {
        const float mo = xh_get(mx, hh), lo = xh_get(lsum, hh);
        const float mt = fmaxf(mx, mo);
        lsum = lsum * ex2(mx - mt) + lo * ex2(mo - mt);
        mx = mt;
      }
      const float inv = (mx > -1e29f) ? 1.f / lsum : 0.f;
      float lastprev = 0.f;
      f32x16 oc[2];
      zero16(oc[0]);
      zero16(oc[1]);
      UNROLL for (int a = 0; a < 8; ++a) if (32 * a <= cmax_u) {
        f32x16 sa;
        zero16(sa);
        const char* pk = R1 + (a >> 1) * 9216 + (32 * (a & 1) + l31) * 144 + hh * 16;
        {
          bf16x8 kf4[4];
          UNROLL for (int ks = 0; ks < 4; ++ks) kf4[ks] = *(const bf16x8*)(pk + ks * 32);
          __builtin_amdgcn_sched_barrier(0);
          UNROLL for (int ks = 0; ks < 4; ++ks) sa = MFMA(kf4[ks], qf[qt][ks], sa);
        }
        UNROLL for (int i = 0; i < 16; ++i) {
          const int c = 32 * a + 8 * (i >> 2) + (i & 3);
          sa[i] = (c <= cmh) ? ex2(sa[i] * sl2 - mx) * inv : 0.f;
        }
        UNROLL for (int q = 0; q < 4; ++q) {
          const int gi = 4 * a + q;
          const float g4 = sa[4 * q] + sa[4 * q + 1] + sa[4 * q + 2] + sa[4 * q + 3];
          const float lastcur = sa[4 * q + 3];
          const float tosend = hh ? lastprev : lastcur;
          const float recv = xh_get(tosend, hh);
          const float im = quad_sum(g4 + recv);
          if ((l31 & 3) == (gi & 3)) impw[(l31 >> 2) * 64 + 2 * gi + hh] = im;
          lastprev = lastcur;
        }
        {
          s16x4 vlo[4], vhi[4];
          UNROLL for (int c = 0; c < 4; ++c) {
            const int st = c >> 1, dt = c & 1;
            const char* pv = R2 + (a >> 1) * 8192 + (32 * (a & 1) + 16 * st + 4 * hh + q4) * 128 + ((dt ^ sw) * 64) + (16 * blk + 4 * p4) * 2;
            vlo[c] = tr_read(pv);
            vhi[c] = tr_read(pv + 8 * 128);
          }
          const bf16x8 pfa = pack8(sa, 0), pfb = pack8(sa, 1);
          __builtin_amdgcn_sched_barrier(0);
          UNROLL for (int c = 0; c < 4; ++c) {
            const bf16x8 vf = __builtin_shufflevector(vlo[c], vhi[c], 0, 1, 2, 3, 4, 5, 6, 7);
            oc[c & 1] = MFMA(vf, (c >> 1) ? pfb : pfa, oc[c & 1]);
          }
        }
        __builtin_amdgcn_sched_barrier(0);
      }
      __syncthreads();
      if (cur >= 16) {
        unsigned* keyw = (unsigned*)impw;
        UNROLL for (int t8 = 0; t8 < 8; ++t8) {
          const float v = impw[t8 * 64 + lane];
          const int j = lane;
          unsigned key = (__float_as_uint(v) & ~63u) | (unsigned)(63 - j);
          if (j == 0 || j == cur || j == cur - 1) key = 0x7f800000u | (unsigned)(63 - j);
          else if (j > cur) key = (unsigned)(63 - j);
          keyw[t8 * 64 + lane] = key;
        }
        __syncthreads();
        _Pragma("unroll 1") for (int t8 = 0; t8 < 8; ++t8) {
          const unsigned key = keyw[t8 * 64 + lane];
          int rank = 0;
          UNROLL for (int c4 = 0; c4 < 16; ++c4) if (c4 <= (cur >> 2)) {
            const u32x4 kk = *(const u32x4*)(keyw + t8 * 64 + c4 * 4);
            rank += (kk[0] > key) ? 1 : 0;
            rank += (kk[1] > key) ? 1 : 0;
            rank += (kk[2] > key) ? 1 : 0;
            rank += (kk[3] > key) ? 1 : 0;
          }
          const unsigned long long mk = __ballot(rank < 16);
          if (lane == 0) selm[16 * w + 8 * qt + t8] = mk;
        }
      } else {
        if (lane < 8) selm[16 * w + 8 * qt + lane] = ~0ull;
      }
      __syncthreads();
      int zq = 0;
      asm volatile("" : "+v"(zq));
      const int rowq = b * T + tq[qt] + zq;
      const float g0 = GATES[(size_t)rowq * 24 + head * 3 + 0];
      u16* dst = (u16*)(p.ws + OFF_ON) + (size_t)rowq * 512 + head * 64;
      UNROLL for (int dt = 0; dt < 2; ++dt) UNROLL for (int g4 = 0; g4 < 4; ++g4) {
        u32x2 v;
        v[0] = pk2(oc[dt][4 * g4 + 0] * g0, oc[dt][4 * g4 + 1] * g0);
        v[1] = pk2(oc[dt][4 * g4 + 2] * g0, oc[dt][4 * g4 + 3] * g0);
        *(u32x2*)(dst + 32 * dt + 8 * g4 + 4 * hh) = v;
      }
    }
    __syncthreads();
  }
  {
    char* qdst = smem + 36864 + w * 8192 + lane * 16;
    UNROLL for (int qt = 0; qt < 2; ++qt) UNROLL for (int ks = 0; ks < 4; ++ks) *(bf16x8*)(qdst + (qt * 4 + ks) * 1024) = qf[qt][ks];
  }
  __syncthreads();
  UNROLL for (int br = 1; br <= 2; ++br) {
    f32x16 o[2][2];
    UNROLL for (int a = 0; a < 2; ++a) UNROLL for (int c = 0; c < 2; ++c) zero16(o[a][c]);
    float mrun[2] = {NEGF, NEGF}, lrun[2] = {0.f, 0.f};
    const u16* Kg = KV6 + ((size_t)((2 * br) * 16 + bg) * T) * 64;
    const u16* Vg = KV6 + ((size_t)((2 * br + 1) * 16 + bg) * T) * 64;
    if (br == 1) nsa_flash<1>(Kg, Vg, 0, cur, cur, o, mrun, lrun, sl2, tq, smem);
    else nsa_flash<2>(Kg, Vg, cur > 8 ? cur - 8 : 0, cur, cur, o, mrun, lrun, sl2, tq, smem);
    UNROLL for (int qt = 0; qt < 2; ++qt) {
      const float lt = xh_sum(lrun[qt]);
      int zq = 0;
      asm volatile("" : "+v"(zq));
      const int rowq = b * T + tq[qt] + zq;
      const float gt = GATES[(size_t)rowq * 24 + head * 3 + br];
      const float inv = gt * __builtin_amdgcn_rcpf(lt);
      u16* dst = (u16*)(p.ws + OFF_ON) + (size_t)rowq * 512 + head * 64;
      UNROLL for (int dt = 0; dt < 2; ++dt) UNROLL for (int g4 = 0; g4 < 4; ++g4) {
        u32x2* pd = (u32x2*)(dst + 32 * dt + 8 * g4 + 4 * hh);
        const u32x2 old = *pd;
        u32x2 v;
        v[0] = pk2(o[qt][dt][4 * g4 + 0] * inv + __uint_as_float(old[0] << 16),
                   o[qt][dt][4 * g4 + 1] * inv + __uint_as_float(old[0] & 0xffff0000u));
        v[1] = pk2(o[qt][dt][4 * g4 + 2] * inv + __uint_as_float(old[1] << 16),
                   o[qt][dt][4 * g4 + 3] * inv + __uint_as_float(old[1] & 0xffff0000u));
        *pd = v;
      }
    }
  }
}

DI void phase_attn(const Params& p, int layer, char* smem, char* smem_blk) {
  int* cnt = (int*)(p.ws + OFF_CNT) + layer;
  int* s_task = (int*)(smem_blk + 2 * VSMEM);
  const int half = vhalf();
  for (;;) {
    if (__builtin_amdgcn_workitem_id_x() == 0) *s_task = atomicAdd(cnt, 2);
    __syncthreads();
    const int task = *s_task + half;
    __syncthreads();
    if (task >= 2048) break;
    if (task < 1024) mla_task(p, task, smem);
    else nsa_task(p, task - 1024, smem);
  }
}

DI void phase_proj(const Params& p, int layer, char* smem) {
  EPI_VARS
  const u16* WL = (const u16*)(p.ws + OFF_W) + (size_t)layer * W_LAYER;
  const u16* OM = (const u16*)(p.ws + OFF_OM);
  const u16* ON = (const u16*)(p.ws + OFF_ON);
  const u16* GM = (const u16*)(p.ws + OFF_GM);
  const u16* GN = (const u16*)(p.ws + OFF_GN);
  u16* Yb = (u16*)(p.ws + OFF_XB);
  const int ntn = 8, ntiles = 256 * ntn;
  for (int tile = vbid(); tile < ntiles; tile += nvb()) {
    const int tm = tile / ntn, tn = tile % ntn;
    f32x16 acc[2][2];
    UNROLL for (int a = 0; a < 2; ++a) UNROLL for (int b = 0; b < 2; ++b) zero16(acc[a][b]);
    gemm_main(OM + (size_t)tm * 128 * 512, 512, WL + W_PM + (size_t)tn * 128 * 512, 512, 512, acc, smem);
    {
      int z1 = 0;
      asm volatile("" : "+v"(z1)::"memory");
      UNROLL for (int mi = 0; mi < 2; ++mi) UNROLL for (int ni = 0; ni < 2; ++ni) UNROLL for (int i = 0; i < 16; ++i) {
        if ((i & 3) == 0) asm volatile("" ::: "memory");
        const int row = tm * 128 + EROW(mi, i) + z1;
        const size_t idx = (size_t)row * 1024 + tn * 128 + wc * 64 + ni * 32 + l31;
        acc[mi][ni][i] *= bf2f(GM[idx]) * __builtin_amdgcn_rcpf(bf2f(GN[idx]));
      }
    }
    gemm_main(ON + (size_t)tm * 128 * 512, 512, WL + W_PN + (size_t)tn * 128 * 512, 512, 512, acc, smem);
    int z2 = 0;
    asm volatile("" : "+v"(z2)::"memory");
    UNROLL for (int mi = 0; mi < 2; ++mi) UNROLL for (int ni = 0; ni < 2; ++ni) UNROLL for (int i = 0; i < 16; ++i) {
      const int row = tm * 128 + EROW(mi, i) + z2;
      const size_t idx = (size_t)row * 1024 + tn * 128 + wc * 64 + ni * 32 + l31;
      if ((i & 3) == 0) asm volatile("" ::: "memory");
      const float y = bf2f(GN[idx]) * acc[mi][ni][i];
      Yb[idx] = f2bf(y);
    }
  }
}

#define XB_TMO      128
#define XB_XCNT(j)  (256  + 64 * (j))
#define XB_XSUB(j)  (1280 + 64 * (j))
#define XB_XGEN(j)  (2304 + 64 * (j))
#define XB_TOP      3328
#define XB_TOPGEN   3392
#define XCD_BAR_WORDS 3456
#define XB_SPIN_CAP (1u << 18)
#define LAS __attribute__((address_space(3)))

__device__ __forceinline__ unsigned xb_ld(unsigned* p)              { return __hip_atomic_load(p, __ATOMIC_RELAXED, __HIP_MEMORY_SCOPE_AGENT); }
__device__ __forceinline__ unsigned xb_add(unsigned* p, unsigned v) { return __hip_atomic_fetch_add(p, v, __ATOMIC_RELAXED, __HIP_MEMORY_SCOPE_AGENT); }
__device__ __forceinline__ unsigned xb_xcc_id() { return (unsigned)__builtin_amdgcn_s_getreg((3 << 11) | 20) & 0xFu; }
#define XB_SPIN(cond, bar) do { unsigned _sp = 0; while (cond) { __builtin_amdgcn_s_sleep(1); \
    if ((++_sp & 255u) == 0u) { if (xb_ld(&(bar)[XB_TMO])) break; if (_sp > XB_SPIN_CAP) { atomicAdd(&(bar)[XB_TMO], 1u); break; } } } } while (0)

struct XcdBarrier {
    unsigned* bar; unsigned x;
    volatile LAS unsigned* st;
};

__device__ __forceinline__ XcdBarrier xcd_barrier_post(unsigned* bar, volatile LAS unsigned* st) {
    XcdBarrier b; b.bar = bar; b.x = xb_xcc_id(); b.st = st;
    if (threadIdx.x == 0) (void)xb_add(&bar[XB_XCNT(b.x)], 1u);
    return b;
}
__device__ __forceinline__ void xcd_barrier_complete(unsigned* bar, unsigned x, unsigned& nloc, unsigned& nx) {
    const unsigned G = gridDim.x * gridDim.y * gridDim.z;
    unsigned sum, cnt, mine, sp = 0u;
    for (;;) {
        sum = 0u; cnt = 0u; mine = 0u;
#pragma unroll
        for (unsigned j = 0; j < 16; ++j) { const unsigned c = xb_ld(&bar[XB_XCNT(j)]); sum += c; cnt += (c > 0u) ? 1u : 0u; mine = (j == x) ? c : mine; }
        if (sum == G) break;
        __builtin_amdgcn_s_sleep(1);
        if ((++sp & 255u) == 0u) { if (xb_ld(&bar[XB_TMO])) break; if (sp > XB_SPIN_CAP) { atomicAdd(&bar[XB_TMO], 1u); break; } }
    }
    nloc = mine > 0u ? mine : 1u; nx = cnt > 0u ? cnt : 1u;
}

__device__ __forceinline__ void xcd_barrier(const XcdBarrier& b) {
    asm volatile("s_waitcnt vmcnt(0)" ::: "memory");
    __syncthreads();
    if (threadIdx.x == 0) {
        unsigned* bar = b.bar;
        __builtin_amdgcn_s_waitcnt(0);
        unsigned nloc = b.st[0], nx = b.st[1];
        if (nloc == 0u) { xcd_barrier_complete(bar, b.x, nloc, nx); b.st[0] = nloc; b.st[1] = nx; }
        const unsigned old = xb_add(&bar[XB_XSUB(b.x)], 1u);
        const unsigned gen = old / nloc;
        if (old + 1u == (gen + 1u) * nloc) {
            __builtin_amdgcn_fence(__ATOMIC_RELEASE, "agent");
            asm volatile("s_waitcnt vmcnt(0)" ::: "memory");
            const unsigned og = xb_add(&bar[XB_TOP], 1u);
            const unsigned tg = og / nx;
            if (og + 1u == (tg + 1u) * nx) xb_add(&bar[XB_TOPGEN], 1u);
            else XB_SPIN(xb_ld(&bar[XB_TOPGEN]) == tg, bar);
            __builtin_amdgcn_fence(__ATOMIC_ACQUIRE, "agent");
            xb_add(&bar[XB_XGEN(b.x)], 1u);
            asm volatile("s_waitcnt vmcnt(0)" ::: "memory");
        } else {
            XB_SPIN(xb_ld(&bar[XB_XGEN(b.x)]) == gen, bar);
            __builtin_amdgcn_fence(__ATOMIC_ACQUIRE, "agent");
            asm volatile("s_waitcnt vmcnt(0)" ::: "memory");
        }
    }
    __syncthreads();
}

#define GSYNC xcd_barrier(xb)
#define LAYER(layer)                                                                                              \
  {                                                                                                               \
    const u16* WL = (const u16*)(p.ws + OFF_W) + (size_t)(layer) * W_LAYER;                                       \
    const u16* XB = (const u16*)(p.ws + OFF_XB);                                                                  \
    const u16* HB = (const u16*)(p.ws + OFF_H);                                                                   \
    big_gemm(XB, WL + W_UP1, 5632, 1024, EpiSwiglu{(u16*)(p.ws + OFF_H)}, smem_blk); GSYNC;                       \
    big_gemm<true, true>(HB, WL + W_DN1, 1024, FF, EpiResid{(layer) == 0 ? p.in[0] : p.out, p.out, 0.5f}, smem_blk); GSYNC;                                   \
    bias_reduce(p); phase_ln(p, p.in[1] + (layer) * DM, p.in[2] + (layer) * DM); GSYNC;                                          \
    big_gemm(XB, WL + W_IN, 3840, 1024, EpiWin{p.ws}, smem_blk); GSYNC;                                           \
    phase_up_cmp(p, layer, smem); GSYNC;                                                                          \
    phase_attn(p, layer, smem, smem_blk); GSYNC;                                                                  \
    big_gemm((const u16*)(p.ws + OFF_OM), WL + W_PM, 1024, 512, EpiGate1{(u16*)(p.ws + OFF_GM)}, smem_blk); GSYNC; big_gemm((const u16*)(p.ws + OFF_ON), WL + W_PN, 1024, 512, EpiGate2{(const u16*)(p.ws + OFF_GM), (const u16*)(p.ws + OFF_GN), (u16*)(p.ws + OFF_XB)}, smem_blk); GSYNC;                                                                           \
    big_gemm(XB, WL + W_OUT, 1024, 1024, EpiResid{p.out, p.out, 1.0f}, smem_blk); GSYNC;        \
    phase_ln(p, p.in[22] + (layer) * DM, p.in[23] + (layer) * DM); GSYNC;                                         \
    big_gemm(XB, WL + W_UP2, 5632, 1024, EpiSwiglu{(u16*)(p.ws + OFF_H)}, smem_blk); GSYNC;                       \
    big_gemm<true, true>(HB, WL + W_DN2, 1024, FF, EpiResid{p.out, p.out, 0.5f}, smem_blk); GSYNC;                                   \
    if ((layer) == 1) phase_ln<false>(p, p.in[27] + (layer) * DM, p.in[28] + (layer) * DM);                       \
    else phase_ln(p, p.in[27] + (layer) * DM, p.in[28] + (layer) * DM);                                           \
  }

__global__ void __launch_bounds__(512, 2) mega(Params p) {
  __shared__ __attribute__((aligned(16))) char smem_blk[SMEM_BYTES];
  char* smem = smem_blk + vhalf() * VSMEM;
  cg::grid_group grid = cg::this_grid();
  volatile LAS unsigned* st = (volatile LAS unsigned*)(smem_blk + 2 * VSMEM + 16);
  if (threadIdx.x == 0) { st[0] = 0u; st[1] = 0u; }
  __syncthreads();
  const XcdBarrier xb = xcd_barrier_post((unsigned*)(p.ws + OFF_BAR), st);
  phase_init(p, smem);
  if (p.ws == nullptr) grid.sync();
  GSYNC;
  LAYER(0)
  GSYNC;
  LAYER(1)
}

extern "C" void kernel_launch(void* const* d_in, const int* in_sizes, int n_in, void* d_out, int out_size, void* d_ws,
                              size_t ws_size, hipStream_t stream) {
  Params p{};
  for (int i = 0; i < 29; ++i) p.in[i] = (const float*)d_in[i];
  p.out = (float*)d_out;
  p.ws = (char*)d_ws;
  if (ws_size < WS_NEED) fprintf(stderr, "workspace too small: %zu < %zu\n", ws_size, (size_t)WS_NEED);
  static int grid_blocks = 0;
  if (!grid_blocks) {
    int dev = 0, cus = 0, per_cu = 0;
    hipGetDevice(&dev);
    hipDeviceGetAttribute(&cus, hipDeviceAttributeMultiprocessorCount, dev);
    hipOccupancyMaxActiveBlocksPerMultiprocessor(&per_cu, mega, 512, 0);
    if (per_cu < 1) per_cu = 1;
    if (per_cu > 1) per_cu = 1;
    grid_blocks = cus * per_cu;
  }
  (void)hipMemsetAsync((char*)d_ws + OFF_BAR, 0, XCD_BAR_WORDS * 4, stream);
  void* args[] = {&p};
  hipError_t e = hipLaunchCooperativeKernel((void*)mega, dim3(grid_blocks), dim3(512), args, 0, stream);
  if (e != hipSuccess) fprintf(stderr, "cooperative launch failed: %s (grid %d)\n", hipGetErrorString(e), grid_blocks);
}
```
